# Optimizing an MI355X kernel written in HIP

```python
import math
import jax, jax.numpy as jnp
from jax import lax
import numpy as np

D_MODEL = 1024
BATCH = 16
SEQ = 2048
DEPTH = 2

GRID_W = 64
CTX_LEN = 256
CHUNK = 32
EPS = 1e-6
LB_FLOOR = 1e-30

MIX_WIDTH = D_MODEL
GLA_HEADS = 4
GLA_WIDTH = MIX_WIDTH // 2
GLA_DV = GLA_WIDTH // GLA_HEADS
GLA_DK = GLA_DV // 2
GLA_QK = GLA_HEADS * GLA_DK
GLA_GATE_RANK = 16
GLA_GATE_NORM = 16.0
HGRN_HEADS = 4
HGRN_WIDTH = MIX_WIDTH - GLA_WIDTH
HGRN_DV = HGRN_WIDTH // HGRN_HEADS
HGRN_DK = 128
HGRN_QK = HGRN_HEADS * HGRN_DK
IN_SPLITS = (GLA_QK, GLA_QK, GLA_WIDTH, GLA_WIDTH, GLA_GATE_RANK, GLA_GATE_RANK,
             HGRN_QK, HGRN_QK, HGRN_QK, HGRN_WIDTH, HGRN_WIDTH)
IN_WIDTH = sum(IN_SPLITS)
D_FF = 256 * math.ceil(8 * D_MODEL / 3 / 256)
N_EXPERTS = 8
TOP_K = 2
D_EXPERT = 7 * D_MODEL // 2
N_DENSE = (DEPTH + 1) // 2
N_MOE = DEPTH // 2

kernel_name = "hybrid_gla_hgrn2_moe_diffusion_block"


def rmsnorm(x, g):
    xf = x.astype(jnp.float32)
    y = xf * lax.rsqrt(jnp.mean(xf * xf, axis=-1, keepdims=True) + EPS)
    return (y * g.astype(jnp.float32)).astype(x.dtype)


def ada_rmsnorm(x, g, shift, scale):
    return rmsnorm(x, g) * (1 + scale) + shift


def to_heads(t, n_heads):
    b, l, _ = t.shape
    return t.reshape(b, l, n_heads, -1).transpose(0, 2, 1, 3)


def merge_heads(t):
    b, h, l, d = t.shape
    return t.transpose(0, 2, 1, 3).reshape(b, l, h * d)


def to_colmajor(t, rows):
    b, l, ch = t.shape
    return t.reshape(b, rows, GRID_W, ch).transpose(0, 2, 1, 3).reshape(b, l, ch)


def from_colmajor(t, rows):
    b, l, ch = t.shape
    return t.reshape(b, GRID_W, rows, ch).transpose(0, 2, 1, 3).reshape(b, l, ch)


def chunk_gla(q, k, v, log_f, s0):
    b_, h_, l_, _ = q.shape
    dv = v.shape[-1]
    n = l_ // CHUNK

    def blocks(t):
        return jnp.moveaxis(t.astype(jnp.float32).reshape(b_, h_, n, CHUNK, t.shape[-1]), 2, 0)

    lower_tri = jnp.tril(jnp.ones((CHUNK, CHUNK), dtype=bool))[:, :, None]

    def step(state, blk):
        qc, kc, vc, gc = blk
        b = jnp.cumsum(gc, axis=2)
        b_last = b[:, :, -1, :]
        o_inter = jnp.einsum('bhcd,bhde->bhce', qc * jnp.exp(b), state)
        diff = b[:, :, :, None, :] - b[:, :, None, :, :]
        decay = jnp.where(lower_tri, jnp.exp(jnp.where(lower_tri, diff, 0.0)), 0.0)
        scores = jnp.einsum('bhid,bhjd,bhijd->bhij', qc, kc, decay)
        o = o_inter + jnp.einsum('bhij,bhje->bhie', scores, vc)
        k_dec = kc * jnp.exp(b_last[:, :, None, :] - b)
        new_state = state * jnp.exp(b_last)[..., None] + jnp.einsum('bhcd,bhce->bhde', k_dec, vc)
        return new_state, o

    final, o = lax.scan(step, s0, (blocks(q), blocks(k), blocks(v), blocks(log_f)))
    o = jnp.moveaxis(o, 0, 2).reshape(b_, h_, l_, dv)
    return o, final


def bidir_recurrence(ctx_in, lat_in, n_heads, need_ctx):
    qc, kfc, kbc, vc, gfc, gbc = [to_heads(t, n_heads) for t in ctx_in]
    ql, kfl, kbl, vl, gfl, gbl = [to_heads(t, n_heads) for t in lat_in]
    flip = lambda t: jnp.flip(t, axis=2)
    b_, h_, _, dk = qc.shape
    s0 = jnp.zeros((b_, h_, dk, vc.shape[-1]), jnp.float32)
    o_cf, s_cf = chunk_gla(qc, kfc, vc, gfc, s0)
    o_cb, s_cb = chunk_gla(flip(qc), flip(kbc), flip(vc), flip(gbc), s0)
    o_lf, _ = chunk_gla(ql, kfl, vl, gfl, s_cf)
    o_lb, _ = chunk_gla(flip(ql), flip(kbl), flip(vl), flip(gbl), s_cb)
    o_lat = o_lf + flip(o_lb)
    o_ctx = (o_cf + flip(o_cb)) if need_ctx else None
    return o_ctx, o_lat


def hgrn_forget(f_pre, lb):
    f_pre = f_pre.astype(jnp.float32)
    log_lb = jnp.log(jnp.maximum(lb, LB_FLOOR))
    log_f = jnp.logaddexp(log_lb, jnp.log1p(-lb) + jax.nn.log_sigmoid(f_pre))
    k = (1.0 - lb) * jax.nn.sigmoid(-f_pre)
    return k, log_f


def project(h, w_in, gate_w2, gate_b, lb):
    p = h @ w_in
    offsets = np.cumsum(np.array(IN_SPLITS))[:-1].tolist()
    gq, gk, gv, gg, grf, grb, hq, hff, hfb, hv, hg = jnp.split(p, offsets, axis=-1)
    gla_q = gq * (GLA_DK ** -0.5)
    gla_lf = jax.nn.log_sigmoid((grf @ gate_w2[0] + gate_b[0]).astype(jnp.float32)) / GLA_GATE_NORM
    gla_lb = jax.nn.log_sigmoid((grb @ gate_w2[1] + gate_b[1]).astype(jnp.float32)) / GLA_GATE_NORM
    hq = jax.nn.silu(hq)
    hk_f, hlf_f = hgrn_forget(hff, lb[0])
    hk_b, hlf_b = hgrn_forget(hfb, lb[1])
    gla = (gla_q, gk, gk, gv, gla_lf, gla_lb)
    hgrn = (hq, hk_f, hk_b, hv, hlf_f, hlf_b)
    return gla, gg, hgrn, hg


def head_out(o, norm_g, dtype):
    return merge_heads(rmsnorm(o, norm_g).astype(dtype))


def token_mix(h_ctx, h_lat, w_in, gate_w2, gate_b, gla_g, hgrn_g, lb, w_out, need_ctx):
    rows = h_lat.shape[1] // GRID_W
    gla_c, gate_gla_c, hgrn_c, gate_hgrn_c = project(h_ctx, w_in, gate_w2, gate_b, lb)
    gla_l, gate_gla_l, hgrn_l, gate_hgrn_l = project(h_lat, w_in, gate_w2, gate_b, lb)
    o_gla_c, o_gla_l = bidir_recurrence(gla_c, gla_l, GLA_HEADS, need_ctx)
    hgrn_l_cm = tuple(to_colmajor(t, rows) for t in hgrn_l)
    o_hg_c, o_hg_l = bidir_recurrence(hgrn_c, hgrn_l_cm, HGRN_HEADS, need_ctx)
    dt = h_lat.dtype
    mix_l = jnp.concatenate([
        head_out(o_gla_l, gla_g, dt) * jax.nn.silu(gate_gla_l),
        from_colmajor(head_out(o_hg_l, hgrn_g, dt), rows) * jax.nn.silu(gate_hgrn_l)], axis=-1)
    y_lat = mix_l @ w_out
    y_ctx = None
    if need_ctx:
        mix_c = jnp.concatenate([
            head_out(o_gla_c, gla_g, dt) * jax.nn.silu(gate_gla_c),
            head_out(o_hg_c, hgrn_g, dt) * jax.nn.silu(gate_hgrn_c)], axis=-1)
        y_ctx = mix_c @ w_out
    return y_ctx, y_lat


def swiglu(h, w1, w3, w2):
    return (jax.nn.silu(h @ w1) * (h @ w3)) @ w2


def moe_swiglu(h, router, w1, w3, w2):
    b, l, d = h.shape
    t = h.reshape(b * l, d)
    logits = (t @ router).astype(jnp.float32)
    top_v, top_i = lax.top_k(logits, TOP_K)
    top_w = jax.nn.softmax(top_v, axis=-1)
    gates = jnp.sum(jax.nn.one_hot(top_i, N_EXPERTS, dtype=jnp.float32) * top_w[..., None], axis=1)
    gates = gates.astype(t.dtype)
    y = jnp.zeros_like(t)
    for e in range(N_EXPERTS):
        y = y + gates[:, e:e + 1] * swiglu(t, w1[e], w3[e], w2[e])
    return y.reshape(b, l, d)


def channel_mix(h, layer, ffn_w1, ffn_w3, ffn_w2, moe_router, moe_w1, moe_w3, moe_w2):
    i = layer // 2
    if layer % 2 == 0:
        return swiglu(h, ffn_w1[i], ffn_w3[i], ffn_w2[i])
    return moe_swiglu(h, moe_router[i], moe_w1[i], moe_w3[i], moe_w2[i])


def setup_inputs(seed: int = 0) -> dict:
    key = jax.random.key(seed)
    ks = jax.random.split(key, 24)
    nrm = lambda k, shape, s: jax.random.normal(k, shape, jnp.float32) * s
    D = D_MODEL
    return {
        "x": nrm(ks[0], (BATCH, SEQ, D), 1.0),
        "c": nrm(ks[1], (BATCH, D), 1.0),
        "ctx": nrm(ks[2], (BATCH, CTX_LEN, D), 1.0),
        "c_ctx": nrm(ks[3], (D,), 1.0),
        "w_mod": nrm(ks[4], (DEPTH, D, 6 * D), 0.5 * D ** -0.5),
        "b_mod": nrm(ks[5], (DEPTH, 6 * D), 0.01),
        "norm1_g": 1.0 + nrm(ks[6], (DEPTH, D), 0.05),
        "norm2_g": 1.0 + nrm(ks[7], (DEPTH, D), 0.05),
        "w_in": nrm(ks[8], (DEPTH, D, IN_WIDTH), D ** -0.5),
        "gla_gate_w2": nrm(ks[9], (DEPTH, 2, GLA_GATE_RANK, GLA_QK), GLA_GATE_RANK ** -0.5),
        "gla_gate_b": nrm(ks[10], (DEPTH, 2, GLA_QK), 0.1),
        "gla_norm_g": 1.0 + nrm(ks[11], (DEPTH, GLA_DV), 0.05),
        "hgrn_norm_g": 1.0 + nrm(ks[12], (DEPTH, HGRN_DV), 0.05),
        "hgrn_lb": 1.0 + nrm(ks[13], (DEPTH, 2, HGRN_QK), 0.1),
        "w_out": nrm(ks[14], (DEPTH, MIX_WIDTH, D), MIX_WIDTH ** -0.5),
        "ffn_w1": nrm(ks[15], (N_DENSE, D, D_FF), D ** -0.5),
        "ffn_w3": nrm(ks[16], (N_DENSE, D, D_FF), D ** -0.5),
        "ffn_w2": nrm(ks[17], (N_DENSE, D_FF, D), D_FF ** -0.5),
        "moe_router": nrm(ks[18], (N_MOE, D, N_EXPERTS), D ** -0.5),
        "moe_w1": nrm(ks[19], (N_MOE, N_EXPERTS, D, D_EXPERT), D ** -0.5),
        "moe_w3": nrm(ks[20], (N_MOE, N_EXPERTS, D, D_EXPERT), D ** -0.5),
        "moe_w2": nrm(ks[21], (N_MOE, N_EXPERTS, D_EXPERT, D), D_EXPERT ** -0.5),
        "final_norm_g": 1.0 + nrm(ks[22], (D,), 0.05),
    }


def reference(x, c, ctx, c_ctx, w_mod, b_mod, norm1_g, norm2_g, w_in, gla_gate_w2, gla_gate_b,
              gla_norm_g, hgrn_norm_g, hgrn_lb, w_out, ffn_w1, ffn_w3, ffn_w2, moe_router,
              moe_w1, moe_w3, moe_w2, final_norm_g):
    lb_soft = jax.nn.softmax(hgrn_lb.astype(jnp.float32), axis=0)
    lb_all = jnp.maximum(jnp.cumsum(lb_soft, axis=0) - lb_soft[0], 0.0)
    silu_c = jax.nn.silu(c)
    silu_cc = jax.nn.silu(c_ctx)
    for l in range(DEPTH):
        last = l == DEPTH - 1
        m_lat = jnp.split((silu_c @ w_mod[l] + b_mod[l])[:, None, :], 6, axis=-1)
        m_ctx = jnp.split(silu_cc @ w_mod[l] + b_mod[l], 6, axis=-1)
        h_lat = ada_rmsnorm(x, norm1_g[l], m_lat[0], m_lat[1])
        h_ctx = ada_rmsnorm(ctx, norm1_g[l], m_ctx[0], m_ctx[1])
        y_ctx, y_lat = token_mix(h_ctx, h_lat, w_in[l], gla_gate_w2[l], gla_gate_b[l],
                                 gla_norm_g[l], hgrn_norm_g[l], lb_all[l], w_out[l], not last)
        x = x + m_lat[2] * y_lat
        h_lat = ada_rmsnorm(x, norm2_g[l], m_lat[3], m_lat[4])
        x = x + m_lat[5] * channel_mix(h_lat, l, ffn_w1, ffn_w3, ffn_w2,
                                       moe_router, moe_w1, moe_w3, moe_w2)
        if not last:
            ctx = ctx + m_ctx[2] * y_ctx
            h_ctx = ada_rmsnorm(ctx, norm2_g[l], m_ctx[3], m_ctx[4])
            ctx = ctx + m_ctx[5] * channel_mix(h_ctx, l, ffn_w1, ffn_w3, ffn_w2,
                                               moe_router, moe_w1, moe_w3, moe_w2)
    return rmsnorm(x, final_norm_g)
```

```cpp
#include <hip/hip_runtime.h>
#include <cstdio>
#include <cstdint>
#ifndef MK_MULTI
#define MK_MULTI 1
#endif
namespace pg8 {
#define PG8_LAS __attribute__((address_space(3)))
typedef unsigned short bf16_t;
typedef short bf16x8 __attribute__((ext_vector_type(8)));
typedef float f32x4 __attribute__((ext_vector_type(4)));
typedef unsigned u32x4 __attribute__((ext_vector_type(4)));
constexpr int BM = 256, BK = 64, HALF = 128, HTB = HALF * BK * 2  , STAGE_BYTES = 8 * HTB, NXCD = 8, WGM = 8;

__host__ __device__ __forceinline__ int lds_byte(int r, int c) { const int st = (r >> 4) * 2 + (c >> 5), rr = r & 15, cc = c & 31, ob = rr * 64 + cc * 2; return st * 1024 + (ob ^ (((ob >> 9) & 1) << 5)); }
__host__ __device__ __forceinline__ void stage_rc(int b, int& R, int& C) { const int st = b / 1024, sb = b % 1024, swz = sb ^ (((sb >> 9) & 1) << 5); R = (st >> 1) * 16 + swz / 64; C = (st & 1) * 32 + (swz % 64) / 2; }
__host__ __device__ __forceinline__ int perm32(int rho) { const int n = rho >> 4, i = rho & 15; return 8 * (i >> 2) + 4 * n + (i & 3); }

struct Unit { int pm, pn; };
struct Gemm { const bf16_t* A; const bf16_t* Bt; int M, N, K; };

struct StaticOrder {
    int nM, nN, nwg, G, c;
    __host__ __device__ void init(int M, int N, int G_, int c_) { nM = M / BM; nN = N / BM; nwg = nM * nN; G = G_; c = c_; }
    __host__ __device__ bool next(int i, Unit& u) const {
        const long L = (long)i * G + c; if (L >= nwg) return false;
        int wgid = (int)L; { const int q = nwg / NXCD, r = nwg % NXCD, xcd = wgid % NXCD, off = wgid / NXCD; wgid = (xcd < r ? xcd * (q + 1) : r * (q + 1) + (xcd - r) * q) + off; }
        const int nig = WGM * nN, gid = wgid / nig, fm = gid * WGM, gsz = (nM - fm) < WGM ? (nM - fm) : WGM;
        u.pm = fm + ((wgid % nig) % gsz); u.pn = (wgid % nig) / gsz; return true;
    }
    __device__ __forceinline__ void a_ready(const Unit&) const {}
    __device__ __forceinline__ void done(const Unit&) const {}
};
__device__ __forceinline__ unsigned cvt_pk_bf16(float lo, float hi) { unsigned r; asm volatile("v_cvt_pk_bf16_f32 %0, %1, %2" : "=v"(r) : "v"(lo), "v"(hi)); return r; }
typedef float f32x2 __attribute__((ext_vector_type(2)));
template <class Epi, class Sched, bool ALIGN_EPI = false, bool SP2 = false>
__device__ __forceinline__ void gemm_phase(PG8_LAS unsigned char* lds, const Gemm g, const Sched& S, const Epi& E) {
    int tid_l = threadIdx.x; asm volatile("" : "+v"(tid_l));
    const int tid = tid_l, wid = __builtin_amdgcn_readfirstlane(tid >> 6), lane = tid & 63, wr = wid >> 2, wc = wid & 3, fr = lane & 15, fq = lane >> 4;
    const int K = g.K, nt = K / BK;
    unsigned voffA[2], voffB[2];
#pragma unroll
    for (int i = 0; i < 2; ++i) { int R, C; stage_rc(tid * 16 + i * 8192, R, C); const int Rb = Epi::PERM ? ((R & ~31) + perm32(R & 31)) : R;
        voffA[i] = (unsigned)(R * K + C) * 2u; voffB[i] = (unsigned)(Rb * K + C) * 2u; }
    const size_t kstep = (size_t)(BK * 2);
    const size_t hstep = (size_t)HALF * K * 2;
    const size_t tstep = 2 * hstep;
    const unsigned ldsw = (unsigned)wid * 1024u;
    const int aoff = lds_byte(wr * 64 + fr, fq * 8), boff = lds_byte(wc * 32 + fr, fq * 8);
#define PG8_SA(b, h) (((b) * 2 + (h)) * HTB)
#define PG8_SB(b, h) ((4 + (b) * 2 + (h)) * HTB)
#define PG8_STAGE(bufoff, gbase, voff) do { _Pragma("unroll") for (int _i = 0; _i < 2; ++_i) \
        __builtin_amdgcn_global_load_lds((const unsigned*)((const char*)(gbase) + (voff)[_i]), (PG8_LAS unsigned*)(lds + (bufoff) + ldsw + _i * 8192), 16, 0, 0); } while (0)
#define PG8_LDA(dst, b, h) do { _Pragma("unroll") for (int m = 0; m < 4; ++m) _Pragma("unroll") for (int k = 0; k < 2; ++k) dst[m][k] = *(const PG8_LAS bf16x8*)(lds + PG8_SA(b, h) + aoff + m * 2048 + k * 1024); } while (0)
#define PG8_LDB(dst, b, h) do { _Pragma("unroll") for (int n = 0; n < 2; ++n) _Pragma("unroll") for (int k = 0; k < 2; ++k) dst[n][k] = *(const PG8_LAS bf16x8*)(lds + PG8_SB(b, h) + boff + n * 2048 + k * 1024); } while (0)
#define PG8_MMA(ai, bj, At, Bt) do { __builtin_amdgcn_s_setprio(1); _Pragma("unroll") for (int m = 0; m < 4; ++m) _Pragma("unroll") for (int n = 0; n < 2; ++n) _Pragma("unroll") for (int k = 0; k < 2; ++k) \
        acc[ai][bj][m][n] = __builtin_amdgcn_mfma_f32_16x16x32_bf16(Bt[n][k], At[m][k], acc[ai][bj][m][n], 0, 0, 0); __builtin_amdgcn_s_setprio(0); } while (0)
#define PG8_WAIT_V(n) asm volatile("s_waitcnt vmcnt(" #n ")" ::: "memory")
#define PG8_WAIT_L(n) asm volatile("s_waitcnt lgkmcnt(" #n ")" ::: "memory")
#define PG8_BAR __builtin_amdgcn_s_barrier()
#define PG8_SCHED __builtin_amdgcn_sched_barrier(0)
    Unit cur, nxt; int ui = 0;
    if (!S.next(0, cur)) return;
    f32x4 acc[2][2][4][2];
#pragma unroll
    for (int a = 0; a < 2; ++a)
#pragma unroll
        for (int b = 0; b < 2; ++b)
#pragma unroll
            for (int m = 0; m < 4; ++m)
#pragma unroll
                for (int n = 0; n < 2; ++n) acc[a][b][m][n] = (f32x4){0.f, 0.f, 0.f, 0.f};
    bf16x8 At[4][2], B0[2][2], B1[2][2];
    const char* cA = (const char*)g.A + (size_t)cur.pm * tstep; const char* cB = (const char*)g.Bt + (size_t)cur.pn * tstep;
    S.a_ready(cur);
    if constexpr (SP2) {
        PG8_STAGE(PG8_SB(0, 0), cB, voffB); PG8_STAGE(PG8_SB(0, 1), cB + hstep, voffB); PG8_STAGE(PG8_SA(0, 0), cA, voffA); PG8_STAGE(PG8_SA(0, 1), cA + hstep, voffA);
        if (wr == 1) PG8_BAR;
        PG8_WAIT_V(2); PG8_BAR;
        PG8_STAGE(PG8_SB(1, 0), cB + kstep, voffB); PG8_STAGE(PG8_SA(1, 0), cA + kstep, voffA); PG8_STAGE(PG8_SB(1, 1), cB + hstep + kstep, voffB);
        PG8_WAIT_V(6); PG8_BAR;
    } else {
        PG8_STAGE(PG8_SB(0, 0), cB, voffB); PG8_STAGE(PG8_SA(0, 0), cA, voffA); PG8_STAGE(PG8_SB(0, 1), cB + hstep, voffB); PG8_STAGE(PG8_SA(0, 1), cA + hstep, voffA);
        if (wr == 1) PG8_BAR;
        PG8_WAIT_V(4); PG8_BAR;
        PG8_STAGE(PG8_SB(1, 0), cB + kstep, voffB); PG8_STAGE(PG8_SA(1, 0), cA + kstep, voffA); PG8_STAGE(PG8_SB(1, 1), cB + hstep + kstep, voffB);
        PG8_WAIT_V(6); PG8_BAR;
    }
    for (;;) {
        const bool has_next = S.next(ui + 1, nxt);
        const char* nA = has_next ? (const char*)g.A + (size_t)nxt.pm * tstep : cA; const char* nB = has_next ? (const char*)g.Bt + (size_t)nxt.pn * tstep : cB;
        for (int t = 0; t < nt; t += 2) {
            const bool last = (t == nt - 2);
            const char* a1 = cA + (size_t)(t + 1) * kstep;
            const char* a2 = last ? nA : cA + (size_t)(t + 2) * kstep; const char* b2 = last ? nB : cB + (size_t)(t + 2) * kstep;
            const char* a3 = a2 + kstep; const char* b3 = b2 + kstep;
            if (last && has_next) S.a_ready(nxt);
            if constexpr (SP2) {
            PG8_LDB(B0, 0, 0); PG8_LDB(B1, 0, 1); PG8_SCHED; PG8_LDA(At, 0, 0); PG8_STAGE(PG8_SA(1, 1), a1 + hstep, voffA);
            PG8_WAIT_V(8); PG8_WAIT_L(0); PG8_BAR; PG8_MMA(0, 0, At, B0); PG8_MMA(0, 1, At, B1); PG8_BAR; PG8_SCHED;
            PG8_LDA(At, 0, 1); PG8_STAGE(PG8_SB(0, 0), b2, voffB); PG8_STAGE(PG8_SB(0, 1), b2 + hstep, voffB); PG8_STAGE(PG8_SA(0, 0), a2, voffA);
            PG8_WAIT_V(8); PG8_WAIT_L(0); PG8_BAR; PG8_MMA(1, 0, At, B0); PG8_MMA(1, 1, At, B1); PG8_BAR; PG8_SCHED;
            PG8_LDB(B0, 1, 0); PG8_LDB(B1, 1, 1); PG8_SCHED; PG8_LDA(At, 1, 0); PG8_STAGE(PG8_SA(0, 1), a2 + hstep, voffA);
            PG8_WAIT_V(8); PG8_WAIT_L(0); PG8_BAR; PG8_MMA(0, 0, At, B0); PG8_MMA(0, 1, At, B1); PG8_BAR; PG8_SCHED;
            PG8_LDA(At, 1, 1); PG8_STAGE(PG8_SB(1, 0), b3, voffB); PG8_STAGE(PG8_SB(1, 1), b3 + hstep, voffB); PG8_STAGE(PG8_SA(1, 0), a3, voffA);
            PG8_WAIT_V(8); PG8_WAIT_L(0); PG8_BAR; PG8_MMA(1, 0, At, B0); PG8_MMA(1, 1, At, B1); PG8_BAR; PG8_SCHED;
            } else {
            PG8_LDB(B0, 0, 0); PG8_SCHED; PG8_LDA(At, 0, 0); PG8_STAGE(PG8_SA(1, 1), a1 + hstep, voffA);
            PG8_WAIT_L(8); PG8_BAR; PG8_WAIT_L(0); PG8_MMA(0, 0, At, B0); PG8_BAR; PG8_SCHED;
            PG8_LDB(B1, 0, 1); PG8_STAGE(PG8_SB(0, 0), b2, voffB);
            PG8_BAR; PG8_WAIT_L(0); PG8_MMA(0, 1, At, B1); PG8_BAR;
            PG8_LDA(At, 0, 1); PG8_STAGE(PG8_SA(0, 0), a2, voffA);
            PG8_BAR; PG8_WAIT_L(0); PG8_MMA(1, 0, At, B0); PG8_BAR; PG8_SCHED;
            PG8_STAGE(PG8_SB(0, 1), b2 + hstep, voffB);
            PG8_WAIT_V(6); PG8_BAR; PG8_MMA(1, 1, At, B1); PG8_BAR;
            PG8_LDB(B0, 1, 0); PG8_SCHED; PG8_LDA(At, 1, 0); PG8_STAGE(PG8_SA(0, 1), a2 + hstep, voffA);
            PG8_WAIT_L(8); PG8_BAR; PG8_WAIT_L(0); PG8_MMA(0, 0, At, B0); PG8_BAR; PG8_SCHED;
            PG8_LDB(B1, 1, 1); PG8_STAGE(PG8_SB(1, 0), b3, voffB);
            PG8_BAR; PG8_WAIT_L(0); PG8_MMA(0, 1, At, B1); PG8_BAR;
            PG8_LDA(At, 1, 1); PG8_STAGE(PG8_SA(1, 0), a3, voffA);
            PG8_BAR; PG8_WAIT_L(0); PG8_MMA(1, 0, At, B0); PG8_BAR; PG8_SCHED;
            PG8_STAGE(PG8_SB(1, 1), b3 + hstep, voffB);
            PG8_WAIT_V(6); PG8_BAR; PG8_MMA(1, 1, At, B1); PG8_BAR;
            }
        }
        if constexpr (ALIGN_EPI) { if (wr == 0) PG8_BAR; }
        if constexpr (!Epi::AFTER_DRAIN) { E(acc, cur, wr, wc, fr, fq); S.done(cur); }
        if (!has_next) break;
#pragma unroll
        for (int a = 0; a < 2; ++a)
#pragma unroll
            for (int b = 0; b < 2; ++b)
#pragma unroll
                for (int m = 0; m < 4; ++m)
#pragma unroll
                    for (int n = 0; n < 2; ++n) acc[a][b][m][n] = (f32x4){0.f, 0.f, 0.f, 0.f};
        cur = nxt; cA = nA; cB = nB; ++ui;
        if constexpr (ALIGN_EPI) { if (wr == 1) PG8_BAR; }
    }
    PG8_WAIT_V(0);
    if constexpr (!ALIGN_EPI) { if (wr == 0) PG8_BAR; }
    PG8_BAR;
    if constexpr (Epi::AFTER_DRAIN) { E.fused(acc, cur, wr, wc, fr, fq, lds, wid, lane); S.done(cur); }
#undef PG8_SA
#undef PG8_SB
#undef PG8_STAGE
#undef PG8_LDA
#undef PG8_LDB
#undef PG8_MMA
#undef PG8_WAIT_V
#undef PG8_WAIT_L
#undef PG8_BAR
#undef PG8_SCHED
}
}
constexpr int NB = 16, SEQ = 2048, CTXL = 256, D = 1024;
constexpr int ML = NB * SEQ, MC = NB * CTXL, MT = ML + MC;
constexpr int INW = 4128, PW = 4096, NIN = 4352;
constexpr int DFF = 2816, NEXP = 8, DEXP = 3584;
constexpr int NWAVES = 8, NTHR = 512;
constexpr float EPS = 1e-6f;
constexpr int NPHASE = 27;
constexpr int CHUNK_PAN = 64;
constexpr int HS_ROWS = 2 * ML + NEXP * 256;

constexpr size_t MiB = 1u << 20;
constexpr size_t WS_CTL = 0, CTL_ZERO_BYTES = 1 * MiB;
constexpr size_t WS_MODS = 1 * MiB, WS_ROUTE = 2 * MiB, WS_GR = 4 * MiB, WS_WIN = 7 * MiB, WS_WOUT = 24 * MiB, WS_F13 = 28 * MiB, WS_F2 = 39 * MiB;
constexpr size_t WS_XC = 45 * MiB, WS_H = 61 * MiB, WS_OB = 133 * MiB, WS_G = 205 * MiB, WS_P = 277 * MiB, WS_END = 565 * MiB;
constexpr size_t WS_MIX = WS_P, WS_ACT0 = WS_P, WS_HS = WS_OB, WS_ACT = 265 * MiB, WS_M13 = 397 * MiB, WS_M2 = 509 * MiB;
static_assert(WS_GR + (size_t)MT * 32 * 2 <= WS_WIN && WS_WIN + 2ull * NIN * 1024 * 2 <= WS_WOUT && WS_F13 + 5632ull * 1024 * 2 <= WS_F2 && WS_F2 + 1024ull * DFF * 2 <= WS_XC, "ws map 1");
static_assert(WS_XC + (size_t)MC * D * 4 <= WS_H && WS_H + (size_t)MT * D * 2 <= WS_OB && WS_OB + (size_t)MT * D * 2 <= WS_G && WS_G + (size_t)MT * D * 2 <= WS_P && WS_P + (size_t)MT * PW * 2 <= WS_END, "ws map 2");
static_assert(WS_ACT0 + (size_t)MT * DFF * 2 <= WS_END && WS_HS + (size_t)HS_ROWS * D * 2 <= WS_ACT && WS_ACT + (size_t)CHUNK_PAN * 256 * DEXP * 2 <= WS_M13 && WS_M13 + 8ull * 7168 * 1024 * 2 <= WS_M2 && WS_M2 + 8ull * 1024 * DEXP * 2 <= WS_END, "ws map 3");
static_assert(WS_MIX + (size_t)MT * D * 2 <= WS_M13, "mix vs moe weights");
constexpr int MO_LAT = 0, MO_CTX = 2 * 16 * 6144, MO_LB = MO_CTX + 2 * 6144;
constexpr size_t RT_SEL = 0, RT_W = 512 * 1024, RT_CNT = 768 * 1024, RT_GW = 1024 * 1024;
constexpr int CW_TMO = 0, CW_CODE = 1, CW_BAR = 4096;
constexpr int RING_BYTES = 131072, LDSCTL_OFF = RING_BYTES, MISC_OFF = LDSCTL_OFF + 320, TAB_OFF = LDSCTL_OFF + 512, LDS_BYTES = 147456;

#define GAS __attribute__((address_space(1)))
#define LAS __attribute__((address_space(3)))
typedef unsigned short bf16;
typedef unsigned v4u __attribute__((ext_vector_type(4)));
typedef unsigned v2u __attribute__((ext_vector_type(2)));
typedef int v4i __attribute__((ext_vector_type(4)));
typedef float f32x4 __attribute__((ext_vector_type(4)));
typedef float f32x2v __attribute__((ext_vector_type(2)));
#define LDS_WAIT() asm volatile("s_waitcnt lgkmcnt(0)" ::: "memory")
#define VM_WAIT() asm volatile("s_waitcnt vmcnt(0)" ::: "memory")
__device__ __forceinline__ unsigned f2bf(float f) { unsigned u = __builtin_bit_cast(unsigned, f); return (u + 0x7fffu + ((u >> 16) & 1u)) >> 16; }
__device__ __forceinline__ unsigned pk2(float lo, float hi) { return f2bf(lo) | (f2bf(hi) << 16); }
__device__ __forceinline__ float bf2f(unsigned b) { return __builtin_bit_cast(float, b << 16); }
__device__ __forceinline__ float bflo(unsigned w) { return __builtin_bit_cast(float, w << 16); }
__device__ __forceinline__ float bfhi(unsigned w) { return __builtin_bit_cast(float, w & 0xffff0000u); }
__device__ __forceinline__ float wave_sum(float v) {
#pragma unroll
    for (int o = 1; o < 64; o <<= 1) v += __shfl_xor(v, o);
    return v;
}
__device__ __forceinline__ float silu_f(float x) { return x / (1.f + __expf(-x)); }
__device__ __forceinline__ float logsig_f(float x) { return fminf(x, 0.f) - __logf(1.f + __expf(-fabsf(x))); }

#define XB_TMO      128
#define XB_XCNT(j)  (256  + 64 * (j))
#define XB_XSUB(j)  (1280 + 64 * (j))
#define XB_XGEN(j)  (2304 + 64 * (j))
#define XB_TOP      3328
#define XB_TOPGEN   3392
#define XCD_BAR_WORDS 3456
#define XB_SPIN_CAP (1u << 18)

__device__ __forceinline__ unsigned xb_ld(unsigned* p)              { return __hip_atomic_load(p, __ATOMIC_RELAXED, __HIP_MEMORY_SCOPE_AGENT); }
__device__ __forceinline__ unsigned xb_add(unsigned* p, unsigned v) { return __hip_atomic_fetch_add(p, v, __ATOMIC_RELAXED, __HIP_MEMORY_SCOPE_AGENT); }
__device__ __forceinline__ unsigned xb_xcc_id() { return (unsigned)__builtin_amdgcn_s_getreg((3 << 11) | 20) & 0xFu; }
#define XB_SPIN(cond, bar) do { unsigned _sp = 0; while (cond) { __builtin_amdgcn_s_sleep(1); \
    if ((++_sp & 255u) == 0u) { if (xb_ld(&(bar)[XB_TMO])) break; if (_sp > XB_SPIN_CAP) { atomicAdd(&(bar)[XB_TMO], 1u); break; } } } } while (0)

struct XcdBarrier {
    unsigned* bar; unsigned x;
    volatile LAS unsigned* st;
};

__device__ __forceinline__ XcdBarrier xcd_barrier_post(unsigned* bar, volatile LAS unsigned* st) {
    XcdBarrier b; b.bar = bar; b.x = xb_xcc_id(); b.st = st;
    if (threadIdx.x == 0) (void)xb_add(&bar[XB_XCNT(b.x)], 1u);
    return b;
}
__device__ __forceinline__ void xcd_barrier_complete(unsigned* bar, unsigned x, unsigned& nloc, unsigned& nx) {
    const unsigned G = gridDim.x * gridDim.y * gridDim.z;
    unsigned sum, cnt, mine, sp = 0u;
    for (;;) {
        sum = 0u; cnt = 0u; mine = 0u;
#pragma unroll
        for (unsigned j = 0; j < 16; ++j) { const unsigned c = xb_ld(&bar[XB_XCNT(j)]); sum += c; cnt += (c > 0u) ? 1u : 0u; mine = (j == x) ? c : mine; }
        if (sum == G) break;
        __builtin_amdgcn_s_sleep(1);
        if ((++sp & 255u) == 0u) { if (xb_ld(&bar[XB_TMO])) break; if (sp > XB_SPIN_CAP) { atomicAdd(&bar[XB_TMO], 1u); break; } }
    }
    nloc = mine > 0u ? mine : 1u; nx = cnt > 0u ? cnt : 1u;
}

__device__ __forceinline__ void xcd_barrier(const XcdBarrier& b) {
    asm volatile("s_waitcnt vmcnt(0)" ::: "memory");
    __syncthreads();
    if (threadIdx.x == 0) {
        unsigned* bar = b.bar;
        __builtin_amdgcn_s_waitcnt(0);
        unsigned nloc = b.st[0], nx = b.st[1];
        if (nloc == 0u) { xcd_barrier_complete(bar, b.x, nloc, nx); b.st[0] = nloc; b.st[1] = nx; }
        const unsigned old = xb_add(&bar[XB_XSUB(b.x)], 1u);
        const unsigned gen = old / nloc;
        if (old + 1u == (gen + 1u) * nloc) {
            __builtin_amdgcn_fence(__ATOMIC_RELEASE, "agent");
            asm volatile("s_waitcnt vmcnt(0)" ::: "memory");
            const unsigned og = xb_add(&bar[XB_TOP], 1u);
            const unsigned tg = og / nx;
            if (og + 1u == (tg + 1u) * nx) xb_add(&bar[XB_TOPGEN], 1u);
            else XB_SPIN(xb_ld(&bar[XB_TOPGEN]) == tg, bar);
            __builtin_amdgcn_fence(__ATOMIC_ACQUIRE, "agent");
            xb_add(&bar[XB_XGEN(b.x)], 1u);
            asm volatile("s_waitcnt vmcnt(0)" ::: "memory");
        } else {
            XB_SPIN(xb_ld(&bar[XB_XGEN(b.x)]) == gen, bar);
            __builtin_amdgcn_fence(__ATOMIC_ACQUIRE, "agent");
            asm volatile("s_waitcnt vmcnt(0)" ::: "memory");
        }
    }
    __syncthreads();
}
using pg8::Unit;
struct EpiInProj {
    static constexpr bool PERM = true, AFTER_DRAIN = false;
    bf16* P; bf16* G; bf16* GR; const float* LB;
    __device__ __forceinline__ void operator()(const pg8::f32x4 (&acc)[2][2][4][2], const Unit& u, int wr, int wc, int fr, int fq) const {
        const int pn = u.pn;
        const int row0 = u.pm * 256 + wr * 64 + fr, cin = wc * 32 + 8 * fq;
        if (pn == 16) {
            if (wc == 0) {
#pragma unroll
                for (int ai = 0; ai < 2; ++ai)
#pragma unroll
                    for (int m = 0; m < 4; ++m) { const pg8::f32x4 v0 = acc[ai][0][m][0], v1 = acc[ai][0][m][1]; v4u w; w.x = pk2(v0[0], v0[1]); w.y = pk2(v0[2], v0[3]); w.z = pk2(v1[0], v1[1]); w.w = pk2(v1[2], v1[3]);
                        *(v4u*)(GR + (size_t)(row0 + ai * 128 + m * 16) * 32 + 8 * fq) = w; }
            }
            return;
        }
        int mode, dcol, dcol2 = 0, ldd = PW; bf16* dst = P; const float* lbp = LB;
        if (pn == 0) { mode = 0; dcol = 0; }
        else if (pn <= 3) { mode = 1; dcol = 256 * pn; }
        else if (pn <= 5) { mode = 1; dst = G; ldd = 1024; dcol = 256 * (pn - 4); }
        else if (pn <= 7) { mode = 2; dcol = 1024 + 256 * (pn - 6); }
        else if (pn <= 9) { mode = 3; dcol = 1536 + 256 * (pn - 8); dcol2 = 2048 + 256 * (pn - 8); lbp = LB + 256 * (pn - 8); }
        else if (pn <= 11) { mode = 3; dcol = 2560 + 256 * (pn - 10); dcol2 = 3072 + 256 * (pn - 10); lbp = LB + 512 + 256 * (pn - 10); }
        else if (pn <= 13) { mode = 1; dcol = 3584 + 256 * (pn - 12); }
        else { mode = 1; dst = G; ldd = 1024; dcol = 512 + 256 * (pn - 14); }
        if (mode == 3) {
#pragma unroll
            for (int bj = 0; bj < 2; ++bj) {
                float lb[8];
#pragma unroll
                for (int j = 0; j < 8; ++j) lb[j] = lbp[bj * 128 + cin + j];
#pragma unroll
                for (int ai = 0; ai < 2; ++ai)
#pragma unroll
                    for (int m = 0; m < 4; ++m) {
                        const pg8::f32x4 v0 = acc[ai][bj][m][0], v1 = acc[ai][bj][m][1];
                        const float a[8] = {v0[0], v0[1], v0[2], v0[3], v1[0], v1[1], v1[2], v1[3]}; float kk[8], lf[8];
#pragma unroll
                        for (int j = 0; j < 8; ++j) { const float e = __expf(-fabsf(a[j])), r = 1.f / (1.f + e), big = r, sml = e * r; const float sg = a[j] >= 0.f ? big : sml, sn = a[j] >= 0.f ? sml : big;
                            kk[j] = (1.f - lb[j]) * sn; lf[j] = __logf(fmaxf(lb[j], 1e-30f) + (1.f - lb[j]) * sg); }
                        const size_t ro = (size_t)(row0 + ai * 128 + m * 16) * PW + bj * 128 + cin;
                        v4u w; w.x = pk2(kk[0], kk[1]); w.y = pk2(kk[2], kk[3]); w.z = pk2(kk[4], kk[5]); w.w = pk2(kk[6], kk[7]); *(v4u*)(P + ro + dcol) = w;
                        v4u x; x.x = pk2(lf[0], lf[1]); x.y = pk2(lf[2], lf[3]); x.z = pk2(lf[4], lf[5]); x.w = pk2(lf[6], lf[7]); *(v4u*)(P + ro + dcol2) = x;
                    }
            }
            return;
        }
#pragma unroll
        for (int ai = 0; ai < 2; ++ai)
#pragma unroll
            for (int m = 0; m < 4; ++m)
#pragma unroll
                for (int bj = 0; bj < 2; ++bj) {
                    const pg8::f32x4 v0 = acc[ai][bj][m][0], v1 = acc[ai][bj][m][1];
                    float a[8] = {v0[0], v0[1], v0[2], v0[3], v1[0], v1[1], v1[2], v1[3]};
                    if (mode == 0) {
#pragma unroll
                        for (int j = 0; j < 8; ++j) a[j] *= 0.125f;
                    } else if (mode == 2) {
#pragma unroll
                        for (int j = 0; j < 8; ++j) a[j] = silu_f(a[j]);
                    }
                    v4u w; w.x = pk2(a[0], a[1]); w.y = pk2(a[2], a[3]); w.z = pk2(a[4], a[5]); w.w = pk2(a[6], a[7]);
                    *(v4u*)(dst + (size_t)(row0 + ai * 128 + m * 16) * ldd + dcol + bj * 128 + cin) = w;
                }
    }
};
struct EpiResid {
    static constexpr bool PERM = false, AFTER_DRAIN = false;
    const float* base_lat; const float* base_ctx; float* out_lat; float* out_ctx; const float* gate_lat; const float* gate_ctx;
    __device__ __forceinline__ void operator()(const pg8::f32x4 (&acc)[2][2][4][2], const Unit& u, int wr, int wc, int fr, int fq) const {
        const int prow = u.pm * 256; const float* base; float* out; const float* gate; int r0;
        if (prow < ML) { base = base_lat; out = out_lat; gate = gate_lat + (prow >> 11) * 6144; r0 = prow; }
        else { base = base_ctx; out = out_ctx; gate = gate_ctx; r0 = prow - ML; }
        const int row0 = r0 + wr * 64 + fr, col0 = u.pn * 256 + wc * 32 + 4 * fq;
        pg8::f32x4 gv[2][2];
#pragma unroll
        for (int bj = 0; bj < 2; ++bj)
#pragma unroll
            for (int n = 0; n < 2; ++n) gv[bj][n] = *(const pg8::f32x4*)(gate + col0 + bj * 128 + n * 16);
#pragma unroll
        for (int ai = 0; ai < 2; ++ai)
#pragma unroll
            for (int m = 0; m < 4; ++m) { const size_t off = (size_t)(row0 + ai * 128 + m * 16) * D + col0;
#pragma unroll
                for (int bj = 0; bj < 2; ++bj)
#pragma unroll
                    for (int n = 0; n < 2; ++n) { const pg8::f32x4 bs = *(const pg8::f32x4*)(base + off + bj * 128 + n * 16); *(pg8::f32x4*)(out + off + bj * 128 + n * 16) = bs + gv[bj][n] * acc[ai][bj][m][n]; }
                asm volatile("" ::: "memory"); }
    }
};
struct EpiSwiGLU {
    static constexpr bool PERM = true, AFTER_DRAIN = false;
    bf16* ACT; int ldc, tiles, pm_off;
    __device__ __forceinline__ void operator()(const pg8::f32x4 (&acc)[2][2][4][2], const Unit& u, int wr, int wc, int fr, int fq) const {
        const int row0 = (u.pm - pm_off) * 256 + wr * 64 + fr, col0 = (u.pn % tiles) * 128 + wc * 32 + 8 * fq;
#pragma unroll
        for (int ai = 0; ai < 2; ++ai)
#pragma unroll
            for (int m = 0; m < 4; ++m) {
                const pg8::f32x4 g0 = acc[ai][0][m][0], g1 = acc[ai][0][m][1], u0 = acc[ai][1][m][0], u1 = acc[ai][1][m][1];
                float o[8];
#pragma unroll
                for (int j = 0; j < 4; ++j) { o[j] = silu_f(g0[j]) * u0[j]; o[4 + j] = silu_f(g1[j]) * u1[j]; }
                v4u w; w.x = pk2(o[0], o[1]); w.y = pk2(o[2], o[3]); w.z = pk2(o[4], o[5]); w.w = pk2(o[6], o[7]);
                *(v4u*)(ACT + (size_t)(row0 + ai * 128 + m * 16) * ldc + col0) = w;
            }
    }
};
struct EpiMoeOut {
    static constexpr bool PERM = true, AFTER_DRAIN = false;
    bf16* Y; const float* GW; int pm_off;
    __device__ __forceinline__ void operator()(const pg8::f32x4 (&acc)[2][2][4][2], const Unit& u, int wr, int wc, int fr, int fq) const {
        const int row0 = (u.pm + pm_off) * 256 + wr * 64 + fr, col0 = (u.pn & 3) * 256 + wc * 32 + 8 * fq;
#pragma unroll
        for (int ai = 0; ai < 2; ++ai)
#pragma unroll
            for (int m = 0; m < 4; ++m) { const int row = row0 + ai * 128 + m * 16; const float gw = GW[row];
#pragma unroll
                for (int bj = 0; bj < 2; ++bj) { const pg8::f32x4 v0 = acc[ai][bj][m][0] * gw, v1 = acc[ai][bj][m][1] * gw;
                    v4u w; w.x = pk2(v0[0], v0[1]); w.y = pk2(v0[2], v0[3]); w.z = pk2(v1[0], v1[1]); w.w = pk2(v1[2], v1[3]);
                    *(v4u*)(Y + (size_t)row * D + col0 + bj * 128) = w; } }
    }
};
struct MoeOrder {
    int nM, nN, nwg, G, c, pan0, a_local; int pb[8];
    __device__ __forceinline__ void init(int nM_, int nN_, int G_, int c_, int pan0_, int a_local_) { nM = nM_; nN = nN_; nwg = nM * nN; G = G_; c = c_; pan0 = pan0_; a_local = a_local_; }
    __device__ __forceinline__ bool next(int i, Unit& u) const {
        const long L = (long)i * G + c; if (L >= nwg) return false;
        int wgid = (int)L; { const int q = nwg / 8, r = nwg % 8, xcd = wgid % 8, off = wgid / 8; wgid = (xcd < r ? xcd * (q + 1) : r * (q + 1) + (xcd - r) * q) + off; }
        const int nig = 8 * nN, gid = wgid / nig, fm = gid * 8, gsz = (nM - fm) < 8 ? (nM - fm) : 8;
        const int pml = fm + ((wgid % nig) % gsz), pnl = (wgid % nig) / gsz, gp = pan0 + pml;
        int e = 0;
#pragma unroll
        for (int j = 1; j < 8; ++j) e += (gp >= pb[j]) ? 1 : 0;
        u.pm = a_local ? pml : gp; u.pn = e * nN + pnl; return true;
    }
    __device__ __forceinline__ void a_ready(const Unit&) const {}
    __device__ __forceinline__ void done(const Unit&) const {}
};

struct Args { const float* in[23]; float* out; unsigned char* ws; int ph_lo, ph_hi; };
typedef const __attribute__((address_space(4))) Args* KA;
__device__ __forceinline__ KA kargs() { KA p = (KA)__builtin_amdgcn_kernarg_segment_ptr(); asm volatile("" : "+s"(p)); return p; }
enum { I_X = 0, I_C, I_CTX, I_CCTX, I_WMOD, I_BMOD, I_N1G, I_N2G, I_WIN, I_GW2, I_GB, I_GLAG, I_HGG, I_HLB, I_WOUT, I_F1, I_F3, I_F2, I_ROUTER, I_M1, I_M3, I_M2, I_FNG };

__device__ __forceinline__ void tr_block(const float* W, int ldw, int col0, int k0, bf16* WT, int K, int drow0, LAS float* scr, int lane) {
#pragma unroll 8
    for (int i = 0; i < 32; ++i) { const int kk = 2 * i + (lane >> 5); scr[kk * 33 + (lane & 31)] = W[(size_t)(k0 + kk) * ldw + col0 + (lane & 31)]; }
    LDS_WAIT(); asm volatile("" ::: "memory");
    const int c = lane & 7;
#pragma unroll
    for (int j = 0; j < 4; ++j) { const int n = (lane >> 3) + 8 * j; const LAS float* s = scr + (8 * c) * 33 + n;
        v4u o; o.x = pk2(s[0 * 33], s[1 * 33]); o.y = pk2(s[2 * 33], s[3 * 33]); o.z = pk2(s[4 * 33], s[5 * 33]); o.w = pk2(s[6 * 33], s[7 * 33]);
        *(v4u*)(WT + (size_t)(drow0 + n) * K + k0 + 8 * c) = o; }
    LDS_WAIT(); asm volatile("" ::: "memory");
}
constexpr int NI_WIN = 2 * 16 * 129, NI_WOUT = 2 * 16 * 32, NI_F13 = 16 * 176, NI_F2 = 44 * 32, NI_MAIN = NI_WIN + NI_WOUT + NI_F13 + NI_F2;
constexpr int NI_M13E = 16 * 224, NI_M2E = 56 * 32, NI_M13 = 8 * NI_M13E, NI_MOE = NI_M13 + 8 * NI_M2E;
__device__ __forceinline__ void conv_item_main(KA a, int it, LAS float* scr, int lane) {
    unsigned char* ws = a->ws;
    if (it < NI_WIN) { const int l = it / 2064, r = it % 2064, kb = r / 129, nb = r % 129, drow = nb < 48 ? 32 * nb : (nb == 48 ? 4096 : 32 * (nb - 1));
        tr_block(a->in[I_WIN] + (size_t)l * 1024 * INW, INW, 32 * nb, 64 * kb, (bf16*)(ws + WS_WIN) + (size_t)l * NIN * 1024, 1024, drow, scr, lane); return; }
    it -= NI_WIN;
    if (it < NI_WOUT) { const int l = it / 512, r = it % 512, kb = r / 32, nb = r % 32;
        tr_block(a->in[I_WOUT] + (size_t)l * 1024 * 1024, 1024, 32 * nb, 64 * kb, (bf16*)(ws + WS_WOUT) + (size_t)l * 1024 * 1024, 1024, 32 * nb, scr, lane); return; }
    it -= NI_WOUT;
    if (it < NI_F13) { const int kb = it / 176, db = it % 176, drow = 32 * db, pn = drow >> 8, half = (drow >> 7) & 1, off = drow & 127;
        tr_block(half ? a->in[I_F3] : a->in[I_F1], DFF, 128 * pn + off, 64 * kb, (bf16*)(ws + WS_F13), 1024, drow, scr, lane); return; }
    it -= NI_F13;
    { const int kb = it / 32, nb = it % 32; tr_block(a->in[I_F2], 1024, 32 * nb, 64 * kb, (bf16*)(ws + WS_F2), DFF, 32 * nb, scr, lane); }
}
__device__ __forceinline__ void conv_item_moe(KA a, int it, LAS float* scr, int lane) {
    unsigned char* ws = a->ws;
    if (it < NI_M13) { const int e = it / NI_M13E, r = it % NI_M13E, kb = r / 224, db = r % 224, drow = 32 * db, pn = drow >> 8, half = (drow >> 7) & 1, off = drow & 127;
        tr_block((half ? a->in[I_M3] : a->in[I_M1]) + (size_t)e * 1024 * DEXP, DEXP, 128 * pn + off, 64 * kb, (bf16*)(ws + WS_M13) + (size_t)e * 7168 * 1024, 1024, drow, scr, lane); return; }
    it -= NI_M13;
    { const int e = it / NI_M2E, r = it % NI_M2E, kb = r / 32, nb = r % 32;
      tr_block(a->in[I_M2] + (size_t)e * DEXP * 1024, 1024, 32 * nb, 64 * kb, (bf16*)(ws + WS_M2) + (size_t)e * 1024 * DEXP, DEXP, 32 * nb, scr, lane); }
}
__device__ __forceinline__ void mod_item(KA a, int it, LAS unsigned char* lds, int tid, int lane, int wave) {
    LAS float* sc = (LAS float*)lds; LAS float* red = (LAS float*)(lds + 69632);
    const int l = it / 96, n0 = 64 * (it % 96);
    for (int idx = tid; idx < 17 * 1024; idx += NTHR) { const int r = idx >> 10, k = idx & 1023; const float v = r < 16 ? a->in[I_C][r * 1024 + k] : a->in[I_CCTX][k]; sc[k * 17 + r] = silu_f(v); }
    __syncthreads();
    float acc[17];
#pragma unroll
    for (int r = 0; r < 17; ++r) acc[r] = 0.f;
    const float* wm = a->in[I_WMOD] + (size_t)l * 1024 * 6144 + n0 + lane;
    for (int k = wave * 128; k < wave * 128 + 128; ++k) { const float w = wm[(size_t)k * 6144];
#pragma unroll
        for (int r = 0; r < 17; ++r) acc[r] += sc[k * 17 + r] * w; }
#pragma unroll
    for (int r = 0; r < 17; ++r) red[(wave * 17 + r) * 64 + lane] = acc[r];
    __syncthreads();
    float* mods = (float*)(a->ws + WS_MODS);
    for (int idx = tid; idx < 17 * 64; idx += NTHR) { const int r = idx >> 6, ln = idx & 63; float s = a->in[I_BMOD][l * 6144 + n0 + ln];
#pragma unroll
        for (int w = 0; w < 8; ++w) s += red[(w * 17 + r) * 64 + ln];
        if (r < 16) mods[MO_LAT + (l * 16 + r) * 6144 + n0 + ln] = s; else mods[MO_CTX + l * 6144 + n0 + ln] = s; }
    __syncthreads();
}
__device__ __forceinline__ void ada_norm_row(const float* xrow, bf16* orow, const float* g, const float* shift, const float* scale, int lane, f32x4 (&y)[4]) {
    const f32x4* xr = (const f32x4*)xrow + lane; float s = 0.f;
#pragma unroll
    for (int j = 0; j < 4; ++j) { y[j] = xr[64 * j]; s += (y[j].x * y[j].x + y[j].y * y[j].y) + (y[j].z * y[j].z + y[j].w * y[j].w); }
    const float rstd = rsqrtf(wave_sum(s) * (1.f / D) + EPS);
    v2u* o8 = (v2u*)orow + lane;
#pragma unroll
    for (int j = 0; j < 4; ++j) { const f32x4 gv = ((const f32x4*)g)[lane + 64 * j], sh = ((const f32x4*)shift)[lane + 64 * j], sc = ((const f32x4*)scale)[lane + 64 * j];
        y[j] = y[j] * rstd * gv * (sc + 1.f) + sh; v2u w; w.x = pk2(y[j].x, y[j].y); w.y = pk2(y[j].z, y[j].w); o8[64 * j] = w; }
}
__device__ __forceinline__ int scan_row(int grp, int b, int dir, int step) {
    if (step < CTXL) { const int t = dir ? (CTXL - 1 - step) : step; return ML + b * CTXL + t; }
    int lp = step - CTXL; if (dir) lp = SEQ - 1 - lp;
    const int t = grp ? ((lp & 31) * 64 + (lp >> 5)) : lp;
    return b * SEQ + t;
}
template <int DK> __device__ __forceinline__ void scan_simple(LAS unsigned char* lds, const bf16* P, const bf16* GR, const float* w2, const float* gb, bf16* OUT, int grp, int b, int hd, int dir, int tid) {
    LAS float* qs = (LAS float*)lds; LAS float* ks = qs + 32 * 128; LAS float* fs = ks + 32 * 128; LAS float* vs = fs + 32 * 128; LAS float* red = vs + 32 * 128;
    const int j = tid & 127, cg = tid >> 7; constexpr int CPT = DK / 4;
    float st[CPT];
#pragma unroll
    for (int i = 0; i < CPT; ++i) st[i] = 0.f;
    for (int blk = 0; blk < (CTXL + SEQ) / 32; ++blk) {
        for (int idx = tid; idx < 32 * DK; idx += NTHR) { const int t = idx / DK, c = idx % DK, row = scan_row(grp, b, dir, blk * 32 + t); const bf16* pr = P + (size_t)row * PW; float q, k, lf;
            if (DK == 64) { q = bf2f(pr[hd * 64 + c]); k = bf2f(pr[256 + hd * 64 + c]); float lg = gb[hd * 64 + c]; const bf16* gr = GR + (size_t)row * 32 + dir * 16;
#pragma unroll
                for (int r = 0; r < 16; ++r) lg += bf2f(gr[r]) * w2[r * 256 + hd * 64 + c];
                lf = logsig_f(lg) * (1.f / 16.f); }
            else { q = bf2f(pr[1024 + hd * 128 + c]); k = bf2f(pr[(dir ? 2560 : 1536) + hd * 128 + c]); lf = bf2f(pr[(dir ? 3072 : 2048) + hd * 128 + c]); }
            qs[t * 128 + c] = q; ks[t * 128 + c] = k; fs[t * 128 + c] = __expf(lf); }
        for (int idx = tid; idx < 32 * 128; idx += NTHR) { const int t = idx >> 7, jj = idx & 127, row = scan_row(grp, b, dir, blk * 32 + t); vs[idx] = bf2f(P[(size_t)row * PW + (DK == 64 ? 512 : 3584) + hd * 128 + jj]); }
        __syncthreads();
        for (int t = 0; t < 32; ++t) { const float vv = vs[t * 128 + j]; float acc = 0.f;
#pragma unroll
            for (int i = 0; i < CPT; ++i) { const int c = cg * CPT + i; st[i] = st[i] * fs[t * 128 + c] + ks[t * 128 + c] * vv; acc += st[i] * qs[t * 128 + c]; }
            red[(t * 4 + cg) * 128 + j] = acc; }
        __syncthreads();
        for (int idx = tid; idx < 4096; idx += NTHR) { const int t = idx >> 7, jj = idx & 127, row = scan_row(grp, b, dir, blk * 32 + t);
            const float o = (red[(t * 4 + 0) * 128 + jj] + red[(t * 4 + 1) * 128 + jj]) + (red[(t * 4 + 2) * 128 + jj] + red[(t * 4 + 3) * 128 + jj]);
            OUT[(size_t)row * D + grp * 512 + hd * 128 + jj] = (bf16)f2bf(o); }
        __syncthreads();
    }
}
__device__ __forceinline__ void mix_row(const bf16* of, const bf16* ob, const bf16* gate, const float* gla_g, const float* hg_g, bf16* out, int lane) {
    const v4u* pf = (const v4u*)of + 2 * lane; const v4u* pb = (const v4u*)ob + 2 * lane; const v4u* pg = (const v4u*)gate + 2 * lane;
    const v4u f0 = pf[0], f1 = pf[1], b0 = pb[0], b1 = pb[1], g0 = pg[0], g1 = pg[1];
    const unsigned fw[8] = {f0.x, f0.y, f0.z, f0.w, f1.x, f1.y, f1.z, f1.w}, bw[8] = {b0.x, b0.y, b0.z, b0.w, b1.x, b1.y, b1.z, b1.w}, gw[8] = {g0.x, g0.y, g0.z, g0.w, g1.x, g1.y, g1.z, g1.w};
    float o[16]; float ss = 0.f;
#pragma unroll
    for (int i = 0; i < 8; ++i) { o[2 * i] = bflo(fw[i]) + bflo(bw[i]); o[2 * i + 1] = bfhi(fw[i]) + bfhi(bw[i]); ss += o[2 * i] * o[2 * i] + o[2 * i + 1] * o[2 * i + 1]; }
    ss += __shfl_xor(ss, 1); ss += __shfl_xor(ss, 2); ss += __shfl_xor(ss, 4);
    const float rstd = rsqrtf(ss * (1.f / 128.f) + EPS);
    const float* ng = ((lane >> 5) ? hg_g : gla_g) + (lane & 7) * 16;
    unsigned w[8];
#pragma unroll
    for (int i = 0; i < 8; ++i) { const float a = o[2 * i] * rstd * ng[2 * i] * silu_f(bflo(gw[i])), c = o[2 * i + 1] * rstd * ng[2 * i + 1] * silu_f(bfhi(gw[i])); w[i] = pk2(a, c); }
    v4u* po = (v4u*)out + 2 * lane; po[0] = (v4u){w[0], w[1], w[2], w[3]}; po[1] = (v4u){w[4], w[5], w[6], w[7]};
}
__device__ __forceinline__ void moe_tab(KA a, LAS unsigned char* lds, int tid, int wg) {
    LAS int* tab = (LAS int*)(lds + TAB_OFF);
    if (tid < 32) tab[tid] = 0;
    __syncthreads();
    if (tid < 256) { const v4i* cp = (const v4i*)(a->ws + WS_ROUTE + RT_CNT) + 2 * tid; const v4i c0 = cp[0], c1 = cp[1]; const int c[8] = {c0.x, c0.y, c0.z, c0.w, c1.x, c1.y, c1.z, c1.w};
#pragma unroll
        for (int e = 0; e < 8; ++e) { __hip_atomic_fetch_add(&tab[e], c[e], __ATOMIC_RELAXED, __HIP_MEMORY_SCOPE_WORKGROUP); if (tid < wg) __hip_atomic_fetch_add(&tab[8 + e], c[e], __ATOMIC_RELAXED, __HIP_MEMORY_SCOPE_WORKGROUP); } }
    __syncthreads();
    if (tid == 0) { int pb = 0; for (int e = 0; e < 8; ++e) { tab[16 + e] = pb; pb += (tab[e] + 255) >> 8; } tab[24] = pb; }
    __syncthreads();
}

__global__ void __launch_bounds__(NTHR, 2) fwd_kernel(Args args) {
    extern __shared__ __attribute__((aligned(16))) unsigned char lds_raw[];
    LAS unsigned char* lds = (LAS unsigned char*)lds_raw;
    {   const int t0 = threadIdx.x;
        for (int u = t0; u < (LDS_BYTES - LDSCTL_OFF) / 4; u += NTHR) ((LAS unsigned*)(lds + LDSCTL_OFF))[u] = 0u;
        __syncthreads();
        (void)xcd_barrier_post((unsigned*)(kargs()->ws + WS_CTL) + CW_BAR, (volatile LAS unsigned*)(lds + MISC_OFF) + 8); }
#define IN(k) (kargs()->ph_lo <= (k) && (k) < kargs()->ph_hi)
#define BAR(k) do { if (IN(k) && IN((k) + 1)) { XcdBarrier bar_; bar_.bar = (unsigned*)(kargs()->ws + WS_CTL) + CW_BAR; bar_.x = xb_xcc_id(); bar_.st = (volatile LAS unsigned*)(lds + MISC_OFF) + 8; xcd_barrier(bar_); } } while (0)
#define PH_VIEW() KA A = kargs(); unsigned char* ws = A->ws; float* mods = (float*)(ws + WS_MODS); bf16* Hb = (bf16*)(ws + WS_H); bf16* OBb = (bf16*)(ws + WS_OB); bf16* Gb = (bf16*)(ws + WS_G); bf16* Pb = (bf16*)(ws + WS_P); \
    bf16* GRb = (bf16*)(ws + WS_GR); bf16* MIXb = (bf16*)(ws + WS_MIX); float* XC = (float*)(ws + WS_XC); float* XL = A->out; (void)mods; (void)Hb; (void)OBb; (void)Gb; (void)Pb; (void)GRb; (void)MIXb; (void)XC; (void)XL; \
    int tid = threadIdx.x; asm volatile("" : "+v"(tid)); const int lane = tid & 63, wave = __builtin_amdgcn_readfirstlane(tid >> 6), wg = blockIdx.x, G = gridDim.x, gw = wg * NWAVES + wave, NGW = G * NWAVES; \
    (void)lane; (void)wave; (void)wg; (void)G; (void)gw; (void)NGW
#define LAYER_VIEW() const float* xlat = l ? (const float*)XL : A->in[I_X]; const float* xctx = l ? (const float*)XC : A->in[I_CTX]; \
    const float* mlat = mods + MO_LAT + l * 16 * 6144; const float* mctx = mods + MO_CTX + l * 6144; (void)xlat; (void)xctx; (void)mlat; (void)mctx
    LAS int* tab = (LAS int*)(lds + TAB_OFF);

    if (IN(0)) { PH_VIEW();
        LAS float* scr = (LAS float*)(lds + wave * 16384);
        for (int it = gw; it < NI_MAIN; it += NGW) conv_item_main(A, it, scr, lane);
        for (int i = wg * NTHR + tid; i < 2 * 28672; i += G * NTHR) { const int l = i / 28672, r = i % 28672; ((v4u*)((bf16*)(ws + WS_WIN) + ((size_t)l * NIN + 4128) * 1024))[r] = (v4u){0u, 0u, 0u, 0u}; }
        __syncthreads();
        for (int it = wg; it < 192; it += G) mod_item(A, it, lds, tid, lane, wave);
        if (wg == G - 1) for (int i = tid; i < 1024; i += NTHR) { const int d = i >> 9, ch = i & 511; const float a0 = A->in[I_HLB][d * 512 + ch], a1 = A->in[I_HLB][(2 + d) * 512 + ch];
            mods[MO_LB + d * 512 + ch] = 0.f; mods[MO_LB + 1024 + d * 512 + ch] = 1.f / (1.f + __expf(a0 - a1)); }
    }
    BAR(0);
#pragma nounroll
    for (int l = 0; l < 2; ++l) {
        const int pb = l ? 9 : 1;
        if (IN(pb)) { PH_VIEW(); LAYER_VIEW();
            for (int m = gw; m < MT; m += NGW) { f32x4 y[4]; const bool lat = m < ML; const float* md = lat ? mlat + (m >> 11) * 6144 : mctx;
                ada_norm_row(lat ? xlat + (size_t)m * D : xctx + (size_t)(m - ML) * D, Hb + (size_t)m * D, A->in[I_N1G] + l * D, md, md + 1024, lane, y); }
        }
        BAR(pb);
        if (IN(pb + 1)) { PH_VIEW(); LAYER_VIEW();
            pg8::Gemm g{Hb, (const bf16*)(ws + WS_WIN) + (size_t)l * NIN * 1024, MT, NIN, D}; pg8::StaticOrder S; S.init(MT, NIN, G, wg);
            EpiInProj E{Pb, Gb, GRb, mods + MO_LB + l * 1024};
            pg8::gemm_phase<EpiInProj, pg8::StaticOrder, true, true>(lds, g, S, E);
        }
        BAR(pb + 1);
        if (IN(pb + 2)) { PH_VIEW(); LAYER_VIEW();
            for (int s = wg; s < 256; s += G) { const int grp = s >> 7, r = s & 127, b = r >> 3, hd = (r >> 1) & 3, dir = r & 1;
                bf16* OUT = dir ? OBb : Hb;
                const float* w2 = A->in[I_GW2] + (size_t)(l * 2 + dir) * 16 * 256; const float* gb = A->in[I_GB] + (l * 2 + dir) * 256;
                if (grp == 0) scan_simple<64>(lds, Pb, GRb, w2, gb, OUT, grp, b, hd, dir, tid); else scan_simple<128>(lds, Pb, GRb, w2, gb, OUT, grp, b, hd, dir, tid); }
        }
        BAR(pb + 2);
        if (IN(pb + 3)) { PH_VIEW(); LAYER_VIEW();
            const int nrow = l ? ML : MT;
            for (int m = gw; m < nrow; m += NGW) mix_row(Hb + (size_t)m * D, OBb + (size_t)m * D, Gb + (size_t)m * D, A->in[I_GLAG] + l * 128, A->in[I_HGG] + l * 128, MIXb + (size_t)m * D, lane);
            if (l == 1) { LAS float* scr = (LAS float*)(lds + wave * 16384); for (int it = gw; it < NI_MOE; it += NGW) conv_item_moe(A, it, scr, lane); }
        }
        BAR(pb + 3);
        if (IN(pb + 4)) { PH_VIEW(); LAYER_VIEW();
            const int Mw = l ? ML : MT;
            pg8::Gemm g{MIXb, (const bf16*)(ws + WS_WOUT) + (size_t)l * 1024 * 1024, Mw, D, D}; pg8::StaticOrder S; S.init(Mw, D, G, wg);
            EpiResid E{xlat, xctx, XL, XC, mlat + 2048, mctx + 2048};
            pg8::gemm_phase<EpiResid, pg8::StaticOrder, true, true>(lds, g, S, E);
        }
        BAR(pb + 4);
        if (l == 0) {
            if (IN(6)) { PH_VIEW(); LAYER_VIEW();
                for (int m = gw; m < MT; m += NGW) { f32x4 y[4]; const bool lat = m < ML; const float* md = lat ? mlat + (m >> 11) * 6144 : mctx;
                    ada_norm_row(lat ? XL + (size_t)m * D : XC + (size_t)(m - ML) * D, Hb + (size_t)m * D, A->in[I_N2G], md + 3072, md + 4096, lane, y); }
            }
            BAR(6);
            if (IN(7)) { PH_VIEW(); LAYER_VIEW();
                pg8::Gemm g{Hb, (const bf16*)(ws + WS_F13), MT, 2 * DFF, D}; pg8::StaticOrder S; S.init(MT, 2 * DFF, G, wg);
                EpiSwiGLU E{(bf16*)(ws + WS_ACT0), DFF, 22, 0};
                pg8::gemm_phase<EpiSwiGLU, pg8::StaticOrder, true, true>(lds, g, S, E);
            }
            BAR(7);
            if (IN(8)) { PH_VIEW(); LAYER_VIEW();
                pg8::Gemm g{(const bf16*)(ws + WS_ACT0), (const bf16*)(ws + WS_F2), MT, D, DFF}; pg8::StaticOrder S; S.init(MT, D, G, wg);
                EpiResid E{XL, XC, XL, XC, mlat + 5120, mctx + 5120};
                pg8::gemm_phase<EpiResid, pg8::StaticOrder, true, true>(lds, g, S, E);
            }
            BAR(8);
        }
    }
    if (IN(14)) { PH_VIEW(); const float* mlat1 = mods + MO_LAT + 16 * 6144;
        LAS float* rt = (LAS float*)lds; LAS int* sE = (LAS int*)(lds + 32768); LAS float* sW = (LAS float*)(lds + 32768 + 1024); LAS int* sL = (LAS int*)(lds + 32768 + 2048);
        for (int idx = tid; idx < 8192; idx += NTHR) { const int k = idx >> 3, e = idx & 7; rt[e * 1024 + k] = A->in[I_ROUTER][idx]; }
        __syncthreads();
        for (int rr = 0; rr < 16; ++rr) { const int tl = wave * 16 + rr, row = wg * 128 + tl; f32x4 y[4]; const float* md = mlat1 + (row >> 11) * 6144;
            ada_norm_row(XL + (size_t)row * D, Hb + (size_t)row * D, A->in[I_N2G] + D, md + 3072, md + 4096, lane, y);
            float lg[8];
#pragma unroll
            for (int e = 0; e < 8; ++e) { float p = 0.f;
#pragma unroll
                for (int j = 0; j < 4; ++j) { const f32x4 r4 = ((const LAS f32x4*)(rt + e * 1024))[lane + 64 * j]; p += (y[j].x * r4.x + y[j].y * r4.y) + (y[j].z * r4.z + y[j].w * r4.w); }
                lg[e] = wave_sum(p); }
            int i0 = 0; float v0 = lg[0];
#pragma unroll
            for (int e = 1; e < 8; ++e) if (lg[e] > v0) { v0 = lg[e]; i0 = e; }
            int i1 = -1; float v1 = -3.0e38f;
#pragma unroll
            for (int e = 0; e < 8; ++e) if (e != i0 && lg[e] > v1) { v1 = lg[e]; i1 = e; }
            const float w0 = 1.f / (1.f + __expf(v1 - v0));
            if (lane == 0) { sE[2 * tl] = i0; sE[2 * tl + 1] = i1; sW[2 * tl] = w0; sW[2 * tl + 1] = 1.f - w0; } }
        __syncthreads();
        if (tid < 8) { int cnt = 0; for (int t = 0; t < 256; ++t) if (sE[t] == tid) sL[t] = cnt++; ((int*)(ws + WS_ROUTE + RT_CNT))[wg * 8 + tid] = cnt; }
        __syncthreads();
        if (tid < 128) { const int row = wg * 128 + tid; ((v4i*)(ws + WS_ROUTE + RT_SEL))[row] = (v4i){sE[2 * tid], sE[2 * tid + 1], sL[2 * tid], sL[2 * tid + 1]};
            ((f32x2v*)(ws + WS_ROUTE + RT_W))[row] = (f32x2v){sW[2 * tid], sW[2 * tid + 1]}; }
    }
    BAR(14);
    if (kargs()->ph_lo >= 16 && kargs()->ph_lo <= 26) moe_tab(kargs(), lds, threadIdx.x, blockIdx.x);
    if (IN(15)) { PH_VIEW();
        moe_tab(kargs(), lds, tid, wg);
        for (int t = wave; t < 128; t += NWAVES) { const int row = wg * 128 + t; v4i* selp = (v4i*)(ws + WS_ROUTE + RT_SEL) + row; const v4i sel = *selp; const f32x2v w = ((const f32x2v*)(ws + WS_ROUTE + RT_W))[row];
            const int s0 = tab[16 + sel.x] * 256 + tab[8 + sel.x] + sel.z, s1 = tab[16 + sel.y] * 256 + tab[8 + sel.y] + sel.w;
            const v4u* src = (const v4u*)(Hb + (size_t)row * D) + 2 * lane; const v4u a0 = src[0], a1 = src[1];
            v4u* d0 = (v4u*)((bf16*)(ws + WS_HS) + (size_t)s0 * D) + 2 * lane; d0[0] = a0; d0[1] = a1;
            v4u* d1 = (v4u*)((bf16*)(ws + WS_HS) + (size_t)s1 * D) + 2 * lane; d1[0] = a0; d1[1] = a1;
            if (lane == 0) { float* gwp = (float*)(ws + WS_ROUTE + RT_GW); gwp[s0] = w.x; gwp[s1] = w.y; *selp = (v4i){sel.x, sel.y, s0, s1}; } }
    }
    BAR(15);
#pragma nounroll
    for (int c = 0; c < 5; ++c) {
        const int TP = tab[24], pan0 = CHUNK_PAN * c; int nM = TP - pan0; nM = nM > CHUNK_PAN ? CHUNK_PAN : nM;
        if (IN(16 + 2 * c) && nM > 0) { PH_VIEW();
            pg8::Gemm g{(const bf16*)(ws + WS_HS), (const bf16*)(ws + WS_M13), 0, 0, D}; MoeOrder S; S.init(nM, 28, G, wg, pan0, 0);
#pragma unroll
            for (int e = 0; e < 8; ++e) S.pb[e] = __builtin_amdgcn_readfirstlane(tab[16 + e]);
            EpiSwiGLU E{(bf16*)(ws + WS_ACT), DEXP, 28, pan0};
            pg8::gemm_phase<EpiSwiGLU, MoeOrder, true, true>(lds, g, S, E);
        }
        BAR(16 + 2 * c);
        if (IN(17 + 2 * c) && nM > 0) { PH_VIEW();
            pg8::Gemm g{(const bf16*)(ws + WS_ACT), (const bf16*)(ws + WS_M2), 0, 0, DEXP}; MoeOrder S; S.init(nM, 4, G, wg, pan0, 1);
#pragma unroll
            for (int e = 0; e < 8; ++e) S.pb[e] = __builtin_amdgcn_readfirstlane(tab[16 + e]);
            EpiMoeOut E{(bf16*)(ws + WS_HS), (const float*)(ws + WS_ROUTE + RT_GW), pan0};
            pg8::gemm_phase<EpiMoeOut, MoeOrder, true, true>(lds, g, S, E);
        }
        BAR(17 + 2 * c);
    }
    if (IN(26)) { PH_VIEW(); const float* mlat1 = mods + MO_LAT + 16 * 6144;
        unsigned bad = __hip_atomic_load((unsigned*)(ws + WS_CTL) + CW_BAR + XB_TMO, __ATOMIC_RELAXED, __HIP_MEMORY_SCOPE_AGENT);
        const bf16* Y = (const bf16*)(ws + WS_HS);
        for (int m = gw; m < ML; m += NGW) { const v4i sel = ((const v4i*)(ws + WS_ROUTE + RT_SEL))[m]; const float* md = mlat1 + (m >> 11) * 6144 + 5120;
            f32x4* xr = (f32x4*)(XL + (size_t)m * D) + lane; const v2u* y0 = (const v2u*)(Y + (size_t)sel.z * D) + lane; const v2u* y1 = (const v2u*)(Y + (size_t)sel.w * D) + lane;
            f32x4 v[4]; float s = 0.f;
#pragma unroll
            for (int j = 0; j < 4; ++j) { const f32x4 x = xr[64 * j], gt = ((const f32x4*)md)[lane + 64 * j]; const v2u a = y0[64 * j], b = y1[64 * j];
                const f32x4 yy = {bflo(a.x) + bflo(b.x), bfhi(a.x) + bfhi(b.x), bflo(a.y) + bflo(b.y), bfhi(a.y) + bfhi(b.y)};
                v[j] = x + gt * yy; s += (v[j].x * v[j].x + v[j].y * v[j].y) + (v[j].z * v[j].z + v[j].w * v[j].w); }
            const float rstd = rsqrtf(wave_sum(s) * (1.f / D) + EPS);
#pragma unroll
            for (int j = 0; j < 4; ++j) { f32x4 o = v[j] * rstd * ((const f32x4*)A->in[I_FNG])[lane + 64 * j]; if (bad) o = (f32x4){__builtin_nanf(""), __builtin_nanf(""), __builtin_nanf(""), __builtin_nanf("")}; xr[64 * j] = o; } }
    }
#undef IN
#undef BAR
}

extern "C" void kernel_launch(void* const* d_in, const int* in_sizes, int n_in, void* d_out, int out_size, void* d_ws, size_t ws_size, hipStream_t stream) {
    static int grid = 0;
    if (grid == 0) {
        if (n_in != 23 || in_sizes[0] != ML * D || out_size != ML * D || ws_size < WS_END) { fprintf(stderr, "kernel_launch: unexpected shapes (n_in %d, in0 %d, out %d, ws %zu, need %zu); nothing launched\n", n_in, n_in > 0 ? in_sizes[0] : -1, out_size, ws_size, (size_t)WS_END); grid = -1; return; }
        int dev = 0, cus = 0, per_cu = 0;
        if (hipGetDevice(&dev) != hipSuccess || hipDeviceGetAttribute(&cus, hipDeviceAttributeMultiprocessorCount, dev) != hipSuccess) { grid = -1; return; }
        if (hipFuncSetAttribute((const void*)fwd_kernel, hipFuncAttributeMaxDynamicSharedMemorySize, LDS_BYTES) != hipSuccess) { fprintf(stderr, "kernel_launch: hipFuncSetAttribute failed\n"); grid = -1; return; }
        if (hipOccupancyMaxActiveBlocksPerMultiprocessor(&per_cu, (const void*)fwd_kernel, NTHR, LDS_BYTES) != hipSuccess || per_cu < 1) fprintf(stderr, "kernel_launch: occupancy query reports %d\n", per_cu);
        (void)hipGetLastError();
        if (cus < 256) { fprintf(stderr, "kernel_launch: needs 256 CUs, device has %d\n", cus); grid = -1; return; }
        grid = 256;
    }
    if (grid < 0) return;
    if (hipMemsetAsync((char*)d_ws + WS_CTL, 0, CTL_ZERO_BYTES, stream) != hipSuccess) return;
    Args a{};
    for (int i = 0; i < 23; ++i) a.in[i] = (const float*)d_in[i];
    a.out = (float*)d_out; a.ws = (unsigned char*)d_ws;
#if MK_MULTI
    for (int k = 0; k < NPHASE; ++k) { a.ph_lo = k; a.ph_hi = k + 1; hipLaunchKernelGGL(fwd_kernel, dim3(grid), dim3(NTHR), LDS_BYTES, stream, a); }
#else
    a.ph_lo = 0; a.ph_hi = NPHASE; hipLaunchKernelGGL(fwd_kernel, dim3(grid), dim3(NTHR), LDS_BYTES, stream, a);
#endif
}
```

```cpp
#include <hip/hip_runtime.h>
#include <cstdio>
#include <cstdint>
#ifndef MK_MULTI
#define MK_MULTI 0
#endif
namespace pg8 {
#define PG8_LAS __attribute__((address_space(3)))
typedef unsigned short bf16_t;
typedef short bf16x8 __attribute__((ext_vector_type(8)));
typedef float f32x4 __attribute__((ext_vector_type(4)));
typedef unsigned u32x4 __attribute__((ext_vector_type(4)));
constexpr int BM = 256, BK = 64, HALF = 128, HTB = HALF * BK * 2  , STAGE_BYTES = 8 * HTB, NXCD = 8, WGM = 8;

__host__ __device__ __forceinline__ int lds_byte(int r, int c) { const int st = (r >> 4) * 2 + (c >> 5), rr = r & 15, cc = c & 31, ob = rr * 64 + cc * 2; return st * 1024 + (ob ^ (((ob >> 9) & 1) << 5)); }
__host__ __device__ __forceinline__ void stage_rc(int b, int& R, int& C) { const int st = b / 1024, sb = b % 1024, swz = sb ^ (((sb >> 9) & 1) << 5); R = (st >> 1) * 16 + swz / 64; C = (st & 1) * 32 + (swz % 64) / 2; }
__host__ __device__ __forceinline__ int perm32(int rho) { const int n = rho >> 4, i = rho & 15; return 8 * (i >> 2) + 4 * n + (i & 3); }

struct Unit { int pm, pn; };
struct Gemm { const bf16_t* A; const bf16_t* Bt; int M, N, K; };

struct StaticOrder {
    int nM, nN, nwg, G, c;
    __host__ __device__ void init(int M, int N, int G_, int c_) { nM = M / BM; nN = N / BM; nwg = nM * nN; G = G_; c = c_; }
    __host__ __device__ bool next(int i, Unit& u) const {
        const long L = (long)i * G + c; if (L >= nwg) return false;
        int wgid = (int)L; { const int q = nwg / NXCD, r = nwg % NXCD, xcd = wgid % NXCD, off = wgid / NXCD; wgid = (xcd < r ? xcd * (q + 1) : r * (q + 1) + (xcd - r) * q) + off; }
        const int nig = WGM * nN, gid = wgid / nig, fm = gid * WGM, gsz = (nM - fm) < WGM ? (nM - fm) : WGM;
        u.pm = fm + ((wgid % nig) % gsz); u.pn = (wgid % nig) / gsz; return true;
    }
    __device__ __forceinline__ void a_ready(const Unit&) const {}
    __device__ __forceinline__ void done(const Unit&) const {}
};
__device__ __forceinline__ unsigned cvt_pk_bf16(float lo, float hi) { unsigned r; asm volatile("v_cvt_pk_bf16_f32 %0, %1, %2" : "=v"(r) : "v"(lo), "v"(hi)); return r; }
typedef float f32x2 __attribute__((ext_vector_type(2)));
template <class Epi, class Sched, bool ALIGN_EPI = false, bool SP2 = false>
__device__ __forceinline__ void gemm_phase(PG8_LAS unsigned char* lds, const Gemm g, const Sched& S, const Epi& E) {
    int tid_l = threadIdx.x; asm volatile("" : "+v"(tid_l));
    const int tid = tid_l, wid = __builtin_amdgcn_readfirstlane(tid >> 6), lane = tid & 63, wr = wid >> 2, wc = wid & 3, fr = lane & 15, fq = lane >> 4;
    const int K = g.K, nt = K / BK;
    unsigned voffA[2], voffB[2];
#pragma unroll
    for (int i = 0; i < 2; ++i) { int R, C; stage_rc(tid * 16 + i * 8192, R, C); const int Rb = Epi::PERM ? ((R & ~31) + perm32(R & 31)) : R;
        voffA[i] = (unsigned)(R * K + C) * 2u; voffB[i] = (unsigned)(Rb * K + C) * 2u; }
    const size_t kstep = (size_t)(BK * 2);
    const size_t hstep = (size_t)HALF * K * 2;
    const size_t tstep = 2 * hstep;
    const unsigned ldsw = (unsigned)wid * 1024u;
    const int aoff = lds_byte(wr * 64 + fr, fq * 8), boff = lds_byte(wc * 32 + fr, fq * 8);
#define PG8_SA(b, h) (((b) * 2 + (h)) * HTB)
#define PG8_SB(b, h) ((4 + (b) * 2 + (h)) * HTB)
#define PG8_STAGE(bufoff, gbase, voff) do { _Pragma("unroll") for (int _i = 0; _i < 2; ++_i) \
        __builtin_amdgcn_global_load_lds((const unsigned*)((const char*)(gbase) + (voff)[_i]), (PG8_LAS unsigned*)(lds + (bufoff) + ldsw + _i * 8192), 16, 0, 0); } while (0)
#define PG8_LDA(dst, b, h) do { _Pragma("unroll") for (int m = 0; m < 4; ++m) _Pragma("unroll") for (int k = 0; k < 2; ++k) dst[m][k] = *(const PG8_LAS bf16x8*)(lds + PG8_SA(b, h) + aoff + m * 2048 + k * 1024); } while (0)
#define PG8_LDB(dst, b, h) do { _Pragma("unroll") for (int n = 0; n < 2; ++n) _Pragma("unroll") for (int k = 0; k < 2; ++k) dst[n][k] = *(const PG8_LAS bf16x8*)(lds + PG8_SB(b, h) + boff + n * 2048 + k * 1024); } while (0)
#define PG8_MMA(ai, bj, At, Bt) do { __builtin_amdgcn_s_setprio(1); _Pragma("unroll") for (int m = 0; m < 4; ++m) _Pragma("unroll") for (int n = 0; n < 2; ++n) _Pragma("unroll") for (int k = 0; k < 2; ++k) \
        acc[ai][bj][m][n] = __builtin_amdgcn_mfma_f32_16x16x32_bf16(Bt[n][k], At[m][k], acc[ai][bj][m][n], 0, 0, 0); __builtin_amdgcn_s_setprio(0); } while (0)
#define PG8_WAIT_V(n) asm volatile("s_waitcnt vmcnt(" #n ")" ::: "memory")
#define PG8_WAIT_L(n) asm volatile("s_waitcnt lgkmcnt(" #n ")" ::: "memory")
#define PG8_BAR __builtin_amdgcn_s_barrier()
#define PG8_SCHED __builtin_amdgcn_sched_barrier(0)
    Unit cur, nxt; int ui = 0;
    if (!S.next(0, cur)) return;
    f32x4 acc[2][2][4][2];
#pragma unroll
    for (int a = 0; a < 2; ++a)
#pragma unroll
        for (int b = 0; b < 2; ++b)
#pragma unroll
            for (int m = 0; m < 4; ++m)
#pragma unroll
                for (int n = 0; n < 2; ++n) acc[a][b][m][n] = (f32x4){0.f, 0.f, 0.f, 0.f};
    bf16x8 At[4][2], B0[2][2], B1[2][2];
    const char* cA = (const char*)g.A + (size_t)cur.pm * tstep; const char* cB = (const char*)g.Bt + (size_t)cur.pn * tstep;
    S.a_ready(cur);
    if constexpr (SP2) {
        PG8_STAGE(PG8_SB(0, 0), cB, voffB); PG8_STAGE(PG8_SB(0, 1), cB + hstep, voffB); PG8_STAGE(PG8_SA(0, 0), cA, voffA); PG8_STAGE(PG8_SA(0, 1), cA + hstep, voffA);
        if (wr == 1) PG8_BAR;
        PG8_WAIT_V(2); PG8_BAR;
        PG8_STAGE(PG8_SB(1, 0), cB + kstep, voffB); PG8_STAGE(PG8_SA(1, 0), cA + kstep, voffA); PG8_STAGE(PG8_SB(1, 1), cB + hstep + kstep, voffB);
        PG8_WAIT_V(6); PG8_BAR;
    } else {
        PG8_STAGE(PG8_SB(0, 0), cB, voffB); PG8_STAGE(PG8_SA(0, 0), cA, voffA); PG8_STAGE(PG8_SB(0, 1), cB + hstep, voffB); PG8_STAGE(PG8_SA(0, 1), cA + hstep, voffA);
        if (wr == 1) PG8_BAR;
        PG8_WAIT_V(4); PG8_BAR;
        PG8_STAGE(PG8_SB(1, 0), cB + kstep, voffB); PG8_STAGE(PG8_SA(1, 0), cA + kstep, voffA); PG8_STAGE(PG8_SB(1, 1), cB + hstep + kstep, voffB);
        PG8_WAIT_V(6); PG8_BAR;
    }
    for (;;) {
        const bool has_next = S.next(ui + 1, nxt);
        const char* nA = has_next ? (const char*)g.A + (size_t)nxt.pm * tstep : cA; const char* nB = has_next ? (const char*)g.Bt + (size_t)nxt.pn * tstep : cB;
        for (int t = 0; t < nt; t += 2) {
            const bool last = (t == nt - 2);
            const char* a1 = cA + (size_t)(t + 1) * kstep;
            const char* a2 = last ? nA : cA + (size_t)(t + 2) * kstep; const char* b2 = last ? nB : cB + (size_t)(t + 2) * kstep;
            const char* a3 = a2 + kstep; const char* b3 = b2 + kstep;
            if (last && has_next) S.a_ready(nxt);
            if constexpr (SP2) {
            PG8_LDB(B0, 0, 0); PG8_LDB(B1, 0, 1); PG8_SCHED; PG8_LDA(At, 0, 0); PG8_STAGE(PG8_SA(1, 1), a1 + hstep, voffA);
            PG8_WAIT_V(8); PG8_WAIT_L(0); PG8_BAR; PG8_MMA(0, 0, At, B0); PG8_MMA(0, 1, At, B1); PG8_BAR; PG8_SCHED;
            PG8_LDA(At, 0, 1); PG8_STAGE(PG8_SB(0, 0), b2, voffB); PG8_STAGE(PG8_SB(0, 1), b2 + hstep, voffB); PG8_STAGE(PG8_SA(0, 0), a2, voffA);
            PG8_WAIT_V(8); PG8_WAIT_L(0); PG8_BAR; PG8_MMA(1, 0, At, B0); PG8_MMA(1, 1, At, B1); PG8_BAR; PG8_SCHED;
            PG8_LDB(B0, 1, 0); PG8_LDB(B1, 1, 1); PG8_SCHED; PG8_LDA(At, 1, 0); PG8_STAGE(PG8_SA(0, 1), a2 + hstep, voffA);
            PG8_WAIT_V(8); PG8_WAIT_L(0); PG8_BAR; PG8_MMA(0, 0, At, B0); PG8_MMA(0, 1, At, B1); PG8_BAR; PG8_SCHED;
            PG8_LDA(At, 1, 1); PG8_STAGE(PG8_SB(1, 0), b3, voffB); PG8_STAGE(PG8_SB(1, 1), b3 + hstep, voffB); PG8_STAGE(PG8_SA(1, 0), a3, voffA);
            PG8_WAIT_V(8); PG8_WAIT_L(0); PG8_BAR; PG8_MMA(1, 0, At, B0); PG8_MMA(1, 1, At, B1); PG8_BAR; PG8_SCHED;
            } else {
            PG8_LDB(B0, 0, 0); PG8_SCHED; PG8_LDA(At, 0, 0); PG8_STAGE(PG8_SA(1, 1), a1 + hstep, voffA);
            PG8_WAIT_L(8); PG8_BAR; PG8_WAIT_L(0); PG8_MMA(0, 0, At, B0); PG8_BAR; PG8_SCHED;
            PG8_LDB(B1, 0, 1); PG8_STAGE(PG8_SB(0, 0), b2, voffB);
            PG8_BAR; PG8_WAIT_L(0); PG8_MMA(0, 1, At, B1); PG8_BAR;
            PG8_LDA(At, 0, 1); PG8_STAGE(PG8_SA(0, 0), a2, voffA);
            PG8_BAR; PG8_WAIT_L(0); PG8_MMA(1, 0, At, B0); PG8_BAR; PG8_SCHED;
            PG8_STAGE(PG8_SB(0, 1), b2 + hstep, voffB);
            PG8_WAIT_V(6); PG8_BAR; PG8_MMA(1, 1, At, B1); PG8_BAR;
            PG8_LDB(B0, 1, 0); PG8_SCHED; PG8_LDA(At, 1, 0); PG8_STAGE(PG8_SA(0, 1), a2 + hstep, voffA);
            PG8_WAIT_L(8); PG8_BAR; PG8_WAIT_L(0); PG8_MMA(0, 0, At, B0); PG8_BAR; PG8_SCHED;
            PG8_LDB(B1, 1, 1); PG8_STAGE(PG8_SB(1, 0), b3, voffB);
            PG8_BAR; PG8_WAIT_L(0); PG8_MMA(0, 1, At, B1); PG8_BAR;
            PG8_LDA(At, 1, 1); PG8_STAGE(PG8_SA(1, 0), a3, voffA);
            PG8_BAR; PG8_WAIT_L(0); PG8_MMA(1, 0, At, B0); PG8_BAR; PG8_SCHED;
            PG8_STAGE(PG8_SB(1, 1), b3 + hstep, voffB);
            PG8_WAIT_V(6); PG8_BAR; PG8_MMA(1, 1, At, B1); PG8_BAR;
            }
        }
        if constexpr (ALIGN_EPI) { if (wr == 0) PG8_BAR; }
        if constexpr (!Epi::AFTER_DRAIN) { E(acc, cur, wr, wc, fr, fq); S.done(cur); }
        if (!has_next) break;
#pragma unroll
        for (int a = 0; a < 2; ++a)
#pragma unroll
            for (int b = 0; b < 2; ++b)
#pragma unroll
                for (int m = 0; m < 4; ++m)
#pragma unroll
                    for (int n = 0; n < 2; ++n) acc[a][b][m][n] = (f32x4){0.f, 0.f, 0.f, 0.f};
        cur = nxt; cA = nA; cB = nB; ++ui;
        if constexpr (ALIGN_EPI) { if (wr == 1) PG8_BAR; }
    }
    PG8_WAIT_V(0);
    if constexpr (!ALIGN_EPI) { if (wr == 0) PG8_BAR; }
    PG8_BAR;
    if constexpr (Epi::AFTER_DRAIN) { E.fused(acc, cur, wr, wc, fr, fq, lds, wid, lane); S.done(cur); }
#undef PG8_SA
#undef PG8_SB
#undef PG8_STAGE
#undef PG8_LDA
#undef PG8_LDB
#undef PG8_MMA
#undef PG8_WAIT_V
#undef PG8_WAIT_L
#undef PG8_BAR
#undef PG8_SCHED
}
}
constexpr int NB = 16, SEQ = 2048, CTXL = 256, D = 1024;
constexpr int ML = NB * SEQ, MC = NB * CTXL, MT = ML + MC;
constexpr int INW = 4128, PW = 4096, NIN = 4352;
constexpr int DFF = 2816, NEXP = 8, DEXP = 3584;
constexpr int NWAVES = 8, NTHR = 512;
constexpr float EPS = 1e-6f;
constexpr int NPHASE = 27;
constexpr int CHUNK_PAN = 64;
constexpr int HS_ROWS = 2 * ML + NEXP * 256;

constexpr size_t MiB = 1u << 20;
constexpr size_t WS_CTL = 0, CTL_ZERO_BYTES = 1 * MiB;
constexpr size_t WS_MODS = 1 * MiB, WS_ROUTE = 2 * MiB, WS_GR = 4 * MiB, WS_WIN = 7 * MiB, WS_WOUT = 24 * MiB, WS_F13 = 28 * MiB, WS_F2 = 39 * MiB;
constexpr size_t WS_XC = 45 * MiB, WS_H = 61 * MiB, WS_OB = 133 * MiB, WS_G = 205 * MiB, WS_P = 277 * MiB, WS_END = 565 * MiB;
constexpr size_t WS_MIX = WS_P, WS_ACT0 = WS_P, WS_HS = WS_OB, WS_ACT = 265 * MiB, WS_M13 = 397 * MiB, WS_M2 = 509 * MiB;
static_assert(WS_GR + (size_t)MT * 32 * 2 <= WS_WIN && WS_WIN + 2ull * NIN * 1024 * 2 <= WS_WOUT && WS_F13 + 5632ull * 1024 * 2 <= WS_F2 && WS_F2 + 1024ull * DFF * 2 <= WS_XC, "ws map 1");
static_assert(WS_XC + (size_t)MC * D * 4 <= WS_H && WS_H + (size_t)MT * D * 2 <= WS_OB && WS_OB + (size_t)MT * D * 2 <= WS_G && WS_G + (size_t)MT * D * 2 <= WS_P && WS_P + (size_t)MT * PW * 2 <= WS_END, "ws map 2");
static_assert(WS_ACT0 + (size_t)MT * DFF * 2 <= WS_END && WS_HS + (size_t)HS_ROWS * D * 2 <= WS_ACT && WS_ACT + (size_t)CHUNK_PAN * 256 * DEXP * 2 <= WS_M13 && WS_M13 + 8ull * 7168 * 1024 * 2 <= WS_M2 && WS_M2 + 8ull * 1024 * DEXP * 2 <= WS_END, "ws map 3");
static_assert(WS_MIX + (size_t)MT * D * 2 <= WS_M13, "mix vs moe weights");
constexpr int MO_LAT = 0, MO_CTX = 2 * 16 * 6144, MO_LB = MO_CTX + 2 * 6144;
constexpr size_t RT_SEL = 0, RT_W = 512 * 1024, RT_CNT = 768 * 1024, RT_GW = 1024 * 1024;
constexpr int CW_TMO = 0, CW_CODE = 1, CW_BAR = 4096;
constexpr int RING_BYTES = 131072, LDSCTL_OFF = RING_BYTES, MISC_OFF = LDSCTL_OFF + 320, TAB_OFF = LDSCTL_OFF + 512, LDS_BYTES = 147456;

#define GAS __attribute__((address_space(1)))
#define LAS __attribute__((address_space(3)))
typedef unsigned short bf16;
typedef unsigned v4u __attribute__((ext_vector_type(4)));
typedef unsigned v2u __attribute__((ext_vector_type(2)));
typedef int v4i __attribute__((ext_vector_type(4)));
typedef float f32x4 __attribute__((ext_vector_type(4)));
typedef float f32x2v __attribute__((ext_vector_type(2)));
#define LDS_WAIT() asm volatile("s_waitcnt lgkmcnt(0)" ::: "memory")
#define VM_WAIT() asm volatile("s_waitcnt vmcnt(0)" ::: "memory")
__device__ __forceinline__ unsigned f2bf(float f) { unsigned u = __builtin_bit_cast(unsigned, f); return (u + 0x7fffu + ((u >> 16) & 1u)) >> 16; }
__device__ __forceinline__ unsigned pk2(float lo, float hi) { return f2bf(lo) | (f2bf(hi) << 16); }
__device__ __forceinline__ float bf2f(unsigned b) { return __builtin_bit_cast(float, b << 16); }
__device__ __forceinline__ float bflo(unsigned w) { return __builtin_bit_cast(float, w << 16); }
__device__ __forceinline__ float bfhi(unsigned w) { return __builtin_bit_cast(float, w & 0xffff0000u); }
__device__ __forceinline__ float wave_sum(float v) {
#pragma unroll
    for (int o = 1; o < 64; o <<= 1) v += __shfl_xor(v, o);
    return v;
}
__device__ __forceinline__ float silu_f(float x) { return x / (1.f + __expf(-x)); }
__device__ __forceinline__ float logsig_f(float x) { return fminf(x, 0.f) - __logf(1.f + __expf(-fabsf(x))); }

#define XB_TMO      128
#define XB_XCNT(j)  (256  + 64 * (j))
#define XB_XSUB(j)  (1280 + 64 * (j))
#define XB_XGEN(j)  (2304 + 64 * (j))
#define XB_TOP      3328
#define XB_TOPGEN   3392
#define XCD_BAR_WORDS 3456
#define XB_SPIN_CAP (1u << 18)

__device__ __forceinline__ unsigned xb_ld(unsigned* p)              { return __hip_atomic_load(p, __ATOMIC_RELAXED, __HIP_MEMORY_SCOPE_AGENT); }
__device__ __forceinline__ unsigned xb_add(unsigned* p, unsigned v) { return __hip_atomic_fetch_add(p, v, __ATOMIC_RELAXED, __HIP_MEMORY_SCOPE_AGENT); }
__device__ __forceinline__ unsigned xb_xcc_id() { return (unsigned)__builtin_amdgcn_s_getreg((3 << 11) | 20) & 0xFu; }
#define XB_SPIN(cond, bar) do { unsigned _sp = 0; while (cond) { __builtin_amdgcn_s_sleep(1); \
    if ((++_sp & 255u) == 0u) { if (xb_ld(&(bar)[XB_TMO])) break; if (_sp > XB_SPIN_CAP) { atomicAdd(&(bar)[XB_TMO], 1u); break; } } } } while (0)

struct XcdBarrier {
    unsigned* bar; unsigned x;
    volatile LAS unsigned* st;
};

__device__ __forceinline__ XcdBarrier xcd_barrier_post(unsigned* bar, volatile LAS unsigned* st) {
    XcdBarrier b; b.bar = bar; b.x = xb_xcc_id(); b.st = st;
    if (threadIdx.x == 0) (void)xb_add(&bar[XB_XCNT(b.x)], 1u);
    return b;
}
__device__ __forceinline__ void xcd_barrier_complete(unsigned* bar, unsigned x, unsigned& nloc, unsigned& nx) {
    const unsigned G = gridDim.x * gridDim.y * gridDim.z;
    unsigned sum, cnt, mine, sp = 0u;
    for (;;) {
        sum = 0u; cnt = 0u; mine = 0u;
#pragma unroll
        for (unsigned j = 0; j < 16; ++j) { const unsigned c = xb_ld(&bar[XB_XCNT(j)]); sum += c; cnt += (c > 0u) ? 1u : 0u; mine = (j == x) ? c : mine; }
        if (sum == G) break;
        __builtin_amdgcn_s_sleep(1);
        if ((++sp & 255u) == 0u) { if (xb_ld(&bar[XB_TMO])) break; if (sp > XB_SPIN_CAP) { atomicAdd(&bar[XB_TMO], 1u); break; } }
    }
    nloc = mine > 0u ? mine : 1u; nx = cnt > 0u ? cnt : 1u;
}

__device__ __forceinline__ void xcd_barrier(const XcdBarrier& b) {
    asm volatile("s_waitcnt vmcnt(0)" ::: "memory");
    __syncthreads();
    if (threadIdx.x == 0) {
        unsigned* bar = b.bar;
        __builtin_amdgcn_s_waitcnt(0);
        unsigned nloc = b.st[0], nx = b.st[1];
        if (nloc == 0u) { xcd_barrier_complete(bar, b.x, nloc, nx); b.st[0] = nloc; b.st[1] = nx; }
        const unsigned old = xb_add(&bar[XB_XSUB(b.x)], 1u);
        const unsigned gen = old / nloc;
        if (old + 1u == (gen + 1u) * nloc) {
            __builtin_amdgcn_fence(__ATOMIC_RELEASE, "agent");
            asm volatile("s_waitcnt vmcnt(0)" ::: "memory");
            const unsigned og = xb_add(&bar[XB_TOP], 1u);
            const unsigned tg = og / nx;
            if (og + 1u == (tg + 1u) * nx) xb_add(&bar[XB_TOPGEN], 1u);
            else XB_SPIN(xb_ld(&bar[XB_TOPGEN]) == tg, bar);
            __builtin_amdgcn_fence(__ATOMIC_ACQUIRE, "agent");
            xb_add(&bar[XB_XGEN(b.x)], 1u);
            asm volatile("s_waitcnt vmcnt(0)" ::: "memory");
        } else {
            XB_SPIN(xb_ld(&bar[XB_XGEN(b.x)]) == gen, bar);
            __builtin_amdgcn_fence(__ATOMIC_ACQUIRE, "agent");
            asm volatile("s_waitcnt vmcnt(0)" ::: "memory");
        }
    }
    __syncthreads();
}
using pg8::Unit;
struct EpiInProj {
    static constexpr bool PERM = true, AFTER_DRAIN = false;
    bf16* P; bf16* G; bf16* GR; const float* LB;
    __device__ __forceinline__ void operator()(const pg8::f32x4 (&acc)[2][2][4][2], const Unit& u, int wr, int wc, int fr, int fq) const {
        const int pn = u.pn;
        const int row0 = u.pm * 256 + wr * 64 + fr, cin = wc * 32 + 8 * fq;
        if (pn == 16) {
            if (wc == 0) {
#pragma unroll
                for (int ai = 0; ai < 2; ++ai)
#pragma unroll
                    for (int m = 0; m < 4; ++m) { const pg8::f32x4 v0 = acc[ai][0][m][0], v1 = acc[ai][0][m][1]; v4u w; w.x = pk2(v0[0], v0[1]); w.y = pk2(v0[2], v0[3]); w.z = pk2(v1[0], v1[1]); w.w = pk2(v1[2], v1[3]);
                        *(v4u*)(GR + (size_t)(row0 + ai * 128 + m * 16) * 32 + 8 * fq) = w; }
            }
            return;
        }
        int mode, dcol, dcol2 = 0, ldd = PW; bf16* dst = P; const float* lbp = LB;
        if (pn == 0) { mode = 0; dcol = 0; }
        else if (pn <= 3) { mode = 1; dcol = 256 * pn; }
        else if (pn <= 5) { mode = 1; dst = G; ldd = 1024; dcol = 256 * (pn - 4); }
        else if (pn <= 7) { mode = 2; dcol = 1024 + 256 * (pn - 6); }
        else if (pn <= 9) { mode = 3; dcol = 1536 + 256 * (pn - 8); dcol2 = 2048 + 256 * (pn - 8); lbp = LB + 256 * (pn - 8); }
        else if (pn <= 11) { mode = 3; dcol = 2560 + 256 * (pn - 10); dcol2 = 3072 + 256 * (pn - 10); lbp = LB + 512 + 256 * (pn - 10); }
        else if (pn <= 13) { mode = 1; dcol = 3584 + 256 * (pn - 12); }
        else { mode = 1; dst = G; ldd = 1024; dcol = 512 + 256 * (pn - 14); }
        if (mode == 3) {
#pragma unroll
            for (int bj = 0; bj < 2; ++bj) {
                float lb[8];
#pragma unroll
                for (int j = 0; j < 8; ++j) lb[j] = lbp[bj * 128 + cin + j];
#pragma unroll
                for (int ai = 0; ai < 2; ++ai)
#pragma unroll
                    for (int m = 0; m < 4; ++m) {
                        const pg8::f32x4 v0 = acc[ai][bj][m][0], v1 = acc[ai][bj][m][1];
                        const float a[8] = {v0[0], v0[1], v0[2], v0[3], v1[0], v1[1], v1[2], v1[3]}; float kk[8], lf[8];
#pragma unroll
                        for (int j = 0; j < 8; ++j) { const float e = __expf(-fabsf(a[j])), r = 1.f / (1.f + e), big = r, sml = e * r; const float sg = a[j] >= 0.f ? big : sml, sn = a[j] >= 0.f ? sml : big;
                            kk[j] = (1.f - lb[j]) * sn; lf[j] = __logf(fmaxf(lb[j], 1e-30f) + (1.f - lb[j]) * sg); }
                        const size_t ro = (size_t)(row0 + ai * 128 + m * 16) * PW + bj * 128 + cin;
                        v4u w; w.x = pk2(kk[0], kk[1]); w.y = pk2(kk[2], kk[3]); w.z = pk2(kk[4], kk[5]); w.w = pk2(kk[6], kk[7]); *(v4u*)(P + ro + dcol) = w;
                        v4u x; x.x = pk2(lf[0], lf[1]); x.y = pk2(lf[2], lf[3]); x.z = pk2(lf[4], lf[5]); x.w = pk2(lf[6], lf[7]); *(v4u*)(P + ro + dcol2) = x;
                    }
            }
            return;
        }
#pragma unroll
        for (int ai = 0; ai < 2; ++ai)
#pragma unroll
            for (int m = 0; m < 4; ++m)
#pragma unroll
                for (int bj = 0; bj < 2; ++bj) {
                    const pg8::f32x4 v0 = acc[ai][bj][m][0], v1 = acc[ai][bj][m][1];
                    float a[8] = {v0[0], v0[1], v0[2], v0[3], v1[0], v1[1], v1[2], v1[3]};
                    if (mode == 0) {
#pragma unroll
                        for (int j = 0; j < 8; ++j) a[j] *= 0.125f;
                    } else if (mode == 2) {
#pragma unroll
                        for (int j = 0; j < 8; ++j) a[j] = silu_f(a[j]);
                    }
                    v4u w; w.x = pk2(a[0], a[1]); w.y = pk2(a[2], a[3]); w.z = pk2(a[4], a[5]); w.w = pk2(a[6], a[7]);
                    *(v4u*)(dst + (size_t)(row0 + ai * 128 + m * 16) * ldd + dcol + bj * 128 + cin) = w;
                }
    }
};
struct EpiResid {
    static constexpr bool PERM = false, AFTER_DRAIN = false;
    const float* base_lat; const float* base_ctx; float* out_lat; float* out_ctx; const float* gate_lat; const float* gate_ctx;
    __device__ __forceinline__ void operator()(const pg8::f32x4 (&acc)[2][2][4][2], const Unit& u, int wr, int wc, int fr, int fq) const {
        const int prow = u.pm * 256; const float* base; float* out; const float* gate; int r0;
        if (prow < ML) { base = base_lat; out = out_lat; gate = gate_lat + (prow >> 11) * 6144; r0 = prow; }
        else { base = base_ctx; out = out_ctx; gate = gate_ctx; r0 = prow - ML; }
        const int row0 = r0 + wr * 64 + fr, col0 = u.pn * 256 + wc * 32 + 4 * fq;
        pg8::f32x4 gv[2][2];
#pragma unroll
        for (int bj = 0; bj < 2; ++bj)
#pragma unroll
            for (int n = 0; n < 2; ++n) gv[bj][n] = *(const pg8::f32x4*)(gate + col0 + bj * 128 + n * 16);
#pragma unroll
        for (int ai = 0; ai < 2; ++ai)
#pragma unroll
            for (int m = 0; m < 4; ++m) { const size_t off = (size_t)(row0 + ai * 128 + m * 16) * D + col0;
#pragma unroll
                for (int bj = 0; bj < 2; ++bj)
#pragma unroll
                    for (int n = 0; n < 2; ++n) { const pg8::f32x4 bs = *(const pg8::f32x4*)(base + off + bj * 128 + n * 16); *(pg8::f32x4*)(out + off + bj * 128 + n * 16) = bs + gv[bj][n] * acc[ai][bj][m][n]; }
                asm volatile("" ::: "memory"); }
    }
};
struct EpiSwiGLU {
    static constexpr bool PERM = true, AFTER_DRAIN = false;
    bf16* ACT; int ldc, tiles, pm_off;
    __device__ __forceinline__ void operator()(const pg8::f32x4 (&acc)[2][2][4][2], const Unit& u, int wr, int wc, int fr, int fq) const {
        const int row0 = (u.pm - pm_off) * 256 + wr * 64 + fr, col0 = (u.pn % tiles) * 128 + wc * 32 + 8 * fq;
#pragma unroll
        for (int ai = 0; ai < 2; ++ai)
#pragma unroll
            for (int m = 0; m < 4; ++m) {
                const pg8::f32x4 g0 = acc[ai][0][m][0], g1 = acc[ai][0][m][1], u0 = acc[ai][1][m][0], u1 = acc[ai][1][m][1];
                float o[8];
#pragma unroll
                for (int j = 0; j < 4; ++j) { o[j] = silu_f(g0[j]) * u0[j]; o[4 + j] = silu_f(g1[j]) * u1[j]; }
                v4u w; w.x = pk2(o[0], o[1]); w.y = pk2(o[2], o[3]); w.z = pk2(o[4], o[5]); w.w = pk2(o[6], o[7]);
                *(v4u*)(ACT + (size_t)(row0 + ai * 128 + m * 16) * ldc + col0) = w;
            }
    }
};
struct EpiMoeOut {
    static constexpr bool PERM = true, AFTER_DRAIN = false;
    bf16* Y; const float* GW; int pm_off;
    __device__ __forceinline__ void operator()(const pg8::f32x4 (&acc)[2][2][4][2], const Unit& u, int wr, int wc, int fr, int fq) const {
        const int row0 = (u.pm + pm_off) * 256 + wr * 64 + fr, col0 = (u.pn & 3) * 256 + wc * 32 + 8 * fq;
#pragma unroll
        for (int ai = 0; ai < 2; ++ai)
#pragma unroll
            for (int m = 0; m < 4; ++m) { const int row = row0 + ai * 128 + m * 16; const float gw = GW[row];
#pragma unroll
                for (int bj = 0; bj < 2; ++bj) { const pg8::f32x4 v0 = acc[ai][bj][m][0] * gw, v1 = acc[ai][bj][m][1] * gw;
                    v4u w; w.x = pk2(v0[0], v0[1]); w.y = pk2(v0[2], v0[3]); w.z = pk2(v1[0], v1[1]); w.w = pk2(v1[2], v1[3]);
                    *(v4u*)(Y + (size_t)row * D + col0 + bj * 128) = w; } }
    }
};
struct MoeOrder {
    int nM, nN, nwg, G, c, pan0, a_local; int pb[8];
    __device__ __forceinline__ void init(int nM_, int nN_, int G_, int c_, int pan0_, int a_local_) { nM = nM_; nN = nN_; nwg = nM * nN; G = G_; c = c_; pan0 = pan0_; a_local = a_local_; }
    __device__ __forceinline__ bool next(int i, Unit& u) const {
        const long L = (long)i * G + c; if (L >= nwg) return false;
        int wgid = (int)L; { const int q = nwg / 8, r = nwg % 8, xcd = wgid % 8, off = wgid / 8; wgid = (xcd < r ? xcd * (q + 1) : r * (q + 1) + (xcd - r) * q) + off; }
        const int nig = 8 * nN, gid = wgid / nig, fm = gid * 8, gsz = (nM - fm) < 8 ? (nM - fm) : 8;
        const int pml = fm + ((wgid % nig) % gsz), pnl = (wgid % nig) / gsz, gp = pan0 + pml;
        int e = 0;
#pragma unroll
        for (int j = 1; j < 8; ++j) e += (gp >= pb[j]) ? 1 : 0;
        u.pm = a_local ? pml : gp; u.pn = e * nN + pnl; return true;
    }
    __device__ __forceinline__ void a_ready(const Unit&) const {}
    __device__ __forceinline__ void done(const Unit&) const {}
};

struct Args { const float* in[23]; float* out; unsigned char* ws; int ph_lo, ph_hi; };
typedef const __attribute__((address_space(4))) Args* KA;
__device__ __forceinline__ KA kargs() { KA p = (KA)__builtin_amdgcn_kernarg_segment_ptr(); asm volatile("" : "+s"(p)); return p; }
enum { I_X = 0, I_C, I_CTX, I_CCTX, I_WMOD, I_BMOD, I_N1G, I_N2G, I_WIN, I_GW2, I_GB, I_GLAG, I_HGG, I_HLB, I_WOUT, I_F1, I_F3, I_F2, I_ROUTER, I_M1, I_M3, I_M2, I_FNG };

__device__ __forceinline__ void tr_block(const float* W, int ldw, int col0, int k0, bf16* WT, int K, int drow0, LAS float* scr, int lane) {
#pragma unroll 8
    for (int i = 0; i < 32; ++i) { const int kk = 2 * i + (lane >> 5); scr[kk * 33 + (lane & 31)] = W[(size_t)(k0 + kk) * ldw + col0 + (lane & 31)]; }
    LDS_WAIT(); asm volatile("" ::: "memory");
    const int c = lane & 7;
#pragma unroll
    for (int j = 0; j < 4; ++j) { const int n = (lane >> 3) + 8 * j; const LAS float* s = scr + (8 * c) * 33 + n;
        v4u o; o.x = pk2(s[0 * 33], s[1 * 33]); o.y = pk2(s[2 * 33], s[3 * 33]); o.z = pk2(s[4 * 33], s[5 * 33]); o.w = pk2(s[6 * 33], s[7 * 33]);
        *(v4u*)(WT + (size_t)(drow0 + n) * K + k0 + 8 * c) = o; }
    LDS_WAIT(); asm volatile("" ::: "memory");
}
constexpr int NI_WIN = 2 * 16 * 129, NI_WOUT = 2 * 16 * 32, NI_F13 = 16 * 176, NI_F2 = 44 * 32, NI_MAIN = NI_WIN + NI_WOUT + NI_F13 + NI_F2;
constexpr int NI_M13E = 16 * 224, NI_M2E = 56 * 32, NI_M13 = 8 * NI_M13E, NI_MOE = NI_M13 + 8 * NI_M2E;
__device__ __forceinline__ void conv_item_main(KA a, int it, LAS float* scr, int lane) {
    unsigned char* ws = a->ws;
    if (it < NI_WIN) { const int l = it / 2064, r = it % 2064, kb = r / 129, nb = r % 129, drow = nb < 48 ? 32 * nb : (nb == 48 ? 4096 : 32 * (nb - 1));
        tr_block(a->in[I_WIN] + (size_t)l * 1024 * INW, INW, 32 * nb, 64 * kb, (bf16*)(ws + WS_WIN) + (size_t)l * NIN * 1024, 1024, drow, scr, lane); return; }
    it -= NI_WIN;
    if (it < NI_WOUT) { const int l = it / 512, r = it % 512, kb = r / 32, nb = r % 32;
        tr_block(a->in[I_WOUT] + (size_t)l * 1024 * 1024, 1024, 32 * nb, 64 * kb, (bf16*)(ws + WS_WOUT) + (size_t)l * 1024 * 1024, 1024, 32 * nb, scr, lane); return; }
    it -= NI_WOUT;
    if (it < NI_F13) { const int kb = it / 176, db = it % 176, drow = 32 * db, pn = drow >> 8, half = (drow >> 7) & 1, off = drow & 127;
        tr_block(half ? a->in[I_F3] : a->in[I_F1], DFF, 128 * pn + off, 64 * kb, (bf16*)(ws + WS_F13), 1024, drow, scr, lane); return; }
    it -= NI_F13;
    { const int kb = it / 32, nb = it % 32; tr_block(a->in[I_F2], 1024, 32 * nb, 64 * kb, (bf16*)(ws + WS_F2), DFF, 32 * nb, scr, lane); }
}
__device__ __forceinline__ void conv_item_moe(KA a, int it, LAS float* scr, int lane) {
    unsigned char* ws = a->ws;
    if (it < NI_M13) { const int e = it / NI_M13E, r = it % NI_M13E, kb = r / 224, db = r % 224, drow = 32 * db, pn = drow >> 8, half = (drow >> 7) & 1, off = drow & 127;
        tr_block((half ? a->in[I_M3] : a->in[I_M1]) + (size_t)e * 1024 * DEXP, DEXP, 128 * pn + off, 64 * kb, (bf16*)(ws + WS_M13) + (size_t)e * 7168 * 1024, 1024, drow, scr, lane); return; }
    it -= NI_M13;
    { const int e = it / NI_M2E, r = it % NI_M2E, kb = r / 32, nb = r % 32;
      tr_block(a->in[I_M2] + (size_t)e * DEXP * 1024, 1024, 32 * nb, 64 * kb, (bf16*)(ws + WS_M2) + (size_t)e * 1024 * DEXP, DEXP, 32 * nb, scr, lane); }
}
__device__ __forceinline__ void mod_item(KA a, int it, LAS unsigned char* lds, int tid, int lane, int wave) {
    LAS float* sc = (LAS float*)lds; LAS float* red = (LAS float*)(lds + 69632);
    const int l = it / 96, n0 = 64 * (it % 96);
    for (int idx = tid; idx < 17 * 1024; idx += NTHR) { const int r = idx >> 10, k = idx & 1023; const float v = r < 16 ? a->in[I_C][r * 1024 + k] : a->in[I_CCTX][k]; sc[k * 17 + r] = silu_f(v); }
    __syncthreads();
    float acc[17];
#pragma unroll
    for (int r = 0; r < 17; ++r) acc[r] = 0.f;
    const float* wm = a->in[I_WMOD] + (size_t)l * 1024 * 6144 + n0 + lane;
    for (int k = wave * 128; k < wave * 128 + 128; ++k) { const float w = wm[(size_t)k * 6144];
#pragma unroll
        for (int r = 0; r < 17; ++r) acc[r] += sc[k * 17 + r] * w; }
#pragma unroll
    for (int r = 0; r < 17; ++r) red[(wave * 17 + r) * 64 + lane] = acc[r];
    __syncthreads();
    float* mods = (float*)(a->ws + WS_MODS);
    for (int idx = tid; idx < 17 * 64; idx += NTHR) { const int r = idx >> 6, ln = idx & 63; float s = a->in[I_BMOD][l * 6144 + n0 + ln];
#pragma unroll
        for (int w = 0; w < 8; ++w) s += red[(w * 17 + r) * 64 + ln];
        if (r < 16) mods[MO_LAT + (l * 16 + r) * 6144 + n0 + ln] = s; else mods[MO_CTX + l * 6144 + n0 + ln] = s; }
    __syncthreads();
}
__device__ __forceinline__ void ada_norm_row(const float* xrow, bf16* orow, const float* g, const float* shift, const float* scale, int lane, f32x4 (&y)[4]) {
    const f32x4* xr = (const f32x4*)xrow + lane; float s = 0.f;
#pragma unroll
    for (int j = 0; j < 4; ++j) { y[j] = xr[64 * j]; s += (y[j].x * y[j].x + y[j].y * y[j].y) + (y[j].z * y[j].z + y[j].w * y[j].w); }
    const float rstd = rsqrtf(wave_sum(s) * (1.f / D) + EPS);
    v2u* o8 = (v2u*)orow + lane;
#pragma unroll
    for (int j = 0; j < 4; ++j) { const f32x4 gv = ((const f32x4*)g)[lane + 64 * j], sh = ((const f32x4*)shift)[lane + 64 * j], sc = ((const f32x4*)scale)[lane + 64 * j];
        y[j] = y[j] * rstd * gv * (sc + 1.f) + sh; v2u w; w.x = pk2(y[j].x, y[j].y); w.y = pk2(y[j].z, y[j].w); o8[64 * j] = w; }
}
__device__ __forceinline__ int scan_row(int grp, int b, int dir, int step) {
    if (step < CTXL) { const int t = dir ? (CTXL - 1 - step) : step; return ML + b * CTXL + t; }
    int lp = step - CTXL; if (dir) lp = SEQ - 1 - lp;
    const int t = grp ? ((lp & 31) * 64 + (lp >> 5)) : lp;
    return b * SEQ + t;
}
template <int DK> __device__ __forceinline__ void scan_simple(LAS unsigned char* lds, const bf16* P, const bf16* GR, const float* w2, const float* gb, bf16* OUT, int grp, int b, int hd, int dir, int tid) {
    LAS float* qs = (LAS float*)lds; LAS float* ks = qs + 32 * 128; LAS float* fs = ks + 32 * 128; LAS float* vs = fs + 32 * 128; LAS float* red = vs + 32 * 128;
    const int j = tid & 127, cg = tid >> 7; constexpr int CPT = DK / 4;
    float st[CPT];
#pragma unroll
    for (int i = 0; i < CPT; ++i) st[i] = 0.f;
    for (int blk = 0; blk < (CTXL + SEQ) / 32; ++blk) {
        for (int idx = tid; idx < 32 * DK; idx += NTHR) { const int t = idx / DK, c = idx % DK, row = scan_row(grp, b, dir, blk * 32 + t); const bf16* pr = P + (size_t)row * PW; float q, k, lf;
            if (DK == 64) { q = bf2f(pr[hd * 64 + c]); k = bf2f(pr[256 + hd * 64 + c]); float lg = gb[hd * 64 + c]; const bf16* gr = GR + (size_t)row * 32 + dir * 16;
#pragma unroll
                for (int r = 0; r < 16; ++r) lg += bf2f(gr[r]) * w2[r * 256 + hd * 64 + c];
                lf = logsig_f(lg) * (1.f / 16.f); }
            else { q = bf2f(pr[1024 + hd * 128 + c]); k = bf2f(pr[(dir ? 2560 : 1536) + hd * 128 + c]); lf = bf2f(pr[(dir ? 3072 : 2048) + hd * 128 + c]); }
            qs[t * 128 + c] = q; ks[t * 128 + c] = k; fs[t * 128 + c] = __expf(lf); }
        for (int idx = tid; idx < 32 * 128; idx += NTHR) { const int t = idx >> 7, jj = idx & 127, row = scan_row(grp, b, dir, blk * 32 + t); vs[idx] = bf2f(P[(size_t)row * PW + (DK == 64 ? 512 : 3584) + hd * 128 + jj]); }
        __syncthreads();
        for (int t = 0; t < 32; ++t) { const float vv = vs[t * 128 + j]; float acc = 0.f;
#pragma unroll
            for (int i = 0; i < CPT; ++i) { const int c = cg * CPT + i; st[i] = st[i] * fs[t * 128 + c] + ks[t * 128 + c] * vv; acc += st[i] * qs[t * 128 + c]; }
            red[(t * 4 + cg) * 128 + j] = acc; }
        __syncthreads();
        for (int idx = tid; idx < 4096; idx += NTHR) { const int t = idx >> 7, jj = idx & 127, row = scan_row(grp, b, dir, blk * 32 + t);
            const float o = (red[(t * 4 + 0) * 128 + jj] + red[(t * 4 + 1) * 128 + jj]) + (red[(t * 4 + 2) * 128 + jj] + red[(t * 4 + 3) * 128 + jj]);
            OUT[(size_t)row * D + grp * 512 + hd * 128 + jj] = (bf16)f2bf(o); }
        __syncthreads();
    }
}
__device__ __forceinline__ void mix_row(const bf16* of, const bf16* ob, const bf16* gate, const float* gla_g, const float* hg_g, bf16* out, int lane) {
    const v4u* pf = (const v4u*)of + 2 * lane; const v4u* pb = (const v4u*)ob + 2 * lane; const v4u* pg = (const v4u*)gate + 2 * lane;
    const v4u f0 = pf[0], f1 = pf[1], b0 = pb[0], b1 = pb[1], g0 = pg[0], g1 = pg[1];
    const unsigned fw[8] = {f0.x, f0.y, f0.z, f0.w, f1.x, f1.y, f1.z, f1.w}, bw[8] = {b0.x, b0.y, b0.z, b0.w, b1.x, b1.y, b1.z, b1.w}, gw[8] = {g0.x, g0.y, g0.z, g0.w, g1.x, g1.y, g1.z, g1.w};
    float o[16]; float ss = 0.f;
#pragma unroll
    for (int i = 0; i < 8; ++i) { o[2 * i] = bflo(fw[i]) + bflo(bw[i]); o[2 * i + 1] = bfhi(fw[i]) + bfhi(bw[i]); ss += o[2 * i] * o[2 * i] + o[2 * i + 1] * o[2 * i + 1]; }
    ss += __shfl_xor(ss, 1); ss += __shfl_xor(ss, 2); ss += __shfl_xor(ss, 4);
    const float rstd = rsqrtf(ss * (1.f / 128.f) + EPS);
    const float* ng = ((lane >> 5) ? hg_g : gla_g) + (lane & 7) * 16;
    unsigned w[8];
#pragma unroll
    for (int i = 0; i < 8; ++i) { const float a = o[2 * i] * rstd * ng[2 * i] * silu_f(bflo(gw[i])), c = o[2 * i + 1] * rstd * ng[2 * i + 1] * silu_f(bfhi(gw[i])); w[i] = pk2(a, c); }
    v4u* po = (v4u*)out + 2 * lane; po[0] = (v4u){w[0], w[1], w[2], w[3]}; po[1] = (v4u){w[4], w[5], w[6], w[7]};
}
__device__ __forceinline__ void moe_tab(KA a, LAS unsigned char* lds, int tid, int wg) {
    LAS int* tab = (LAS int*)(lds + TAB_OFF);
    if (tid < 32) tab[tid] = 0;
    __syncthreads();
    if (tid < 256) { const v4i* cp = (const v4i*)(a->ws + WS_ROUTE + RT_CNT) + 2 * tid; const v4i c0 = cp[0], c1 = cp[1]; const int c[8] = {c0.x, c0.y, c0.z, c0.w, c1.x, c1.y, c1.z, c1.w};
#pragma unroll
        for (int e = 0; e < 8; ++e) { __hip_atomic_fetch_add(&tab[e], c[e], __ATOMIC_RELAXED, __HIP_MEMORY_SCOPE_WORKGROUP); if (tid < wg) __hip_atomic_fetch_add(&tab[8 + e], c[e], __ATOMIC_RELAXED, __HIP_MEMORY_SCOPE_WORKGROUP); } }
    __syncthreads();
    if (tid == 0) { int pb = 0; for (int e = 0; e < 8; ++e) { tab[16 + e] = pb; pb += (tab[e] + 255) >> 8; } tab[24] = pb; }
    __syncthreads();
}

__global__ void __launch_bounds__(NTHR, 2) fwd_kernel(Args args) {
    extern __shared__ __attribute__((aligned(16))) unsigned char lds_raw[];
    LAS unsigned char* lds = (LAS unsigned char*)lds_raw;
    {   const int t0 = threadIdx.x;
        for (int u = t0; u < (LDS_BYTES - LDSCTL_OFF) / 4; u += NTHR) ((LAS unsigned*)(lds + LDSCTL_OFF))[u] = 0u;
        __syncthreads();
        (void)xcd_barrier_post((unsigned*)(kargs()->ws + WS_CTL) + CW_BAR, (volatile LAS unsigned*)(lds + MISC_OFF) + 8); }
#define IN(k) (kargs()->ph_lo <= (k) && (k) < kargs()->ph_hi)
#define BAR(k) do { if (IN(k) && IN((k) + 1)) { XcdBarrier bar_; bar_.bar = (unsigned*)(kargs()->ws + WS_CTL) + CW_BAR; bar_.x = xb_xcc_id(); bar_.st = (volatile LAS unsigned*)(lds + MISC_OFF) + 8; xcd_barrier(bar_); } } while (0)
#define PH_VIEW() KA A = kargs(); unsigned char* ws = A->ws; float* mods = (float*)(ws + WS_MODS); bf16* Hb = (bf16*)(ws + WS_H); bf16* OBb = (bf16*)(ws + WS_OB); bf16* Gb = (bf16*)(ws + WS_G); bf16* Pb = (bf16*)(ws + WS_P); \
    bf16* GRb = (bf16*)(ws + WS_GR); bf16* MIXb = (bf16*)(ws + WS_MIX); float* XC = (float*)(ws + WS_XC); float* XL = A->out; (void)mods; (void)Hb; (void)OBb; (void)Gb; (void)Pb; (void)GRb; (void)MIXb; (void)XC; (void)XL; \
    int tid = threadIdx.x; asm volatile("" : "+v"(tid)); const int lane = tid & 63, wave = __builtin_amdgcn_readfirstlane(tid >> 6), wg = blockIdx.x, G = gridDim.x, gw = wg * NWAVES + wave, NGW = G * NWAVES; \
    (void)lane; (void)wave; (void)wg; (void)G; (void)gw; (void)NGW
#define LAYER_VIEW() const float* xlat = l ? (const float*)XL : A->in[I_X]; const float* xctx = l ? (const float*)XC : A->in[I_CTX]; \
    const float* mlat = mods + MO_LAT + l * 16 * 6144; const float* mctx = mods + MO_CTX + l * 6144; (void)xlat; (void)xctx; (void)mlat; (void)mctx
    LAS int* tab = (LAS int*)(lds + TAB_OFF);

    if (IN(0)) { PH_VIEW();
        LAS float* scr = (LAS float*)(lds + wave * 16384);
        for (int it = gw; it < NI_MAIN; it += NGW) conv_item_main(A, it, scr, lane);
        for (int i = wg * NTHR + tid; i < 2 * 28672; i += G * NTHR) { const int l = i / 28672, r = i % 28672; ((v4u*)((bf16*)(ws + WS_WIN) + ((size_t)l * NIN + 4128) * 1024))[r] = (v4u){0u, 0u, 0u, 0u}; }
        __syncthreads();
        for (int it = wg; it < 192; it += G) mod_item(A, it, lds, tid, lane, wave);
        if (wg == G - 1) for (int i = tid; i < 1024; i += NTHR) { const int d = i >> 9, ch = i & 511; const float a0 = A->in[I_HLB][d * 512 + ch], a1 = A->in[I_HLB][(2 + d) * 512 + ch];
            mods[MO_LB + d * 512 + ch] = 0.f; mods[MO_LB + 1024 + d * 512 + ch] = 1.f / (1.f + __expf(a0 - a1)); }
    }
    BAR(0);
#pragma nounroll
    for (int l = 0; l < 2; ++l) {
        const int pb = l ? 9 : 1;
        if (IN(pb)) { PH_VIEW(); LAYER_VIEW();
            for (int m = gw; m < MT; m += NGW) { f32x4 y[4]; const bool lat = m < ML; const float* md = lat ? mlat + (m >> 11) * 6144 : mctx;
                ada_norm_row(lat ? xlat + (size_t)m * D : xctx + (size_t)(m - ML) * D, Hb + (size_t)m * D, A->in[I_N1G] + l * D, md, md + 1024, lane, y); }
        }
        BAR(pb);
        if (IN(pb + 1)) { PH_VIEW(); LAYER_VIEW();
            pg8::Gemm g{Hb, (const bf16*)(ws + WS_WIN) + (size_t)l * NIN * 1024, MT, NIN, D}; pg8::StaticOrder S; S.init(MT, NIN, G, wg);
            EpiInProj E{Pb, Gb, GRb, mods + MO_LB + l * 1024};
            pg8::gemm_phase<EpiInProj, pg8::StaticOrder, true, true>(lds, g, S, E);
        }
        BAR(pb + 1);
        if (IN(pb + 2)) { PH_VIEW(); LAYER_VIEW();
            for (int s = wg; s < 256; s += G) { const int grp = s >> 7, r = s & 127, b = r >> 3, hd = (r >> 1) & 3, dir = r & 1;
                bf16* OUT = dir ? OBb : Hb;
                const float* w2 = A->in[I_GW2] + (size_t)(l * 2 + dir) * 16 * 256; const float* gb = A->in[I_GB] + (l * 2 + dir) * 256;
                if (grp == 0) scan_simple<64>(lds, Pb, GRb, w2, gb, OUT, grp, b, hd, dir, tid); else scan_simple<128>(lds, Pb, GRb, w2, gb, OUT, grp, b, hd, dir, tid); }
        }
        BAR(pb + 2);
        if (IN(pb + 3)) { PH_VIEW(); LAYER_VIEW();
            const int nrow = l ? ML : MT;
            for (int m = gw; m < nrow; m += NGW) mix_row(Hb + (size_t)m * D, OBb + (size_t)m * D, Gb + (size_t)m * D, A->in[I_GLAG] + l * 128, A->in[I_HGG] + l * 128, MIXb + (size_t)m * D, lane);
            if (l == 1) { LAS float* scr = (LAS float*)(lds + wave * 16384); for (int it = gw; it < NI_MOE; it += NGW) conv_item_moe(A, it, scr, lane); }
        }
        BAR(pb + 3);
        if (IN(pb + 4)) { PH_VIEW(); LAYER_VIEW();
            const int Mw = l ? ML : MT;
            pg8::Gemm g{MIXb, (const bf16*)(ws + WS_WOUT) + (size_t)l * 1024 * 1024, Mw, D, D}; pg8::StaticOrder S; S.init(Mw, D, G, wg);
            EpiResid E{xlat, xctx, XL, XC, mlat + 2048, mctx + 2048};
            pg8::gemm_phase<EpiResid, pg8::StaticOrder, true, true>(lds, g, S, E);
        }
        BAR(pb + 4);
        if (l == 0) {
            if (IN(6)) { PH_VIEW(); LAYER_VIEW();
                for (int m = gw; m < MT; m += NGW) { f32x4 y[4]; const bool lat = m < ML; const float* md = lat ? mlat + (m >> 11) * 6144 : mctx;
                    ada_norm_row(lat ? XL + (size_t)m * D : XC + (size_t)(m - ML) * D, Hb + (size_t)m * D, A->in[I_N2G], md + 3072, md + 4096, lane, y); }
            }
            BAR(6);
            if (IN(7)) { PH_VIEW(); LAYER_VIEW();
                pg8::Gemm g{Hb, (const bf16*)(ws + WS_F13), MT, 2 * DFF, D}; pg8::StaticOrder S; S.init(MT, 2 * DFF, G, wg);
                EpiSwiGLU E{(bf16*)(ws + WS_ACT0), DFF, 22, 0};
                pg8::gemm_phase<EpiSwiGLU, pg8::StaticOrder, true, true>(lds, g, S, E);
            }
            BAR(7);
            if (IN(8)) { PH_VIEW(); LAYER_VIEW();
                pg8::Gemm g{(const bf16*)(ws + WS_ACT0), (const bf16*)(ws + WS_F2), MT, D, DFF}; pg8::StaticOrder S; S.init(MT, D, G, wg);
                EpiResid E{XL, XC, XL, XC, mlat + 5120, mctx + 5120};
                pg8::gemm_phase<EpiResid, pg8::StaticOrder, true, true>(lds, g, S, E);
            }
            BAR(8);
        }
    }
    if (IN(14)) { PH_VIEW(); const float* mlat1 = mods + MO_LAT + 16 * 6144;
        LAS float* rt = (LAS float*)lds; LAS int* sE = (LAS int*)(lds + 32768); LAS float* sW = (LAS float*)(lds + 32768 + 1024); LAS int* sL = (LAS int*)(lds + 32768 + 2048);
        for (int idx = tid; idx < 8192; idx += NTHR) { const int k = idx >> 3, e = idx & 7; rt[e * 1024 + k] = A->in[I_ROUTER][idx]; }
        __syncthreads();
        for (int rr = 0; rr < 16; ++rr) { const int tl = wave * 16 + rr, row = wg * 128 + tl; f32x4 y[4]; const float* md = mlat1 + (row >> 11) * 6144;
            ada_norm_row(XL + (size_t)row * D, Hb + (size_t)row * D, A->in[I_N2G] + D, md + 3072, md + 4096, lane, y);
            float lg[8];
#pragma unroll
            for (int e = 0; e < 8; ++e) { float p = 0.f;
#pragma unroll
                for (int j = 0; j < 4; ++j) { const f32x4 r4 = ((const LAS f32x4*)(rt + e * 1024))[lane + 64 * j]; p += (y[j].x * r4.x + y[j].y * r4.y) + (y[j].z * r4.z + y[j].w * r4.w); }
                lg[e] = wave_sum(p); }
            int i0 = 0; float v0 = lg[0];
#pragma unroll
            for (int e = 1; e < 8; ++e) if (lg[e] > v0) { v0 = lg[e]; i0 = e; }
            int i1 = -1; float v1 = -3.0e38f;
#pragma unroll
            for (int e = 0; e < 8; ++e) if (e != i0 && lg[e] > v1) { v1 = lg[e]; i1 = e; }
            const float w0 = 1.f / (1.f + __expf(v1 - v0));
            if (lane == 0) { sE[2 * tl] = i0; sE[2 * tl + 1] = i1; sW[2 * tl] = w0; sW[2 * tl + 1] = 1.f - w0; } }
        __syncthreads();
        if (tid < 8) { int cnt = 0; for (int t = 0; t < 256; ++t) if (sE[t] == tid) sL[t] = cnt++; ((int*)(ws + WS_ROUTE + RT_CNT))[wg * 8 + tid] = cnt; }
        __syncthreads();
        if (tid < 128) { const int row = wg * 128 + tid; ((v4i*)(ws + WS_ROUTE + RT_SEL))[row] = (v4i){sE[2 * tid], sE[2 * tid + 1], sL[2 * tid], sL[2 * tid + 1]};
            ((f32x2v*)(ws + WS_ROUTE + RT_W))[row] = (f32x2v){sW[2 * tid], sW[2 * tid + 1]}; }
    }
    BAR(14);
    if (kargs()->ph_lo >= 16 && kargs()->ph_lo <= 26) moe_tab(kargs(), lds, threadIdx.x, blockIdx.x);
    if (IN(15)) { PH_VIEW();
        moe_tab(kargs(), lds, tid, wg);
        for (int t = wave; t < 128; t += NWAVES) { const int row = wg * 128 + t; v4i* selp = (v4i*)(ws + WS_ROUTE + RT_SEL) + row; const v4i sel = *selp; const f32x2v w = ((const f32x2v*)(ws + WS_ROUTE + RT_W))[row];
            const int s0 = tab[16 + sel.x] * 256 + tab[8 + sel.x] + sel.z, s1 = tab[16 + sel.y] * 256 + tab[8 + sel.y] + sel.w;
            const v4u* src = (const v4u*)(Hb + (size_t)row * D) + 2 * lane; const v4u a0 = src[0], a1 = src[1];
            v4u* d0 = (v4u*)((bf16*)(ws + WS_HS) + (size_t)s0 * D) + 2 * lane; d0[0] = a0; d0[1] = a1;
            v4u* d1 = (v4u*)((bf16*)(ws + WS_HS) + (size_t)s1 * D) + 2 * lane; d1[0] = a0; d1[1] = a1;
            if (lane == 0) { float* gwp = (float*)(ws + WS_ROUTE + RT_GW); gwp[s0] = w.x; gwp[s1] = w.y; *selp = (v4i){sel.x, sel.y, s0, s1}; } }
    }
    BAR(15);
#pragma nounroll
    for (int c = 0; c < 5; ++c) {
        const int TP = tab[24], pan0 = CHUNK_PAN * c; int nM = TP - pan0; nM = nM > CHUNK_PAN ? CHUNK_PAN : nM;
        if (IN(16 + 2 * c) && nM > 0) { PH_VIEW();
            pg8::Gemm g{(const bf16*)(ws + WS_HS), (const bf16*)(ws + WS_M13), 0, 0, D}; MoeOrder S; S.init(nM, 28, G, wg, pan0, 0);
#pragma unroll
            for (int e = 0; e < 8; ++e) S.pb[e] = __builtin_amdgcn_readfirstlane(tab[16 + e]);
            EpiSwiGLU E{(bf16*)(ws + WS_ACT), DEXP, 28, pan0};
            pg8::gemm_phase<EpiSwiGLU, MoeOrder, true, true>(lds, g, S, E);
        }
        BAR(16 + 2 * c);
        if (IN(17 + 2 * c) && nM > 0) { PH_VIEW();
            pg8::Gemm g{(const bf16*)(ws + WS_ACT), (const bf16*)(ws + WS_M2), 0, 0, DEXP}; MoeOrder S; S.init(nM, 4, G, wg, pan0, 1);
#pragma unroll
            for (int e = 0; e < 8; ++e) S.pb[e] = __builtin_amdgcn_readfirstlane(tab[16 + e]);
            EpiMoeOut E{(bf16*)(ws + WS_HS), (const float*)(ws + WS_ROUTE + RT_GW), pan0};
            pg8::gemm_phase<EpiMoeOut, MoeOrder, true, true>(lds, g, S, E);
        }
        BAR(17 + 2 * c);
    }
    if (IN(26)) { PH_VIEW(); const float* mlat1 = mods + MO_LAT + 16 * 6144;
        unsigned bad = __hip_atomic_load((unsigned*)(ws + WS_CTL) + CW_BAR + XB_TMO, __ATOMIC_RELAXED, __HIP_MEMORY_SCOPE_AGENT);
        const bf16* Y = (const bf16*)(ws + WS_HS);
        for (int m = gw; m < ML; m += NGW) { const v4i sel = ((const v4i*)(ws + WS_ROUTE + RT_SEL))[m]; const float* md = mlat1 + (m >> 11) * 6144 + 5120;
            f32x4* xr = (f32x4*)(XL + (size_t)m * D) + lane; const v2u* y0 = (const v2u*)(Y + (size_t)sel.z * D) + lane; const v2u* y1 = (const v2u*)(Y + (size_t)sel.w * D) + lane;
            f32x4 v[4]; float s = 0.f;
#pragma unroll
            for (int j = 0; j < 4; ++j) { const f32x4 x = xr[64 * j], gt = ((const f32x4*)md)[lane + 64 * j]; const v2u a = y0[64 * j], b = y1[64 * j];
                const f32x4 yy = {bflo(a.x) + bflo(b.x), bfhi(a.x) + bfhi(b.x), bflo(a.y) + bflo(b.y), bfhi(a.y) + bfhi(b.y)};
                v[j] = x + gt * yy; s += (v[j].x * v[j].x + v[j].y * v[j].y) + (v[j].z * v[j].z + v[j].w * v[j].w); }
            const float rstd = rsqrtf(wave_sum(s) * (1.f / D) + EPS);
#pragma unroll
            for (int j = 0; j < 4; ++j) { f32x4 o = v[j] * rstd * ((const f32x4*)A->in[I_FNG])[lane + 64 * j]; if (bad) o = (f32x4){__builtin_nanf(""), __builtin_nanf(""), __builtin_nanf(""), __builtin_nanf("")}; xr[64 * j] = o; } }
    }
#undef IN
#undef BAR
}

extern "C" void kernel_launch(void* const* d_in, const int* in_sizes, int n_in, void* d_out, int out_size, void* d_ws, size_t ws_size, hipStream_t stream) {
    static int grid = 0;
    if (grid == 0) {
        if (n_in != 23 || in_sizes[0] != ML * D || out_size != ML * D || ws_size < WS_END) { fprintf(stderr, "kernel_launch: unexpected shapes (n_in %d, in0 %d, out %d, ws %zu, need %zu); nothing launched\n", n_in, n_in > 0 ? in_sizes[0] : -1, out_size, ws_size, (size_t)WS_END); grid = -1; return; }
        int dev = 0, cus = 0, per_cu = 0;
        if (hipGetDevice(&dev) != hipSuccess || hipDeviceGetAttribute(&cus, hipDeviceAttributeMultiprocessorCount, dev) != hipSuccess) { grid = -1; return; }
        if (hipFuncSetAttribute((const void*)fwd_kernel, hipFuncAttributeMaxDynamicSharedMemorySize, LDS_BYTES) != hipSuccess) { fprintf(stderr, "kernel_launch: hipFuncSetAttribute failed\n"); grid = -1; return; }
        if (hipOccupancyMaxActiveBlocksPerMultiprocessor(&per_cu, (const void*)fwd_kernel, NTHR, LDS_BYTES) != hipSuccess || per_cu < 1) fprintf(stderr, "kernel_launch: occupancy query reports %d\n", per_cu);
        (void)hipGetLastError();
        if (cus < 256) { fprintf(stderr, "kernel_launch: needs 256 CUs, device has %d\n", cus); grid = -1; return; }
        grid = 256;
    }
    if (grid < 0) return;
    if (hipMemsetAsync((char*)d_ws + WS_CTL, 0, CTL_ZERO_BYTES, stream) != hipSuccess) return;
    Args a{};
    for (int i = 0; i < 23; ++i) a.in[i] = (const float*)d_in[i];
    a.out = (float*)d_out; a.ws = (unsigned char*)d_ws;
#if MK_MULTI
    for (int k = 0; k < NPHASE; ++k) { a.ph_lo = k; a.ph_hi = k + 1; hipLaunchKernelGGL(fwd_kernel, dim3(grid), dim3(NTHR), LDS_BYTES, stream, a); }
#else
    a.ph_lo = 0; a.ph_hi = NPHASE; hipLaunchKernelGGL(fwd_kernel, dim3(grid), dim3(NTHR), LDS_BYTES, stream, a);
#endif
}
```

```cpp
#include <hip/hip_runtime.h>
#include <cstdio>
#include <cstdint>
#ifndef MK_MULTI
#define MK_MULTI 0
#endif
namespace pg8 {
#define PG8_LAS __attribute__((address_space(3)))
typedef unsigned short bf16_t;
typedef short bf16x8 __attribute__((ext_vector_type(8)));
typedef float f32x4 __attribute__((ext_vector_type(4)));
typedef unsigned u32x4 __attribute__((ext_vector_type(4)));
constexpr int BM = 256, BK = 64, HALF = 128, HTB = HALF * BK * 2  , STAGE_BYTES = 8 * HTB, NXCD = 8, WGM = 8;

__host__ __device__ __forceinline__ int lds_byte(int r, int c) { const int st = (r >> 4) * 2 + (c >> 5), rr = r & 15, cc = c & 31, ob = rr * 64 + cc * 2; return st * 1024 + (ob ^ (((ob >> 9) & 1) << 5)); }
__host__ __device__ __forceinline__ void stage_rc(int b, int& R, int& C) { const int st = b / 1024, sb = b % 1024, swz = sb ^ (((sb >> 9) & 1) << 5); R = (st >> 1) * 16 + swz / 64; C = (st & 1) * 32 + (swz % 64) / 2; }
__host__ __device__ __forceinline__ int perm32(int rho) { const int n = rho >> 4, i = rho & 15; return 8 * (i >> 2) + 4 * n + (i & 3); }

struct Unit { int pm, pn; };
struct Gemm { const bf16_t* A; const bf16_t* Bt; int M, N, K; };

struct StaticOrder {
    int nM, nN, nwg, G, c;
    __host__ __device__ void init(int M, int N, int G_, int c_) { nM = M / BM; nN = N / BM; nwg = nM * nN; G = G_; c = c_; }
    __host__ __device__ bool next(int i, Unit& u) const {
        const long L = (long)i * G + c; if (L >= nwg) return false;
        int wgid = (int)L; { const int q = nwg / NXCD, r = nwg % NXCD, xcd = wgid % NXCD, off = wgid / NXCD; wgid = (xcd < r ? xcd * (q + 1) : r * (q + 1) + (xcd - r) * q) + off; }
        const int nig = WGM * nN, gid = wgid / nig, fm = gid * WGM, gsz = (nM - fm) < WGM ? (nM - fm) : WGM;
        u.pm = fm + ((wgid % nig) % gsz); u.pn = (wgid % nig) / gsz; return true;
    }
    __device__ __forceinline__ void a_ready(const Unit&) const {}
    __device__ __forceinline__ void done(const Unit&) const {}
};
__device__ __forceinline__ unsigned cvt_pk_bf16(float lo, float hi) { unsigned r; asm volatile("v_cvt_pk_bf16_f32 %0, %1, %2" : "=v"(r) : "v"(lo), "v"(hi)); return r; }
typedef float f32x2 __attribute__((ext_vector_type(2)));
template <class Epi, class Sched, bool ALIGN_EPI = false, bool SP2 = false>
__device__ __forceinline__ void gemm_phase(PG8_LAS unsigned char* lds, const Gemm g, const Sched& S, const Epi& E) {
    int tid_l = threadIdx.x; asm volatile("" : "+v"(tid_l));
    const int tid = tid_l, wid = __builtin_amdgcn_readfirstlane(tid >> 6), lane = tid & 63, wr = wid >> 2, wc = wid & 3, fr = lane & 15, fq = lane >> 4;
    const int K = g.K, nt = K / BK;
    unsigned voffA[2], voffB[2];
#pragma unroll
    for (int i = 0; i < 2; ++i) { int R, C; stage_rc(tid * 16 + i * 8192, R, C); const int Rb = Epi::PERM ? ((R & ~31) + perm32(R & 31)) : R;
        voffA[i] = (unsigned)(R * K + C) * 2u; voffB[i] = (unsigned)(Rb * K + C) * 2u; }
    const size_t kstep = (size_t)(BK * 2);
    const size_t hstep = (size_t)HALF * K * 2;
    const size_t tstep = 2 * hstep;
    const unsigned ldsw = (unsigned)wid * 1024u;
    const int aoff = lds_byte(wr * 64 + fr, fq * 8), boff = lds_byte(wc * 32 + fr, fq * 8);
#define PG8_SA(b, h) (((b) * 2 + (h)) * HTB)
#define PG8_SB(b, h) ((4 + (b) * 2 + (h)) * HTB)
#define PG8_STAGE(bufoff, gbase, voff) do { _Pragma("unroll") for (int _i = 0; _i < 2; ++_i) \
        __builtin_amdgcn_global_load_lds((const unsigned*)((const char*)(gbase) + (voff)[_i]), (PG8_LAS unsigned*)(lds + (bufoff) + ldsw + _i * 8192), 16, 0, 0); } while (0)
#define PG8_LDA(dst, b, h) do { _Pragma("unroll") for (int m = 0; m < 4; ++m) _Pragma("unroll") for (int k = 0; k < 2; ++k) dst[m][k] = *(const PG8_LAS bf16x8*)(lds + PG8_SA(b, h) + aoff + m * 2048 + k * 1024); } while (0)
#define PG8_LDB(dst, b, h) do { _Pragma("unroll") for (int n = 0; n < 2; ++n) _Pragma("unroll") for (int k = 0; k < 2; ++k) dst[n][k] = *(const PG8_LAS bf16x8*)(lds + PG8_SB(b, h) + boff + n * 2048 + k * 1024); } while (0)
#define PG8_MMA(ai, bj, At, Bt) do { __builtin_amdgcn_s_setprio(1); _Pragma("unroll") for (int m = 0; m < 4; ++m) _Pragma("unroll") for (int n = 0; n < 2; ++n) _Pragma("unroll") for (int k = 0; k < 2; ++k) \
        acc[ai][bj][m][n] = __builtin_amdgcn_mfma_f32_16x16x32_bf16(Bt[n][k], At[m][k], acc[ai][bj][m][n], 0, 0, 0); __builtin_amdgcn_s_setprio(0); } while (0)
#define PG8_WAIT_V(n) asm volatile("s_waitcnt vmcnt(" #n ")" ::: "memory")
#define PG8_WAIT_L(n) asm volatile("s_waitcnt lgkmcnt(" #n ")" ::: "memory")
#define PG8_BAR __builtin_amdgcn_s_barrier()
#define PG8_SCHED __builtin_amdgcn_sched_barrier(0)
    Unit cur, nxt; int ui = 0;
    if (!S.next(0, cur)) return;
    f32x4 acc[2][2][4][2];
#pragma unroll
    for (int a = 0; a < 2; ++a)
#pragma unroll
        for (int b = 0; b < 2; ++b)
#pragma unroll
            for (int m = 0; m < 4; ++m)
#pragma unroll
                for (int n = 0; n < 2; ++n) acc[a][b][m][n] = (f32x4){0.f, 0.f, 0.f, 0.f};
    bf16x8 At[4][2], B0[2][2], B1[2][2];
    const char* cA = (const char*)g.A + (size_t)cur.pm * tstep; const char* cB = (const char*)g.Bt + (size_t)cur.pn * tstep;
    S.a_ready(cur);
    if constexpr (SP2) {
        PG8_STAGE(PG8_SB(0, 0), cB, voffB); PG8_STAGE(PG8_SB(0, 1), cB + hstep, voffB); PG8_STAGE(PG8_SA(0, 0), cA, voffA); PG8_STAGE(PG8_SA(0, 1), cA + hstep, voffA);
        if (wr == 1) PG8_BAR;
        PG8_WAIT_V(2); PG8_BAR;
        PG8_STAGE(PG8_SB(1, 0), cB + kstep, voffB); PG8_STAGE(PG8_SA(1, 0), cA + kstep, voffA); PG8_STAGE(PG8_SB(1, 1), cB + hstep + kstep, voffB);
        PG8_WAIT_V(6); PG8_BAR;
    } else {
        PG8_STAGE(PG8_SB(0, 0), cB, voffB); PG8_STAGE(PG8_SA(0, 0), cA, voffA); PG8_STAGE(PG8_SB(0, 1), cB + hstep, voffB); PG8_STAGE(PG8_SA(0, 1), cA + hstep, voffA);
        if (wr == 1) PG8_BAR;
        PG8_WAIT_V(4); PG8_BAR;
        PG8_STAGE(PG8_SB(1, 0), cB + kstep, voffB); PG8_STAGE(PG8_SA(1, 0), cA + kstep, voffA); PG8_STAGE(PG8_SB(1, 1), cB + hstep + kstep, voffB);
        PG8_WAIT_V(6); PG8_BAR;
    }
    for (;;) {
        const bool has_next = S.next(ui + 1, nxt);
        const char* nA = has_next ? (const char*)g.A + (size_t)nxt.pm * tstep : cA; const char* nB = has_next ? (const char*)g.Bt + (size_t)nxt.pn * tstep : cB;
        for (int t = 0; t < nt; t += 2) {
            const bool last = (t == nt - 2);
            const char* a1 = cA + (size_t)(t + 1) * kstep;
            const char* a2 = last ? nA : cA + (size_t)(t + 2) * kstep; const char* b2 = last ? nB : cB + (size_t)(t + 2) * kstep;
            const char* a3 = a2 + kstep; const char* b3 = b2 + kstep;
            if (last && has_next) S.a_ready(nxt);
            if constexpr (SP2) {
            PG8_LDB(B0, 0, 0); PG8_LDB(B1, 0, 1); PG8_SCHED; PG8_LDA(At, 0, 0); PG8_STAGE(PG8_SA(1, 1), a1 + hstep, voffA);
            PG8_WAIT_V(8); PG8_WAIT_L(0); PG8_BAR; PG8_MMA(0, 0, At, B0); PG8_MMA(0, 1, At, B1); PG8_BAR; PG8_SCHED;
            PG8_LDA(At, 0, 1); PG8_STAGE(PG8_SB(0, 0), b2, voffB); PG8_STAGE(PG8_SB(0, 1), b2 + hstep, voffB); PG8_STAGE(PG8_SA(0, 0), a2, voffA);
            PG8_WAIT_V(8); PG8_WAIT_L(0); PG8_BAR; PG8_MMA(1, 0, At, B0); PG8_MMA(1, 1, At, B1); PG8_BAR; PG8_SCHED;
            PG8_LDB(B0, 1, 0); PG8_LDB(B1, 1, 1); PG8_SCHED; PG8_LDA(At, 1, 0); PG8_STAGE(PG8_SA(0, 1), a2 + hstep, voffA);
            PG8_WAIT_V(8); PG8_WAIT_L(0); PG8_BAR; PG8_MMA(0, 0, At, B0); PG8_MMA(0, 1, At, B1); PG8_BAR; PG8_SCHED;
            PG8_LDA(At, 1, 1); PG8_STAGE(PG8_SB(1, 0), b3, voffB); PG8_STAGE(PG8_SB(1, 1), b3 + hstep, voffB); PG8_STAGE(PG8_SA(1, 0), a3, voffA);
            PG8_WAIT_V(8); PG8_WAIT_L(0); PG8_BAR; PG8_MMA(1, 0, At, B0); PG8_MMA(1, 1, At, B1); PG8_BAR; PG8_SCHED;
            } else {
            PG8_LDB(B0, 0, 0); PG8_SCHED; PG8_LDA(At, 0, 0); PG8_STAGE(PG8_SA(1, 1), a1 + hstep, voffA);
            PG8_WAIT_L(8); PG8_BAR; PG8_WAIT_L(0); PG8_MMA(0, 0, At, B0); PG8_BAR; PG8_SCHED;
            PG8_LDB(B1, 0, 1); PG8_STAGE(PG8_SB(0, 0), b2, voffB);
            PG8_BAR; PG8_WAIT_L(0); PG8_MMA(0, 1, At, B1); PG8_BAR;
            PG8_LDA(At, 0, 1); PG8_STAGE(PG8_SA(0, 0), a2, voffA);
            PG8_BAR; PG8_WAIT_L(0); PG8_MMA(1, 0, At, B0); PG8_BAR; PG8_SCHED;
            PG8_STAGE(PG8_SB(0, 1), b2 + hstep, voffB);
            PG8_WAIT_V(6); PG8_BAR; PG8_MMA(1, 1, At, B1); PG8_BAR;
            PG8_LDB(B0, 1, 0); PG8_SCHED; PG8_LDA(At, 1, 0); PG8_STAGE(PG8_SA(0, 1), a2 + hstep, voffA);
            PG8_WAIT_L(8); PG8_BAR; PG8_WAIT_L(0); PG8_MMA(0, 0, At, B0); PG8_BAR; PG8_SCHED;
            PG8_LDB(B1, 1, 1); PG8_STAGE(PG8_SB(1, 0), b3, voffB);
            PG8_BAR; PG8_WAIT_L(0); PG8_MMA(0, 1, At, B1); PG8_BAR;
            PG8_LDA(At, 1, 1); PG8_STAGE(PG8_SA(1, 0), a3, voffA);
            PG8_BAR; PG8_WAIT_L(0); PG8_MMA(1, 0, At, B0); PG8_BAR; PG8_SCHED;
            PG8_STAGE(PG8_SB(1, 1), b3 + hstep, voffB);
            PG8_WAIT_V(6); PG8_BAR; PG8_MMA(1, 1, At, B1); PG8_BAR;
            }
        }
        if constexpr (ALIGN_EPI) { if (wr == 0) PG8_BAR; }
        if constexpr (!Epi::AFTER_DRAIN) { E(acc, cur, wr, wc, fr, fq); S.done(cur); }
        if (!has_next) break;
#pragma unroll
        for (int a = 0; a < 2; ++a)
#pragma unroll
            for (int b = 0; b < 2; ++b)
#pragma unroll
                for (int m = 0; m < 4; ++m)
#pragma unroll
                    for (int n = 0; n < 2; ++n) acc[a][b][m][n] = (f32x4){0.f, 0.f, 0.f, 0.f};
        cur = nxt; cA = nA; cB = nB; ++ui;
        if constexpr (ALIGN_EPI) { if (wr == 1) PG8_BAR; }
    }
    PG8_WAIT_V(0);
    if constexpr (!ALIGN_EPI) { if (wr == 0) PG8_BAR; }
    PG8_BAR;
    if constexpr (Epi::AFTER_DRAIN) { E.fused(acc, cur, wr, wc, fr, fq, lds, wid, lane); S.done(cur); }
#undef PG8_SA
#undef PG8_SB
#undef PG8_STAGE
#undef PG8_LDA
#undef PG8_LDB
#undef PG8_MMA
#undef PG8_WAIT_V
#undef PG8_WAIT_L
#undef PG8_BAR
#undef PG8_SCHED
}
}
constexpr int NB = 16, SEQ = 2048, CTXL = 256, D = 1024;
constexpr int ML = NB * SEQ, MC = NB * CTXL, MT = ML + MC;
constexpr int INW = 4128, PW = 4096, NIN = 4352;
constexpr int DFF = 2816, NEXP = 8, DEXP = 3584;
constexpr int NWAVES = 8, NTHR = 512;
constexpr float EPS = 1e-6f;
constexpr int NPHASE = 27;
constexpr int CHUNK_PAN = 64;
constexpr int HS_ROWS = 2 * ML + NEXP * 256;

constexpr size_t MiB = 1u << 20;
constexpr size_t WS_CTL = 0, CTL_ZERO_BYTES = 1 * MiB;
constexpr size_t WS_MODS = 1 * MiB, WS_ROUTE = 2 * MiB, WS_GR = 4 * MiB, WS_WIN = 7 * MiB, WS_WOUT = 24 * MiB, WS_F13 = 28 * MiB, WS_F2 = 39 * MiB;
constexpr size_t WS_XC = 45 * MiB, WS_H = 61 * MiB, WS_OB = 133 * MiB, WS_G = 205 * MiB, WS_P = 277 * MiB, WS_END = 565 * MiB;
constexpr size_t WS_MIX = WS_P, WS_ACT0 = WS_P, WS_HS = WS_OB, WS_ACT = 265 * MiB, WS_M13 = 397 * MiB, WS_M2 = 509 * MiB;
static_assert(WS_GR + (size_t)MT * 32 * 2 <= WS_WIN && WS_WIN + 2ull * NIN * 1024 * 2 <= WS_WOUT && WS_F13 + 5632ull * 1024 * 2 <= WS_F2 && WS_F2 + 1024ull * DFF * 2 <= WS_XC, "ws map 1");
static_assert(WS_XC + (size_t)MC * D * 4 <= WS_H && WS_H + (size_t)MT * D * 2 <= WS_OB && WS_OB + (size_t)MT * D * 2 <= WS_G && WS_G + (size_t)MT * D * 2 <= WS_P && WS_P + (size_t)MT * PW * 2 <= WS_END, "ws map 2");
static_assert(WS_ACT0 + (size_t)MT * DFF * 2 <= WS_END && WS_HS + (size_t)HS_ROWS * D * 2 <= WS_ACT && WS_ACT + (size_t)CHUNK_PAN * 256 * DEXP * 2 <= WS_M13 && WS_M13 + 8ull * 7168 * 1024 * 2 <= WS_M2 && WS_M2 + 8ull * 1024 * DEXP * 2 <= WS_END, "ws map 3");
static_assert(WS_MIX + (size_t)MT * D * 2 <= WS_M13, "mix vs moe weights");
constexpr int MO_LAT = 0, MO_CTX = 2 * 16 * 6144, MO_LB = MO_CTX + 2 * 6144;
constexpr size_t RT_SEL = 0, RT_W = 512 * 1024, RT_CNT = 768 * 1024, RT_GW = 1024 * 1024;
constexpr int CW_TMO = 0, CW_CODE = 1, CW_BAR = 4096;
constexpr int RING_BYTES = 131072, LDSCTL_OFF = RING_BYTES, MISC_OFF = LDSCTL_OFF + 320, TAB_OFF = LDSCTL_OFF + 512, LDS_BYTES = 147456;

#define GAS __attribute__((address_space(1)))
#define LAS __attribute__((address_space(3)))
typedef unsigned short bf16;
typedef unsigned v4u __attribute__((ext_vector_type(4)));
typedef unsigned v2u __attribute__((ext_vector_type(2)));
typedef int v4i __attribute__((ext_vector_type(4)));
typedef float f32x4 __attribute__((ext_vector_type(4)));
typedef float f32x2v __attribute__((ext_vector_type(2)));
#define LDS_WAIT() asm volatile("s_waitcnt lgkmcnt(0)" ::: "memory")
#define VM_WAIT() asm volatile("s_waitcnt vmcnt(0)" ::: "memory")
__device__ __forceinline__ unsigned f2bf(float f) { unsigned u = __builtin_bit_cast(unsigned, f); return (u + 0x7fffu + ((u >> 16) & 1u)) >> 16; }
__device__ __forceinline__ unsigned pk2(float lo, float hi) { return f2bf(lo) | (f2bf(hi) << 16); }
__device__ __forceinline__ float bf2f(unsigned b) { return __builtin_bit_cast(float, b << 16); }
__device__ __forceinline__ float bflo(unsigned w) { return __builtin_bit_cast(float, w << 16); }
__device__ __forceinline__ float bfhi(unsigned w) { return __builtin_bit_cast(float, w & 0xffff0000u); }
__device__ __forceinline__ float wave_sum(float v) {
#pragma unroll
    for (int o = 1; o < 64; o <<= 1) v += __shfl_xor(v, o);
    return v;
}
__device__ __forceinline__ float silu_f(float x) { return x / (1.f + __expf(-x)); }
__device__ __forceinline__ float logsig_f(float x) { return fminf(x, 0.f) - __logf(1.f + __expf(-fabsf(x))); }

#define XB_TMO      128
#define XB_XCNT(j)  (256  + 64 * (j))
#define XB_XSUB(j)  (1280 + 64 * (j))
#define XB_XGEN(j)  (2304 + 64 * (j))
#define XB_TOP      3328
#define XB_TOPGEN   3392
#define XCD_BAR_WORDS 3456
#define XB_SPIN_CAP (1u << 18)

__device__ __forceinline__ unsigned xb_ld(unsigned* p)              { return __hip_atomic_load(p, __ATOMIC_RELAXED, __HIP_MEMORY_SCOPE_AGENT); }
__device__ __forceinline__ unsigned xb_add(unsigned* p, unsigned v) { return __hip_atomic_fetch_add(p, v, __ATOMIC_RELAXED, __HIP_MEMORY_SCOPE_AGENT); }
__device__ __forceinline__ unsigned xb_xcc_id() { return (unsigned)__builtin_amdgcn_s_getreg((3 << 11) | 20) & 0xFu; }
#define XB_SPIN(cond, bar) do { unsigned _sp = 0; while (cond) { __builtin_amdgcn_s_sleep(1); \
    if ((++_sp & 255u) == 0u) { if (xb_ld(&(bar)[XB_TMO])) break; if (_sp > XB_SPIN_CAP) { atomicAdd(&(bar)[XB_TMO], 1u); break; } } } } while (0)

struct XcdBarrier {
    unsigned* bar; unsigned x;
    volatile LAS unsigned* st;
};

__device__ __forceinline__ XcdBarrier xcd_barrier_post(unsigned* bar, volatile LAS unsigned* st) {
    XcdBarrier b; b.bar = bar; b.x = xb_xcc_id(); b.st = st;
    if (threadIdx.x == 0) (void)xb_add(&bar[XB_XCNT(b.x)], 1u);
    return b;
}
__device__ __forceinline__ void xcd_barrier_complete(unsigned* bar, unsigned x, unsigned& nloc, unsigned& nx) {
    const unsigned G = gridDim.x * gridDim.y * gridDim.z;
    unsigned sum, cnt, mine, sp = 0u;
    for (;;) {
        sum = 0u; cnt = 0u; mine = 0u;
#pragma unroll
        for (unsigned j = 0; j < 16; ++j) { const unsigned c = xb_ld(&bar[XB_XCNT(j)]); sum += c; cnt += (c > 0u) ? 1u : 0u; mine = (j == x) ? c : mine; }
        if (sum == G) break;
        __builtin_amdgcn_s_sleep(1);
        if ((++sp & 255u) == 0u) { if (xb_ld(&bar[XB_TMO])) break; if (sp > XB_SPIN_CAP) { atomicAdd(&bar[XB_TMO], 1u); break; } }
    }
    nloc = mine > 0u ? mine : 1u; nx = cnt > 0u ? cnt : 1u;
}

__device__ __forceinline__ void xcd_barrier(const XcdBarrier& b) {
    asm volatile("s_waitcnt vmcnt(0)" ::: "memory");
    __syncthreads();
    if (threadIdx.x == 0) {
        unsigned* bar = b.bar;
        __builtin_amdgcn_s_waitcnt(0);
        unsigned nloc = b.st[0], nx = b.st[1];
        if (nloc == 0u) { xcd_barrier_complete(bar, b.x, nloc, nx); b.st[0] = nloc; b.st[1] = nx; }
        const unsigned old = xb_add(&bar[XB_XSUB(b.x)], 1u);
        const unsigned gen = old / nloc;
        if (old + 1u == (gen + 1u) * nloc) {
            __builtin_amdgcn_fence(__ATOMIC_RELEASE, "agent");
            asm volatile("s_waitcnt vmcnt(0)" ::: "memory");
            const unsigned og = xb_add(&bar[XB_TOP], 1u);
            const unsigned tg = og / nx;
            if (og + 1u == (tg + 1u) * nx) xb_add(&bar[XB_TOPGEN], 1u);
            else XB_SPIN(xb_ld(&bar[XB_TOPGEN]) == tg, bar);
            __builtin_amdgcn_fence(__ATOMIC_ACQUIRE, "agent");
            xb_add(&bar[XB_XGEN(b.x)], 1u);
            asm volatile("s_waitcnt vmcnt(0)" ::: "memory");
        } else {
            XB_SPIN(xb_ld(&bar[XB_XGEN(b.x)]) == gen, bar);
            __builtin_amdgcn_fence(__ATOMIC_ACQUIRE, "agent");
            asm volatile("s_waitcnt vmcnt(0)" ::: "memory");
        }
    }
    __syncthreads();
}
using pg8::Unit;
struct EpiInProj {
    static constexpr bool PERM = true, AFTER_DRAIN = false;
    bf16* P; bf16* G; bf16* GR; const float* LB;
    __device__ __forceinline__ void operator()(const pg8::f32x4 (&acc)[2][2][4][2], const Unit& u, int wr, int wc, int fr, int fq) const {
        const int pn = u.pn;
        const int row0 = u.pm * 256 + wr * 64 + fr, cin = wc * 32 + 8 * fq;
        if (pn == 16) {
            if (wc == 0) {
#pragma unroll
                for (int ai = 0; ai < 2; ++ai)
#pragma unroll
                    for (int m = 0; m < 4; ++m) { const pg8::f32x4 v0 = acc[ai][0][m][0], v1 = acc[ai][0][m][1]; v4u w; w.x = pk2(v0[0], v0[1]); w.y = pk2(v0[2], v0[3]); w.z = pk2(v1[0], v1[1]); w.w = pk2(v1[2], v1[3]);
                        *(v4u*)(GR + (size_t)(row0 + ai * 128 + m * 16) * 32 + 8 * fq) = w; }
            }
            return;
        }
        int mode, dcol, dcol2 = 0, ldd = PW; bf16* dst = P; const float* lbp = LB;
        if (pn == 0) { mode = 0; dcol = 0; }
        else if (pn <= 3) { mode = 1; dcol = 256 * pn; }
        else if (pn <= 5) { mode = 1; dst = G; ldd = 1024; dcol = 256 * (pn - 4); }
        else if (pn <= 7) { mode = 2; dcol = 1024 + 256 * (pn - 6); }
        else if (pn <= 9) { mode = 3; dcol = 1536 + 256 * (pn - 8); dcol2 = 2048 + 256 * (pn - 8); lbp = LB + 256 * (pn - 8); }
        else if (pn <= 11) { mode = 3; dcol = 2560 + 256 * (pn - 10); dcol2 = 3072 + 256 * (pn - 10); lbp = LB + 512 + 256 * (pn - 10); }
        else if (pn <= 13) { mode = 1; dcol = 3584 + 256 * (pn - 12); }
        else { mode = 1; dst = G; ldd = 1024; dcol = 512 + 256 * (pn - 14); }
        if (mode == 3) {
#pragma unroll
            for (int bj = 0; bj < 2; ++bj) {
                float lb[8];
#pragma unroll
                for (int j = 0; j < 8; ++j) lb[j] = lbp[bj * 128 + cin + j];
#pragma unroll
                for (int ai = 0; ai < 2; ++ai)
#pragma unroll
                    for (int m = 0; m < 4; ++m) {
                        const pg8::f32x4 v0 = acc[ai][bj][m][0], v1 = acc[ai][bj][m][1];
                        const float a[8] = {v0[0], v0[1], v0[2], v0[3], v1[0], v1[1], v1[2], v1[3]}; float kk[8], lf[8];
#pragma unroll
                        for (int j = 0; j < 8; ++j) { const float e = __expf(-fabsf(a[j])), r = 1.f / (1.f + e), big = r, sml = e * r; const float sg = a[j] >= 0.f ? big : sml, sn = a[j] >= 0.f ? sml : big;
                            kk[j] = (1.f - lb[j]) * sn; lf[j] = __logf(fmaxf(lb[j], 1e-30f) + (1.f - lb[j]) * sg); }
                        const size_t ro = (size_t)(row0 + ai * 128 + m * 16) * PW + bj * 128 + cin;
                        v4u w; w.x = pk2(kk[0], kk[1]); w.y = pk2(kk[2], kk[3]); w.z = pk2(kk[4], kk[5]); w.w = pk2(kk[6], kk[7]); *(v4u*)(P + ro + dcol) = w;
                        v4u x; x.x = pk2(lf[0], lf[1]); x.y = pk2(lf[2], lf[3]); x.z = pk2(lf[4], lf[5]); x.w = pk2(lf[6], lf[7]); *(v4u*)(P + ro + dcol2) = x;
                    }
            }
            return;
        }
#pragma unroll
        for (int ai = 0; ai < 2; ++ai)
#pragma unroll
            for (int m = 0; m < 4; ++m)
#pragma unroll
                for (int bj = 0; bj < 2; ++bj) {
                    const pg8::f32x4 v0 = acc[ai][bj][m][0], v1 = acc[ai][bj][m][1];
                    float a[8] = {v0[0], v0[1], v0[2], v0[3], v1[0], v1[1], v1[2], v1[3]};
                    if (mode == 0) {
#pragma unroll
                        for (int j = 0; j < 8; ++j) a[j] *= 0.125f;
                    } else if (mode == 2) {
#pragma unroll
                        for (int j = 0; j < 8; ++j) a[j] = silu_f(a[j]);
                    }
                    v4u w; w.x = pk2(a[0], a[1]); w.y = pk2(a[2], a[3]); w.z = pk2(a[4], a[5]); w.w = pk2(a[6], a[7]);
                    *(v4u*)(dst + (size_t)(row0 + ai * 128 + m * 16) * ldd + dcol + bj * 128 + cin) = w;
                }
    }
};
struct EpiResid {
    static constexpr bool PERM = false, AFTER_DRAIN = false;
    const float* base_lat; const float* base_ctx; float* out_lat; float* out_ctx; const float* gate_lat; const float* gate_ctx;
    __device__ __forceinline__ void operator()(const pg8::f32x4 (&acc)[2][2][4][2], const Unit& u, int wr, int wc, int fr, int fq) const {
        const int prow = u.pm * 256; const float* base; float* out; const float* gate; int r0;
        if (prow < ML) { base = base_lat; out = out_lat; gate = gate_lat + (prow >> 11) * 6144; r0 = prow; }
        else { base = base_ctx; out = out_ctx; gate = gate_ctx; r0 = prow - ML; }
        const int row0 = r0 + wr * 64 + fr, col0 = u.pn * 256 + wc * 32 + 4 * fq;
        pg8::f32x4 gv[2][2];
#pragma unroll
        for (int bj = 0; bj < 2; ++bj)
#pragma unroll
            for (int n = 0; n < 2; ++n) gv[bj][n] = *(const pg8::f32x4*)(gate + col0 + bj * 128 + n * 16);
#pragma unroll
        for (int ai = 0; ai < 2; ++ai)
#pragma unroll
            for (int m = 0; m < 4; ++m) { const size_t off = (size_t)(row0 + ai * 128 + m * 16) * D + col0;
#pragma unroll
                for (int bj = 0; bj < 2; ++bj)
#pragma unroll
                    for (int n = 0; n < 2; ++n) { const pg8::f32x4 bs = *(const pg8::f32x4*)(base + off + bj * 128 + n * 16); *(pg8::f32x4*)(out + off + bj * 128 + n * 16) = bs + gv[bj][n] * acc[ai][bj][m][n]; }
                asm volatile("" ::: "memory"); }
    }
};
struct EpiSwiGLU {
    static constexpr bool PERM = true, AFTER_DRAIN = false;
    bf16* ACT; int ldc, tiles, pm_off;
    __device__ __forceinline__ void operator()(const pg8::f32x4 (&acc)[2][2][4][2], const Unit& u, int wr, int wc, int fr, int fq) const {
        const int row0 = (u.pm - pm_off) * 256 + wr * 64 + fr, col0 = (u.pn % tiles) * 128 + wc * 32 + 8 * fq;
#pragma unroll
        for (int ai = 0; ai < 2; ++ai)
#pragma unroll
            for (int m = 0; m < 4; ++m) {
                const pg8::f32x4 g0 = acc[ai][0][m][0], g1 = acc[ai][0][m][1], u0 = acc[ai][1][m][0], u1 = acc[ai][1][m][1];
                float o[8];
#pragma unroll
                for (int j = 0; j < 4; ++j) { o[j] = silu_f(g0[j]) * u0[j]; o[4 + j] = silu_f(g1[j]) * u1[j]; }
                v4u w; w.x = pk2(o[0], o[1]); w.y = pk2(o[2], o[3]); w.z = pk2(o[4], o[5]); w.w = pk2(o[6], o[7]);
                *(v4u*)(ACT + (size_t)(row0 + ai * 128 + m * 16) * ldc + col0) = w;
            }
    }
};
struct EpiMoeOut {
    static constexpr bool PERM = true, AFTER_DRAIN = false;
    bf16* Y; const float* GW; int pm_off;
    __device__ __forceinline__ void operator()(const pg8::f32x4 (&acc)[2][2][4][2], const Unit& u, int wr, int wc, int fr, int fq) const {
        const int row0 = (u.pm + pm_off) * 256 + wr * 64 + fr, col0 = (u.pn & 3) * 256 + wc * 32 + 8 * fq;
#pragma unroll
        for (int ai = 0; ai < 2; ++ai)
#pragma unroll
            for (int m = 0; m < 4; ++m) { const int row = row0 + ai * 128 + m * 16; const float gw = GW[row];
#pragma unroll
                for (int bj = 0; bj < 2; ++bj) { const pg8::f32x4 v0 = acc[ai][bj][m][0] * gw, v1 = acc[ai][bj][m][1] * gw;
                    v4u w; w.x = pk2(v0[0], v0[1]); w.y = pk2(v0[2], v0[3]); w.z = pk2(v1[0], v1[1]); w.w = pk2(v1[2], v1[3]);
                    *(v4u*)(Y + (size_t)row * D + col0 + bj * 128) = w; } }
    }
};
struct MoeOrder {
    int nM, nN, nwg, G, c, pan0, a_local; int pb[8];
    __device__ __forceinline__ void init(int nM_, int nN_, int G_, int c_, int pan0_, int a_local_) { nM = nM_; nN = nN_; nwg = nM * nN; G = G_; c = c_; pan0 = pan0_; a_local = a_local_; }
    __device__ __forceinline__ bool next(int i, Unit& u) const {
        const long L = (long)i * G + c; if (L >= nwg) return false;
        int wgid = (int)L; { const int q = nwg / 8, r = nwg % 8, xcd = wgid % 8, off = wgid / 8; wgid = (xcd < r ? xcd * (q + 1) : r * (q + 1) + (xcd - r) * q) + off; }
        const int nig = 8 * nN, gid = wgid / nig, fm = gid * 8, gsz = (nM - fm) < 8 ? (nM - fm) : 8;
        const int pml = fm + ((wgid % nig) % gsz), pnl = (wgid % nig) / gsz, gp = pan0 + pml;
        int e = 0;
#pragma unroll
        for (int j = 1; j < 8; ++j) e += (gp >= pb[j]) ? 1 : 0;
        u.pm = a_local ? pml : gp; u.pn = e * nN + pnl; return true;
    }
    __device__ __forceinline__ void a_ready(const Unit&) const {}
    __device__ __forceinline__ void done(const Unit&) const {}
};

struct Args { const float* in[23]; float* out; unsigned char* ws; int ph_lo, ph_hi; };
typedef const __attribute__((address_space(4))) Args* KA;
__device__ __forceinline__ KA kargs() { KA p = (KA)__builtin_amdgcn_kernarg_segment_ptr(); asm volatile("" : "+s"(p)); return p; }
enum { I_X = 0, I_C, I_CTX, I_CCTX, I_WMOD, I_BMOD, I_N1G, I_N2G, I_WIN, I_GW2, I_GB, I_GLAG, I_HGG, I_HLB, I_WOUT, I_F1, I_F3, I_F2, I_ROUTER, I_M1, I_M3, I_M2, I_FNG };

__device__ __forceinline__ void tr_block(const float* W, int ldw, int col0, int k0, bf16* WT, int K, int drow0, LAS float* scr, int lane) {
#pragma unroll 8
    for (int i = 0; i < 32; ++i) { const int kk = 2 * i + (lane >> 5); scr[kk * 33 + (lane & 31)] = W[(size_t)(k0 + kk) * ldw + col0 + (lane & 31)]; }
    LDS_WAIT(); asm volatile("" ::: "memory");
    const int c = lane & 7;
#pragma unroll
    for (int j = 0; j < 4; ++j) { const int n = (lane >> 3) + 8 * j; const LAS float* s = scr + (8 * c) * 33 + n;
        v4u o; o.x = pk2(s[0 * 33], s[1 * 33]); o.y = pk2(s[2 * 33], s[3 * 33]); o.z = pk2(s[4 * 33], s[5 * 33]); o.w = pk2(s[6 * 33], s[7 * 33]);
        *(v4u*)(WT + (size_t)(drow0 + n) * K + k0 + 8 * c) = o; }
    LDS_WAIT(); asm volatile("" ::: "memory");
}
constexpr int NI_WIN = 2 * 16 * 129, NI_WOUT = 2 * 16 * 32, NI_F13 = 16 * 176, NI_F2 = 44 * 32, NI_MAIN = NI_WIN + NI_WOUT + NI_F13 + NI_F2;
constexpr int NI_M13E = 16 * 224, NI_M2E = 56 * 32, NI_M13 = 8 * NI_M13E, NI_MOE = NI_M13 + 8 * NI_M2E;
__device__ __forceinline__ void conv_item_main(KA a, int it, LAS float* scr, int lane) {
    unsigned char* ws = a->ws;
    if (it < NI_WIN) { const int l = it / 2064, r = it % 2064, kb = r / 129, nb = r % 129, drow = nb < 48 ? 32 * nb : (nb == 48 ? 4096 : 32 * (nb - 1));
        tr_block(a->in[I_WIN] + (size_t)l * 1024 * INW, INW, 32 * nb, 64 * kb, (bf16*)(ws + WS_WIN) + (size_t)l * NIN * 1024, 1024, drow, scr, lane); return; }
    it -= NI_WIN;
    if (it < NI_WOUT) { const int l = it / 512, r = it % 512, kb = r / 32, nb = r % 32;
        tr_block(a->in[I_WOUT] + (size_t)l * 1024 * 1024, 1024, 32 * nb, 64 * kb, (bf16*)(ws + WS_WOUT) + (size_t)l * 1024 * 1024, 1024, 32 * nb, scr, lane); return; }
    it -= NI_WOUT;
    if (it < NI_F13) { const int kb = it / 176, db = it % 176, drow = 32 * db, pn = drow >> 8, half = (drow >> 7) & 1, off = drow & 127;
        tr_block(half ? a->in[I_F3] : a->in[I_F1], DFF, 128 * pn + off, 64 * kb, (bf16*)(ws + WS_F13), 1024, drow, scr, lane); return; }
    it -= NI_F13;
    { const int kb = it / 32, nb = it % 32; tr_block(a->in[I_F2], 1024, 32 * nb, 64 * kb, (bf16*)(ws + WS_F2), DFF, 32 * nb, scr, lane); }
}
__device__ __forceinline__ void conv_item_moe(KA a, int it, LAS float* scr, int lane) {
    unsigned char* ws = a->ws;
    if (it < NI_M13) { const int e = it / NI_M13E, r = it % NI_M13E, kb = r / 224, db = r % 224, drow = 32 * db, pn = drow >> 8, half = (drow >> 7) & 1, off = drow & 127;
        tr_block((half ? a->in[I_M3] : a->in[I_M1]) + (size_t)e * 1024 * DEXP, DEXP, 128 * pn + off, 64 * kb, (bf16*)(ws + WS_M13) + (size_t)e * 7168 * 1024, 1024, drow, scr, lane); return; }
    it -= NI_M13;
    { const int e = it / NI_M2E, r = it % NI_M2E, kb = r / 32, nb = r % 32;
      tr_block(a->in[I_M2] + (size_t)e * DEXP * 1024, 1024, 32 * nb, 64 * kb, (bf16*)(ws + WS_M2) + (size_t)e * 1024 * DEXP, DEXP, 32 * nb, scr, lane); }
}
__device__ __forceinline__ void mod_item(KA a, int it, LAS unsigned char* lds, int tid, int lane, int wave) {
    LAS float* sc = (LAS float*)lds; LAS float* red = (LAS float*)(lds + 69632);
    const int l = it / 96, n0 = 64 * (it % 96);
    for (int idx = tid; idx < 17 * 1024; idx += NTHR) { const int r = idx >> 10, k = idx & 1023; const float v = r < 16 ? a->in[I_C][r * 1024 + k] : a->in[I_CCTX][k]; sc[k * 17 + r] = silu_f(v); }
    __syncthreads();
    float acc[17];
#pragma unroll
    for (int r = 0; r < 17; ++r) acc[r] = 0.f;
    const float* wm = a->in[I_WMOD] + (size_t)l * 1024 * 6144 + n0 + lane;
    for (int k = wave * 128; k < wave * 128 + 128; ++k) { const float w = wm[(size_t)k * 6144];
#pragma unroll
        for (int r = 0; r < 17; ++r) acc[r] += sc[k * 17 + r] * w; }
#pragma unroll
    for (int r = 0; r < 17; ++r) red[(wave * 17 + r) * 64 + lane] = acc[r];
    __syncthreads();
    float* mods = (float*)(a->ws + WS_MODS);
    for (int idx = tid; idx < 17 * 64; idx += NTHR) { const int r = idx >> 6, ln = idx & 63; float s = a->in[I_BMOD][l * 6144 + n0 + ln];
#pragma unroll
        for (int w = 0; w < 8; ++w) s += red[(w * 17 + r) * 64 + ln];
        if (r < 16) mods[MO_LAT + (l * 16 + r) * 6144 + n0 + ln] = s; else mods[MO_CTX + l * 6144 + n0 + ln] = s; }
    __syncthreads();
}
__device__ __forceinline__ void ada_norm_row(const float* xrow, bf16* orow, const float* g, const float* shift, const float* scale, int lane, f32x4 (&y)[4]) {
    const f32x4* xr = (const f32x4*)xrow + lane; float s = 0.f;
#pragma unroll
    for (int j = 0; j < 4; ++j) { y[j] = xr[64 * j]; s += (y[j].x * y[j].x + y[j].y * y[j].y) + (y[j].z * y[j].z + y[j].w * y[j].w); }
    const float rstd = rsqrtf(wave_sum(s) * (1.f / D) + EPS);
    v2u* o8 = (v2u*)orow + lane;
#pragma unroll
    for (int j = 0; j < 4; ++j) { const f32x4 gv = ((const f32x4*)g)[lane + 64 * j], sh = ((const f32x4*)shift)[lane + 64 * j], sc = ((const f32x4*)scale)[lane + 64 * j];
        y[j] = y[j] * rstd * gv * (sc + 1.f) + sh; v2u w; w.x = pk2(y[j].x, y[j].y); w.y = pk2(y[j].z, y[j].w); o8[64 * j] = w; }
}
__device__ __forceinline__ int scan_row(int grp, int b, int dir, int step) {
    if (step < CTXL) { const int t = dir ? (CTXL - 1 - step) : step; return ML + b * CTXL + t; }
    int lp = step - CTXL; if (dir) lp = SEQ - 1 - lp;
    const int t = grp ? ((lp & 31) * 64 + (lp >> 5)) : lp;
    return b * SEQ + t;
}
template <int DK> __device__ __forceinline__ void scan_simple(LAS unsigned char* lds, const bf16* P, const bf16* GR, const float* w2, const float* gb, bf16* OUT, int grp, int b, int hd, int dir, int tid) {
    LAS float* qs = (LAS float*)lds; LAS float* ks = qs + 32 * 128; LAS float* fs = ks + 32 * 128; LAS float* vs = fs + 32 * 128; LAS float* red = vs + 32 * 128;
    const int j = tid & 127, cg = tid >> 7; constexpr int CPT = DK / 4;
    float st[CPT];
#pragma unroll
    for (int i = 0; i < CPT; ++i) st[i] = 0.f;
    for (int blk = 0; blk < (CTXL + SEQ) / 32; ++blk) {
        for (int idx = tid; idx < 32 * DK; idx += NTHR) { const int t = idx / DK, c = idx % DK, row = scan_row(grp, b, dir, blk * 32 + t); const bf16* pr = P + (size_t)row * PW; float q, k, lf;
            if (DK == 64) { q = bf2f(pr[hd * 64 + c]); k = bf2f(pr[256 + hd * 64 + c]); float lg = gb[hd * 64 + c]; const bf16* gr = GR + (size_t)row * 32 + dir * 16;
#pragma unroll
                for (int r = 0; r < 16; ++r) lg += bf2f(gr[r]) * w2[r * 256 + hd * 64 + c];
                lf = logsig_f(lg) * (1.f / 16.f); }
            else { q = bf2f(pr[1024 + hd * 128 + c]); k = bf2f(pr[(dir ? 2560 : 1536) + hd * 128 + c]); lf = bf2f(pr[(dir ? 3072 : 2048) + hd * 128 + c]); }
            qs[t * 128 + c] = q; ks[t * 128 + c] = k; fs[t * 128 + c] = __expf(lf); }
        for (int idx = tid; idx < 32 * 128; idx += NTHR) { const int t = idx >> 7, jj = idx & 127, row = scan_row(grp, b, dir, blk * 32 + t); vs[idx] = bf2f(P[(size_t)row * PW + (DK == 64 ? 512 : 3584) + hd * 128 + jj]); }
        __syncthreads();
        for (int t = 0; t < 32; ++t) { const float vv = vs[t * 128 + j]; float acc = 0.f;
#pragma unroll
            for (int i = 0; i < CPT; ++i) { const int c = cg * CPT + i; st[i] = st[i] * fs[t * 128 + c] + ks[t * 128 + c] * vv; acc += st[i] * qs[t * 128 + c]; }
            red[(t * 4 + cg) * 128 + j] = acc; }
        __syncthreads();
        for (int idx = tid; idx < 4096; idx += NTHR) { const int t = idx >> 7, jj = idx & 127, row = scan_row(grp, b, dir, blk * 32 + t);
            const float o = (red[(t * 4 + 0) * 128 + jj] + red[(t * 4 + 1) * 128 + jj]) + (red[(t * 4 + 2) * 128 + jj] + red[(t * 4 + 3) * 128 + jj]);
            OUT[(size_t)row * D + grp * 512 + hd * 128 + jj] = (bf16)f2bf(o); }
        __syncthreads();
    }
}
__device__ __forceinline__ void mix_row(const bf16* of, const bf16* ob, const bf16* gate, const float* gla_g, const float* hg_g, bf16* out, int lane) {
    const v4u* pf = (const v4u*)of + 2 * lane; const v4u* pb = (const v4u*)ob + 2 * lane; const v4u* pg = (const v4u*)gate + 2 * lane;
    const v4u f0 = pf[0], f1 = pf[1], b0 = pb[0], b1 = pb[1], g0 = pg[0], g1 = pg[1];
    const unsigned fw[8] = {f0.x, f0.y, f0.z, f0.w, f1.x, f1.y, f1.z, f1.w}, bw[8] = {b0.x, b0.y, b0.z, b0.w, b1.x, b1.y, b1.z, b1.w}, gw[8] = {g0.x, g0.y, g0.z, g0.w, g1.x, g1.y, g1.z, g1.w};
    float o[16]; float ss = 0.f;
#pragma unroll
    for (int i = 0; i < 8; ++i) { o[2 * i] = bflo(fw[i]) + bflo(bw[i]); o[2 * i + 1] = bfhi(fw[i]) + bfhi(bw[i]); ss += o[2 * i] * o[2 * i] + o[2 * i + 1] * o[2 * i + 1]; }
    ss += __shfl_xor(ss, 1); ss += __shfl_xor(ss, 2); ss += __shfl_xor(ss, 4);
    const float rstd = rsqrtf(ss * (1.f / 128.f) + EPS);
    const float* ng = ((lane >> 5) ? hg_g : gla_g) + (lane & 7) * 16;
    unsigned w[8];
#pragma unroll
    for (int i = 0; i < 8; ++i) { const float a = o[2 * i] * rstd * ng[2 * i] * silu_f(bflo(gw[i])), c = o[2 * i + 1] * rstd * ng[2 * i + 1] * silu_f(bfhi(gw[i])); w[i] = pk2(a, c); }
    v4u* po = (v4u*)out + 2 * lane; po[0] = (v4u){w[0], w[1], w[2], w[3]}; po[1] = (v4u){w[4], w[5], w[6], w[7]};
}
__device__ __forceinline__ void moe_tab(KA a, LAS unsigned char* lds, int tid, int wg) {
    LAS int* tab = (LAS int*)(lds + TAB_OFF);
    if (tid < 32) tab[tid] = 0;
    __syncthreads();
    if (tid < 256) { const v4i* cp = (const v4i*)(a->ws + WS_ROUTE + RT_CNT) + 2 * tid; const v4i c0 = cp[0], c1 = cp[1]; const int c[8] = {c0.x, c0.y, c0.z, c0.w, c1.x, c1.y, c1.z, c1.w};
#pragma unroll
        for (int e = 0; e < 8; ++e) { __hip_atomic_fetch_add(&tab[e], c[e], __ATOMIC_RELAXED, __HIP_MEMORY_SCOPE_WORKGROUP); if (tid < wg) __hip_atomic_fetch_add(&tab[8 + e], c[e], __ATOMIC_RELAXED, __HIP_MEMORY_SCOPE_WORKGROUP); } }
    __syncthreads();
    if (tid == 0) { int pb = 0; for (int e = 0; e < 8; ++e) { tab[16 + e] = pb; pb += (tab[e] + 255) >> 8; } tab[24] = pb; }
    __syncthreads();
}

typedef short bf16x8 __attribute__((ext_vector_type(8)));
typedef float f32x16 __attribute__((ext_vector_type(16)));
typedef float f32x2_t __attribute__((ext_vector_type(2)));
typedef __bf16 bf16x2_t __attribute__((ext_vector_type(2)));
#define MFMA32(a, b, c) __builtin_amdgcn_mfma_f32_32x32x16_bf16((a), (b), (c), 0, 0, 0)
__device__ __forceinline__ unsigned cvtpk(float lo, float hi) { f32x2_t v = {lo, hi}; bf16x2_t b = __builtin_convertvector(v, bf16x2_t); return __builtin_bit_cast(unsigned, b); }
__device__ __forceinline__ int perm16(int c) { return (c & ~12) | ((c & 4) << 1) | ((c & 8) >> 1); }
template <int DK> __device__ __forceinline__ int rm_addr(int t, int pos) {
    const int swz = (DK == 128) ? (t & 15) : ((t >> 1) & 7);
    return t * (2 * DK) + ((((pos >> 3) ^ swz)) << 4) + ((pos & 7) << 1);
}
__device__ __forceinline__ int ti_addr(int row, int tok) { return row * 64 + ((((tok >> 3) ^ ((row >> 2) & 3))) << 4) + ((tok & 7) << 1); }
constexpr int SC_IMG = 25600, SC_QI = 0, SC_KDT = 8192, SC_VT = 16384, SC_DV = 24576;
constexpr int SC_QK = 3 * SC_IMG, SC_QKSET = 16384, SC_S = SC_QK + 2 * SC_QKSET;
static_assert(SC_S + 4096 <= RING_BYTES, "scan LDS map");
constexpr int NCHUNK = (CTXL + SEQ) / 32;

template <int DK> __device__ __forceinline__ void scan_mfma(LAS unsigned char* lds, const bf16* P, const bf16* GR, const float* w2, const float* gb, bf16* OUT, int grp, int b, int hd, int dir, int tid) {
    const int lane = tid & 63, wave = __builtin_amdgcn_readfirstlane(tid >> 6);
    constexpr int NCP = DK / 8, NTG = 64 / NCP, TPL = 32 / NTG, NT = DK / 32;
    const int i31 = lane & 31, h = lane >> 5;
    const int qcol = (DK == 64) ? hd * 64 : 1024 + hd * 128, kcol = (DK == 64) ? 256 + hd * 64 : (dir ? 2560 : 1536) + hd * 128, lcol = (dir ? 3072 : 2048) + hd * 128, vcol = ((DK == 64) ? 512 : 3584) + hd * 128;
    const int ocol = grp * 512 + hd * 128;
    if (wave < 4) {
        const int sw = wave;
        f32x16 ST[NT];
#pragma unroll
        for (int T = 0; T < NT; ++T)
#pragma unroll
            for (int r = 0; r < 16; ++r) ST[T][r] = 0.f;
        for (int it = -2; it < NCHUNK; ++it) {
            if (it >= 0) {
                const LAS unsigned char* img = lds + (it % 3) * SC_IMG; const LAS unsigned char* simg = lds + SC_S + (it & 1) * 2048;
                f32x16 oacc;
#pragma unroll
                for (int r = 0; r < 16; ++r) oacc[r] = 0.f;
#pragma unroll
                for (int T = 0; T < NT; ++T)
#pragma unroll
                    for (int s = 0; s < 2; ++s) { const int ks = 2 * T + s;
                        v4u p; p.x = cvtpk(ST[T][8 * s], ST[T][8 * s + 1]); p.y = cvtpk(ST[T][8 * s + 2], ST[T][8 * s + 3]); p.z = cvtpk(ST[T][8 * s + 4], ST[T][8 * s + 5]); p.w = cvtpk(ST[T][8 * s + 6], ST[T][8 * s + 7]);
                        const bf16x8 bq = *(const LAS bf16x8*)(img + SC_QI + rm_addr<DK>(i31, 16 * ks + 8 * h));
                        oacc = MFMA32(__builtin_bit_cast(bf16x8, p), bq, oacc); }
                bf16x8 va[2];
#pragma unroll
                for (int s = 0; s < 2; ++s) { va[s] = *(const LAS bf16x8*)(img + SC_VT + ti_addr(32 * sw + i31, 16 * s + 8 * h));
                    const bf16x8 sb = *(const LAS bf16x8*)(simg + ti_addr(i31, 16 * s + 8 * h));
                    oacc = MFMA32(va[s], sb, oacc); }
                { const int row = scan_row(grp, b, dir, it * 32 + i31); bf16* op = OUT + (size_t)row * D + ocol + 32 * sw + 4 * h;
#pragma unroll
                  for (int g = 0; g < 4; ++g) { v2u w; w.x = cvtpk(oacc[4 * g], oacc[4 * g + 1]); w.y = cvtpk(oacc[4 * g + 2], oacc[4 * g + 3]); *(v2u*)(op + 8 * g) = w; } }
#pragma unroll
                for (int T = 0; T < NT; ++T) {
#pragma unroll
                    for (int g = 0; g < 4; ++g) { const f32x4 d4 = *(const LAS f32x4*)(img + SC_DV + (32 * T + 8 * g + 4 * h) * 4);
                        ST[T][4 * g] *= d4.x; ST[T][4 * g + 1] *= d4.y; ST[T][4 * g + 2] *= d4.z; ST[T][4 * g + 3] *= d4.w; }
#pragma unroll
                    for (int s = 0; s < 2; ++s) { const bf16x8 kd = *(const LAS bf16x8*)(img + SC_KDT + ti_addr(32 * T + i31, 16 * s + 8 * h)); ST[T] = MFMA32(kd, va[s], ST[T]); }
                }
            }
            asm volatile("s_waitcnt lgkmcnt(0)" ::: "memory"); __builtin_amdgcn_s_barrier(); asm volatile("" ::: "memory");
        }
    } else {
        const int pw = wave - 4;
        const int tg = lane / NCP, cp = lane % NCP, c0 = (DK / 4) * pw + 2 * cp, t0 = tg * TPL;
        const int pos0 = (c0 & ~15) | perm16(c0 & 15);
        const int tgv = lane >> 4, cpv = lane & 15, d0 = 32 * pw + 2 * cpv, tv0 = 8 * tgv;
        float w2r[2][16]; float gb0 = 0.f, gb1 = 0.f;
        if (DK == 64) {
#pragma unroll
            for (int r = 0; r < 16; ++r) { w2r[0][r] = w2[r * 256 + hd * 64 + c0]; w2r[1][r] = w2[r * 256 + hd * 64 + c0 + 1]; }
            gb0 = gb[hd * 64 + c0]; gb1 = gb[hd * 64 + c0 + 1];
        }
        unsigned rq[TPL], rk[TPL], rl[TPL], rv[8]; v4u rg[TPL][2];
        auto load_chunk = [&](int ch) {
#pragma unroll
            for (int t = 0; t < TPL; ++t) { const int row = scan_row(grp, b, dir, ch * 32 + t0 + t); const bf16* pr = P + (size_t)row * PW;
                rq[t] = *(const unsigned*)(pr + qcol + c0); rk[t] = *(const unsigned*)(pr + kcol + c0);
                if (DK == 64) { const v4u* gp = (const v4u*)(GR + (size_t)row * 32 + dir * 16); rg[t][0] = gp[0]; rg[t][1] = gp[1]; } else rl[t] = *(const unsigned*)(pr + lcol + c0); }
#pragma unroll
            for (int t = 0; t < 8; ++t) { const int row = scan_row(grp, b, dir, ch * 32 + tv0 + t); rv[t] = *(const unsigned*)(P + (size_t)row * PW + vcol + d0); }
        };
        load_chunk(0);
        for (int it = -2; it < NCHUNK; ++it) {
            const int cw = it + 2;
            if (cw < NCHUNK) {
                LAS unsigned char* img = lds + (cw % 3) * SC_IMG; LAS unsigned char* qk = lds + SC_QK + (cw & 1) * SC_QKSET;
                float c0v[TPL], c1v[TPL];
                { float a0 = 0.f, a1 = 0.f;
#pragma unroll
                  for (int t = 0; t < TPL; ++t) { float l0, l1;
                      if (DK == 64) { float g0 = gb0, g1 = gb1; const unsigned gw[8] = {rg[t][0].x, rg[t][0].y, rg[t][0].z, rg[t][0].w, rg[t][1].x, rg[t][1].y, rg[t][1].z, rg[t][1].w};
#pragma unroll
                          for (int r = 0; r < 8; ++r) { const float e0 = bflo(gw[r]), e1 = bfhi(gw[r]); g0 += e0 * w2r[0][2 * r] + e1 * w2r[0][2 * r + 1]; g1 += e0 * w2r[1][2 * r] + e1 * w2r[1][2 * r + 1]; }
                          l0 = logsig_f(g0) * (1.f / 16.f); l1 = logsig_f(g1) * (1.f / 16.f); }
                      else { l0 = bflo(rl[t]); l1 = bfhi(rl[t]); }
                      a0 += l0; a1 += l1; c0v[t] = a0; c1v[t] = a1; } }
                float s0 = c0v[TPL - 1], s1 = c1v[TPL - 1];
#pragma unroll
                for (int d = NCP; d < 64; d <<= 1) { const float u0 = __shfl_up(s0, d), u1 = __shfl_up(s1, d); if (lane >= d) { s0 += u0; s1 += u1; } }
                const float off0 = s0 - c0v[TPL - 1], off1 = s1 - c1v[TPL - 1];
                constexpr int TGREF = 16 / TPL - 1;
                const float br0 = __shfl(s0, TGREF * NCP + cp), br1 = __shfl(s1, TGREF * NCP + cp), bl0 = __shfl(s0, (NTG - 1) * NCP + cp), bl1 = __shfl(s1, (NTG - 1) * NCP + cp);
                const float cR0 = __expf(br0), cR1 = __expf(br1), cL0 = __expf(bl0 - br0), cL1 = __expf(bl1 - br1);
                unsigned kdp0[TPL / 2], kdp1[TPL / 2]; float kdprev0 = 0.f, kdprev1 = 0.f;
#pragma unroll
                for (int t = 0; t < TPL; ++t) {
                    const float e0 = fminf(fmaxf(off0 + c0v[t] - br0, -80.f), 80.f), e1 = fminf(fmaxf(off1 + c1v[t] - br1, -80.f), 80.f);
                    const float E0 = __expf(e0), E1 = __expf(e1), R0 = __builtin_amdgcn_rcpf(E0), R1 = __builtin_amdgcn_rcpf(E1);
                    const float qs0 = bflo(rq[t]) * E0, qs1 = bfhi(rq[t]) * E1, ks0 = bflo(rk[t]) * R0, ks1 = bfhi(rk[t]) * R1;
                    const int tt = t0 + t;
                    *(LAS unsigned*)(img + SC_QI + rm_addr<DK>(tt, pos0)) = cvtpk(qs0 * cR0, qs1 * cR1);
                    *(LAS unsigned*)(qk + rm_addr<DK>(tt, pos0)) = cvtpk(qs0, qs1);
                    *(LAS unsigned*)(qk + 8192 + rm_addr<DK>(tt, pos0)) = cvtpk(ks0, ks1);
                    const float kd0 = ks0 * cL0, kd1 = ks1 * cL1;
                    if (t & 1) { kdp0[t >> 1] = cvtpk(kdprev0, kd0); kdp1[t >> 1] = cvtpk(kdprev1, kd1); } else { kdprev0 = kd0; kdprev1 = kd1; }
                }
                if constexpr (TPL == 8) { *(LAS v4u*)(img + SC_KDT + ti_addr(c0, t0)) = (v4u){kdp0[0], kdp0[1], kdp0[TPL / 2 - 2], kdp0[TPL / 2 - 1]}; *(LAS v4u*)(img + SC_KDT + ti_addr(c0 + 1, t0)) = (v4u){kdp1[0], kdp1[1], kdp1[TPL / 2 - 2], kdp1[TPL / 2 - 1]}; }
                else { *(LAS v2u*)(img + SC_KDT + ti_addr(c0, t0)) = (v2u){kdp0[0], kdp0[1]}; *(LAS v2u*)(img + SC_KDT + ti_addr(c0 + 1, t0)) = (v2u){kdp1[0], kdp1[1]}; }
                if (tg == 0) *(LAS f32x2v*)(img + SC_DV + c0 * 4) = (f32x2v){cR0 * cL0, cR1 * cL1};
                { v4u lo, hi;
                  lo.x = (rv[0] & 0xffffu) | (rv[1] << 16); lo.y = (rv[2] & 0xffffu) | (rv[3] << 16); lo.z = (rv[4] & 0xffffu) | (rv[5] << 16); lo.w = (rv[6] & 0xffffu) | (rv[7] << 16);
                  hi.x = (rv[0] >> 16) | (rv[1] & 0xffff0000u); hi.y = (rv[2] >> 16) | (rv[3] & 0xffff0000u); hi.z = (rv[4] >> 16) | (rv[5] & 0xffff0000u); hi.w = (rv[6] >> 16) | (rv[7] & 0xffff0000u);
                  *(LAS v4u*)(img + SC_VT + ti_addr(d0, tv0)) = lo; *(LAS v4u*)(img + SC_VT + ti_addr(d0 + 1, tv0)) = hi; }
                if (cw + 1 < NCHUNK) load_chunk(cw + 1);
            }
            const int cs = it + 1;
            if (cs >= 0 && cs < NCHUNK && pw == (cs & 3)) {
                const LAS unsigned char* qk = lds + SC_QK + (cs & 1) * SC_QKSET; LAS unsigned char* simg = lds + SC_S + (cs & 1) * 2048;
                f32x16 sacc;
#pragma unroll
                for (int r = 0; r < 16; ++r) sacc[r] = 0.f;
#pragma unroll
                for (int ks = 0; ks < DK / 16; ++ks) { const int ad = rm_addr<DK>(i31, 16 * ks + 8 * h);
                    const bf16x8 ka = *(const LAS bf16x8*)(qk + 8192 + ad), qb = *(const LAS bf16x8*)(qk + ad); sacc = MFMA32(ka, qb, sacc); }
#pragma unroll
                for (int g = 0; g < 4; ++g) { float m[4];
#pragma unroll
                    for (int e = 0; e < 4; ++e) { const int j = 8 * g + 4 * h + e; m[e] = (i31 >= j) ? sacc[4 * g + e] : 0.f; }
                    *(LAS v2u*)(simg + i31 * 64 + ((g ^ ((i31 >> 2) & 3)) << 4) + 8 * h) = (v2u){cvtpk(m[0], m[1]), cvtpk(m[2], m[3])}; }
            }
            asm volatile("s_waitcnt lgkmcnt(0)" ::: "memory"); __builtin_amdgcn_s_barrier(); asm volatile("" ::: "memory");
        }
    }
}

__global__ void __launch_bounds__(NTHR, 2) fwd_kernel(Args args) {
    extern __shared__ __attribute__((aligned(16))) unsigned char lds_raw[];
    LAS unsigned char* lds = (LAS unsigned char*)lds_raw;
    {   const int t0 = threadIdx.x;
        for (int u = t0; u < (LDS_BYTES - LDSCTL_OFF) / 4; u += NTHR) ((LAS unsigned*)(lds + LDSCTL_OFF))[u] = 0u;
        __syncthreads();
        (void)xcd_barrier_post((unsigned*)(kargs()->ws + WS_CTL) + CW_BAR, (volatile LAS unsigned*)(lds + MISC_OFF) + 8); }
#define IN(k) (kargs()->ph_lo <= (k) && (k) < kargs()->ph_hi)
#define BAR(k) do { if (IN(k) && IN((k) + 1)) { XcdBarrier bar_; bar_.bar = (unsigned*)(kargs()->ws + WS_CTL) + CW_BAR; bar_.x = xb_xcc_id(); bar_.st = (volatile LAS unsigned*)(lds + MISC_OFF) + 8; xcd_barrier(bar_); } } while (0)
#define PH_VIEW() KA A = kargs(); unsigned char* ws = A->ws; float* mods = (float*)(ws + WS_MODS); bf16* Hb = (bf16*)(ws + WS_H); bf16* OBb = (bf16*)(ws + WS_OB); bf16* Gb = (bf16*)(ws + WS_G); bf16* Pb = (bf16*)(ws + WS_P); \
    bf16* GRb = (bf16*)(ws + WS_GR); bf16* MIXb = (bf16*)(ws + WS_MIX); float* XC = (float*)(ws + WS_XC); float* XL = A->out; (void)mods; (void)Hb; (void)OBb; (void)Gb; (void)Pb; (void)GRb; (void)MIXb; (void)XC; (void)XL; \
    int tid = threadIdx.x; asm volatile("" : "+v"(tid)); const int lane = tid & 63, wave = __builtin_amdgcn_readfirstlane(tid >> 6), wg = blockIdx.x, G = gridDim.x, gw = wg * NWAVES + wave, NGW = G * NWAVES; \
    (void)lane; (void)wave; (void)wg; (void)G; (void)gw; (void)NGW
#define LAYER_VIEW() const float* xlat = l ? (const float*)XL : A->in[I_X]; const float* xctx = l ? (const float*)XC : A->in[I_CTX]; \
    const float* mlat = mods + MO_LAT + l * 16 * 6144; const float* mctx = mods + MO_CTX + l * 6144; (void)xlat; (void)xctx; (void)mlat; (void)mctx
    LAS int* tab = (LAS int*)(lds + TAB_OFF);

    if (IN(0)) { PH_VIEW();
        LAS float* scr = (LAS float*)(lds + wave * 16384);
        for (int it = gw; it < NI_MAIN; it += NGW) conv_item_main(A, it, scr, lane);
        for (int i = wg * NTHR + tid; i < 2 * 28672; i += G * NTHR) { const int l = i / 28672, r = i % 28672; ((v4u*)((bf16*)(ws + WS_WIN) + ((size_t)l * NIN + 4128) * 1024))[r] = (v4u){0u, 0u, 0u, 0u}; }
        __syncthreads();
        for (int it = wg; it < 192; it += G) mod_item(A, it, lds, tid, lane, wave);
        if (wg == G - 1) for (int i = tid; i < 1024; i += NTHR) { const int d = i >> 9, ch = i & 511; const float a0 = A->in[I_HLB][d * 512 + ch], a1 = A->in[I_HLB][(2 + d) * 512 + ch];
            mods[MO_LB + d * 512 + ch] = 0.f; mods[MO_LB + 1024 + d * 512 + ch] = 1.f / (1.f + __expf(a0 - a1)); }
    }
    BAR(0);
#pragma nounroll
    for (int l = 0; l < 2; ++l) {
        const int pb = l ? 9 : 1;
        if (IN(pb)) { PH_VIEW(); LAYER_VIEW();
            for (int m = gw; m < MT; m += NGW) { f32x4 y[4]; const bool lat = m < ML; const float* md = lat ? mlat + (m >> 11) * 6144 : mctx;
                ada_norm_row(lat ? xlat + (size_t)m * D : xctx + (size_t)(m - ML) * D, Hb + (size_t)m * D, A->in[I_N1G] + l * D, md, md + 1024, lane, y); }
        }
        BAR(pb);
        if (IN(pb + 1)) { PH_VIEW(); LAYER_VIEW();
            pg8::Gemm g{Hb, (const bf16*)(ws + WS_WIN) + (size_t)l * NIN * 1024, MT, NIN, D}; pg8::StaticOrder S; S.init(MT, NIN, G, wg);
            EpiInProj E{Pb, Gb, GRb, mods + MO_LB + l * 1024};
            pg8::gemm_phase<EpiInProj, pg8::StaticOrder, true, true>(lds, g, S, E);
        }
        BAR(pb + 1);
        if (IN(pb + 2)) { PH_VIEW(); LAYER_VIEW();
            for (int s = wg; s < 256; s += G) { const int grp = s >> 7, r = s & 127, b = r >> 3, hd = (r >> 1) & 3, dir = r & 1;
                bf16* OUT = dir ? OBb : Hb;
                const float* w2 = A->in[I_GW2] + (size_t)(l * 2 + dir) * 16 * 256; const float* gb = A->in[I_GB] + (l * 2 + dir) * 256;
                if (grp == 0) scan_mfma<64>(lds, Pb, GRb, w2, gb, OUT, grp, b, hd, dir, tid); else scan_mfma<128>(lds, Pb, GRb, w2, gb, OUT, grp, b, hd, dir, tid); }
        }
        BAR(pb + 2);
        if (IN(pb + 3)) { PH_VIEW(); LAYER_VIEW();
            const int nrow = l ? ML : MT;
            for (int m = gw; m < nrow; m += NGW) mix_row(Hb + (size_t)m * D, OBb + (size_t)m * D, Gb + (size_t)m * D, A->in[I_GLAG] + l * 128, A->in[I_HGG] + l * 128, MIXb + (size_t)m * D, lane);
            if (l == 1) { LAS float* scr = (LAS float*)(lds + wave * 16384); for (int it = gw; it < NI_MOE; it += NGW) conv_item_moe(A, it, scr, lane); }
        }
        BAR(pb + 3);
        if (IN(pb + 4)) { PH_VIEW(); LAYER_VIEW();
            const int Mw = l ? ML : MT;
            pg8::Gemm g{MIXb, (const bf16*)(ws + WS_WOUT) + (size_t)l * 1024 * 1024, Mw, D, D}; pg8::StaticOrder S; S.init(Mw, D, G, wg);
            EpiResid E{xlat, xctx, XL, XC, mlat + 2048, mctx + 2048};
            pg8::gemm_phase<EpiResid, pg8::StaticOrder, true, true>(lds, g, S, E);
        }
        BAR(pb + 4);
        if (l == 0) {
            if (IN(6)) { PH_VIEW(); LAYER_VIEW();
                for (int m = gw; m < MT; m += NGW) { f32x4 y[4]; const bool lat = m < ML; const float* md = lat ? mlat + (m >> 11) * 6144 : mctx;
                    ada_norm_row(lat ? XL + (size_t)m * D : XC + (size_t)(m - ML) * D, Hb + (size_t)m * D, A->in[I_N2G], md + 3072, md + 4096, lane, y); }
            }
            BAR(6);
            if (IN(7)) { PH_VIEW(); LAYER_VIEW();
                pg8::Gemm g{Hb, (const bf16*)(ws + WS_F13), MT, 2 * DFF, D}; pg8::StaticOrder S; S.init(MT, 2 * DFF, G, wg);
                EpiSwiGLU E{(bf16*)(ws + WS_ACT0), DFF, 22, 0};
                pg8::gemm_phase<EpiSwiGLU, pg8::StaticOrder, true, true>(lds, g, S, E);
            }
            BAR(7);
            if (IN(8)) { PH_VIEW(); LAYER_VIEW();
                pg8::Gemm g{(const bf16*)(ws + WS_ACT0), (const bf16*)(ws + WS_F2), MT, D, DFF}; pg8::StaticOrder S; S.init(MT, D, G, wg);
                EpiResid E{XL, XC, XL, XC, mlat + 5120, mctx + 5120};
                pg8::gemm_phase<EpiResid, pg8::StaticOrder, true, true>(lds, g, S, E);
            }
            BAR(8);
        }
    }
    if (IN(14)) { PH_VIEW(); const float* mlat1 = mods + MO_LAT + 16 * 6144;
        LAS float* rt = (LAS float*)lds; LAS int* sE = (LAS int*)(lds + 32768); LAS float* sW = (LAS float*)(lds + 32768 + 1024); LAS int* sL = (LAS int*)(lds + 32768 + 2048);
        for (int idx = tid; idx < 8192; idx += NTHR) { const int k = idx >> 3, e = idx & 7; rt[e * 1024 + k] = A->in[I_ROUTER][idx]; }
        __syncthreads();
        for (int rr = 0; rr < 16; ++rr) { const int tl = wave * 16 + rr, row = wg * 128 + tl; f32x4 y[4]; const float* md = mlat1 + (row >> 11) * 6144;
            ada_norm_row(XL + (size_t)row * D, Hb + (size_t)row * D, A->in[I_N2G] + D, md + 3072, md + 4096, lane, y);
            float lg[8];
#pragma unroll
            for (int e = 0; e < 8; ++e) { float p = 0.f;
#pragma unroll
                for (int j = 0; j < 4; ++j) { const f32x4 r4 = ((const LAS f32x4*)(rt + e * 1024))[lane + 64 * j]; p += (y[j].x * r4.x + y[j].y * r4.y) + (y[j].z * r4.z + y[j].w * r4.w); }
                lg[e] = wave_sum(p); }
            int i0 = 0; float v0 = lg[0];
#pragma unroll
            for (int e = 1; e < 8; ++e) if (lg[e] > v0) { v0 = lg[e]; i0 = e; }
            int i1 = -1; float v1 = -3.0e38f;
#pragma unroll
            for (int e = 0; e < 8; ++e) if (e != i0 && lg[e] > v1) { v1 = lg[e]; i1 = e; }
            const float w0 = 1.f / (1.f + __expf(v1 - v0));
            if (lane == 0) { sE[2 * tl] = i0; sE[2 * tl + 1] = i1; sW[2 * tl] = w0; sW[2 * tl + 1] = 1.f - w0; } }
        __syncthreads();
        if (tid < 8) { int cnt = 0; for (int t = 0; t < 256; ++t) if (sE[t] == tid) sL[t] = cnt++; ((int*)(ws + WS_ROUTE + RT_CNT))[wg * 8 + tid] = cnt; }
        __syncthreads();
        if (tid < 128) { const int row = wg * 128 + tid; ((v4i*)(ws + WS_ROUTE + RT_SEL))[row] = (v4i){sE[2 * tid], sE[2 * tid + 1], sL[2 * tid], sL[2 * tid + 1]};
            ((f32x2v*)(ws + WS_ROUTE + RT_W))[row] = (f32x2v){sW[2 * tid], sW[2 * tid + 1]}; }
    }
    BAR(14);
    if (kargs()->ph_lo >= 16 && kargs()->ph_lo <= 26) moe_tab(kargs(), lds, threadIdx.x, blockIdx.x);
    if (IN(15)) { PH_VIEW();
        moe_tab(kargs(), lds, tid, wg);
        for (int t = wave; t < 128; t += NWAVES) { const int row = wg * 128 + t; v4i* selp = (v4i*)(ws + WS_ROUTE + RT_SEL) + row; const v4i sel = *selp; const f32x2v w = ((const f32x2v*)(ws + WS_ROUTE + RT_W))[row];
            const int s0 = tab[16 + sel.x] * 256 + tab[8 + sel.x] + sel.z, s1 = tab[16 + sel.y] * 256 + tab[8 + sel.y] + sel.w;
            const v4u* src = (const v4u*)(Hb + (size_t)row * D) + 2 * lane; const v4u a0 = src[0], a1 = src[1];
            v4u* d0 = (v4u*)((bf16*)(ws + WS_HS) + (size_t)s0 * D) + 2 * lane; d0[0] = a0; d0[1] = a1;
            v4u* d1 = (v4u*)((bf16*)(ws + WS_HS) + (size_t)s1 * D) + 2 * lane; d1[0] = a0; d1[1] = a1;
            if (lane == 0) { float* gwp = (float*)(ws + WS_ROUTE + RT_GW); gwp[s0] = w.x; gwp[s1] = w.y; *selp = (v4i){sel.x, sel.y, s0, s1}; } }
    }
    BAR(15);
#pragma nounroll
    for (int c = 0; c < 5; ++c) {
        const int TP = tab[24], pan0 = CHUNK_PAN * c; int nM = TP - pan0; nM = nM > CHUNK_PAN ? CHUNK_PAN : nM;
        if (IN(16 + 2 * c) && nM > 0) { PH_VIEW();
            pg8::Gemm g{(const bf16*)(ws + WS_HS), (const bf16*)(ws + WS_M13), 0, 0, D}; MoeOrder S; S.init(nM, 28, G, wg, pan0, 0);
#pragma unroll
            for (int e = 0; e < 8; ++e) S.pb[e] = __builtin_amdgcn_readfirstlane(tab[16 + e]);
            EpiSwiGLU E{(bf16*)(ws + WS_ACT), DEXP, 28, pan0};
            pg8::gemm_phase<EpiSwiGLU, MoeOrder, true, true>(lds, g, S, E);
        }
        BAR(16 + 2 * c);
        if (IN(17 + 2 * c) && nM > 0) { PH_VIEW();
            pg8::Gemm g{(const bf16*)(ws + WS_ACT), (const bf16*)(ws + WS_M2), 0, 0, DEXP}; MoeOrder S; S.init(nM, 4, G, wg, pan0, 1);
#pragma unroll
            for (int e = 0; e < 8; ++e) S.pb[e] = __builtin_amdgcn_readfirstlane(tab[16 + e]);
            EpiMoeOut E{(bf16*)(ws + WS_HS), (const float*)(ws + WS_ROUTE + RT_GW), pan0};
            pg8::gemm_phase<EpiMoeOut, MoeOrder, true, true>(lds, g, S, E);
        }
        BAR(17 + 2 * c);
    }
    if (IN(26)) { PH_VIEW(); const float* mlat1 = mods + MO_LAT + 16 * 6144;
        unsigned bad = __hip_atomic_load((unsigned*)(ws + WS_CTL) + CW_BAR + XB_TMO, __ATOMIC_RELAXED, __HIP_MEMORY_SCOPE_AGENT);
        const bf16* Y = (const bf16*)(ws + WS_HS);
        for (int m = gw; m < ML; m += NGW) { const v4i sel = ((const v4i*)(ws + WS_ROUTE + RT_SEL))[m]; const float* md = mlat1 + (m >> 11) * 6144 + 5120;
            f32x4* xr = (f32x4*)(XL + (size_t)m * D) + lane; const v2u* y0 = (const v2u*)(Y + (size_t)sel.z * D) + lane; const v2u* y1 = (const v2u*)(Y + (size_t)sel.w * D) + lane;
            f32x4 v[4]; float s = 0.f;
#pragma unroll
            for (int j = 0; j < 4; ++j) { const f32x4 x = xr[64 * j], gt = ((const f32x4*)md)[lane + 64 * j]; const v2u a = y0[64 * j], b = y1[64 * j];
                const f32x4 yy = {bflo(a.x) + bflo(b.x), bfhi(a.x) + bfhi(b.x), bflo(a.y) + bflo(b.y), bfhi(a.y) + bfhi(b.y)};
                v[j] = x + gt * yy; s += (v[j].x * v[j].x + v[j].y * v[j].y) + (v[j].z * v[j].z + v[j].w * v[j].w); }
            const float rstd = rsqrtf(wave_sum(s) * (1.f / D) + EPS);
#pragma unroll
            for (int j = 0; j < 4; ++j) { f32x4 o = v[j] * rstd * ((const f32x4*)A->in[I_FNG])[lane + 64 * j]; if (bad) o = (f32x4){__builtin_nanf(""), __builtin_nanf(""), __builtin_nanf(""), __builtin_nanf("")}; xr[64 * j] = o; } }
    }
#undef IN
#undef BAR
}

extern "C" void kernel_launch(void* const* d_in, const int* in_sizes, int n_in, void* d_out, int out_size, void* d_ws, size_t ws_size, hipStream_t stream) {
    static int grid = 0;
    if (grid == 0) {
        if (n_in != 23 || in_sizes[0] != ML * D || out_size != ML * D || ws_size < WS_END) { fprintf(stderr, "kernel_launch: unexpected shapes (n_in %d, in0 %d, out %d, ws %zu, need %zu); nothing launched\n", n_in, n_in > 0 ? in_sizes[0] : -1, out_size, ws_size, (size_t)WS_END); grid = -1; return; }
        int dev = 0, cus = 0, per_cu = 0;
        if (hipGetDevice(&dev) != hipSuccess || hipDeviceGetAttribute(&cus, hipDeviceAttributeMultiprocessorCount, dev) != hipSuccess) { grid = -1; return; }
        if (hipFuncSetAttribute((const void*)fwd_kernel, hipFuncAttributeMaxDynamicSharedMemorySize, LDS_BYTES) != hipSuccess) { fprintf(stderr, "kernel_launch: hipFuncSetAttribute failed\n"); grid = -1; return; }
        if (hipOccupancyMaxActiveBlocksPerMultiprocessor(&per_cu, (const void*)fwd_kernel, NTHR, LDS_BYTES) != hipSuccess || per_cu < 1) fprintf(stderr, "kernel_launch: occupancy query reports %d\n", per_cu);
        (void)hipGetLastError();
        if (cus < 256) { fprintf(stderr, "kernel_launch: needs 256 CUs, device has %d\n", cus); grid = -1; return; }
        grid = 256;
    }
    if (grid < 0) return;
    if (hipMemsetAsync((char*)d_ws + WS_CTL, 0, CTL_ZERO_BYTES, stream) != hipSuccess) return;
    Args a{};
    for (int i = 0; i < 23; ++i) a.in[i] = (const float*)d_in[i];
    a.out = (float*)d_out; a.ws = (unsigned char*)d_ws;
#if MK_MULTI
    for (int k = 0; k < NPHASE; ++k) { a.ph_lo = k; a.ph_hi = k + 1; hipLaunchKernelGGL(fwd_kernel, dim3(grid), dim3(NTHR), LDS_BYTES, stream, a); }
#else
    a.ph_lo = 0; a.ph_hi = NPHASE; hipLaunchKernelGGL(fwd_kernel, dim3(grid), dim3(NTHR), LDS_BYTES, stream, a);
#endif
}
```

```cpp
#include <hip/hip_runtime.h>
#include <cstdio>
#include <cstdint>
#ifndef MK_MULTI
#define MK_MULTI 0
#endif
#ifndef PROBE_REP
#define PROBE_REP 0ull
#endif
#ifndef PROBE_AT
#define PROBE_AT (-1)
#endif
namespace pg8 {
#define PG8_LAS __attribute__((address_space(3)))
typedef unsigned short bf16_t;
typedef short bf16x8 __attribute__((ext_vector_type(8)));
typedef float f32x4 __attribute__((ext_vector_type(4)));
typedef unsigned u32x4 __attribute__((ext_vector_type(4)));
typedef int i32x4 __attribute__((ext_vector_type(4)));
template <bool I8> struct AccSel { typedef f32x4 T; };
template <> struct AccSel<true> { typedef i32x4 T; };
__device__ __forceinline__ f32x4 mma_bf16(bf16x8 a, bf16x8 b, f32x4 c) { return __builtin_amdgcn_mfma_f32_16x16x32_bf16(a, b, c, 0, 0, 0); }
__device__ __forceinline__ i32x4 mma_i8(bf16x8 a, bf16x8 b, i32x4 c) { return __builtin_amdgcn_mfma_i32_16x16x64_i8(__builtin_bit_cast(i32x4, a), __builtin_bit_cast(i32x4, b), c, 0, 0, 0); }
constexpr int BM = 256, BK = 64, HALF = 128, HTB = HALF * BK * 2  , STAGE_BYTES = 8 * HTB, NXCD = 8, WGM = 8;

__host__ __device__ __forceinline__ int lds_byte(int r, int c) { const int st = (r >> 4) * 2 + (c >> 5), rr = r & 15, cc = c & 31, ob = rr * 64 + cc * 2; return st * 1024 + (ob ^ (((ob >> 9) & 1) << 5)); }
__host__ __device__ __forceinline__ void stage_rc(int b, int& R, int& C) { const int st = b / 1024, sb = b % 1024, swz = sb ^ (((sb >> 9) & 1) << 5); R = (st >> 1) * 16 + swz / 64; C = (st & 1) * 32 + (swz % 64) / 2; }
__host__ __device__ __forceinline__ int perm32(int rho) { const int n = rho >> 4, i = rho & 15; return 8 * (i >> 2) + 4 * n + (i & 3); }

struct Unit { int pm, pn; };
struct Gemm { const bf16_t* A; const bf16_t* Bt; int M, N, K; };

struct StaticOrder {
    int nM, nN, nwg, G, c;
    __host__ __device__ void init(int M, int N, int G_, int c_) { nM = M / BM; nN = N / BM; nwg = nM * nN; G = G_; c = c_; }
    __host__ __device__ bool next(int i, Unit& u) const {
        const long L = (long)i * G + c; if (L >= nwg) return false;
        int wgid = (int)L; { const int q = nwg / NXCD, r = nwg % NXCD, xcd = wgid % NXCD, off = wgid / NXCD; wgid = (xcd < r ? xcd * (q + 1) : r * (q + 1) + (xcd - r) * q) + off; }
        const int nig = WGM * nN, gid = wgid / nig, fm = gid * WGM, gsz = (nM - fm) < WGM ? (nM - fm) : WGM;
        u.pm = fm + ((wgid % nig) % gsz); u.pn = (wgid % nig) / gsz; return true;
    }
    __device__ __forceinline__ void a_ready(const Unit&) const {}
    __device__ __forceinline__ void done(const Unit&) const {}
};
__device__ __forceinline__ unsigned cvt_pk_bf16(float lo, float hi) { unsigned r; asm volatile("v_cvt_pk_bf16_f32 %0, %1, %2" : "=v"(r) : "v"(lo), "v"(hi)); return r; }
typedef float f32x2 __attribute__((ext_vector_type(2)));
template <class Epi, class Sched, bool ALIGN_EPI = false, bool SP2 = false>
__device__ __forceinline__ void gemm_phase(PG8_LAS unsigned char* lds, const Gemm g, const Sched& S, const Epi& E) {
    int tid_l = threadIdx.x; asm volatile("" : "+v"(tid_l));
    const int tid = tid_l, wid = __builtin_amdgcn_readfirstlane(tid >> 6), lane = tid & 63, wr = wid >> 2, wc = wid & 3, fr = lane & 15, fq = lane >> 4;
    const int K = g.K, nt = K / BK;
    unsigned voffA[2], voffB[2];
#pragma unroll
    for (int i = 0; i < 2; ++i) { int R, C; stage_rc(tid * 16 + i * 8192, R, C); const int Rb = Epi::PERM ? ((R & ~31) + perm32(R & 31)) : R;
        voffA[i] = (unsigned)(R * K + C) * 2u; voffB[i] = (unsigned)(Rb * K + C) * 2u; }
    const size_t kstep = (size_t)(BK * 2);
    const size_t hstep = (size_t)HALF * K * 2;
    const size_t tstep = 2 * hstep;
    const unsigned ldsw = (unsigned)wid * 1024u;
    const int aoff = lds_byte(wr * 64 + fr, fq * 8), boff = lds_byte(wc * 32 + fr, fq * 8);
#define PG8_SA(b, h) (((b) * 2 + (h)) * HTB)
#define PG8_SB(b, h) ((4 + (b) * 2 + (h)) * HTB)
#define PG8_STAGE(bufoff, gbase, voff) do { _Pragma("unroll") for (int _i = 0; _i < 2; ++_i) \
        __builtin_amdgcn_global_load_lds((const unsigned*)((const char*)(gbase) + (voff)[_i]), (PG8_LAS unsigned*)(lds + (bufoff) + ldsw + _i * 8192), 16, 0, 0); } while (0)
#define PG8_LDA(dst, b, h) do { _Pragma("unroll") for (int m = 0; m < 4; ++m) _Pragma("unroll") for (int k = 0; k < 2; ++k) dst[m][k] = *(const PG8_LAS bf16x8*)(lds + PG8_SA(b, h) + aoff + m * 2048 + k * 1024); } while (0)
#define PG8_LDB(dst, b, h) do { _Pragma("unroll") for (int n = 0; n < 2; ++n) _Pragma("unroll") for (int k = 0; k < 2; ++k) dst[n][k] = *(const PG8_LAS bf16x8*)(lds + PG8_SB(b, h) + boff + n * 2048 + k * 1024); } while (0)
#define PG8_MMA(ai, bj, At, Bt) do { __builtin_amdgcn_s_setprio(1); _Pragma("unroll") for (int m = 0; m < 4; ++m) _Pragma("unroll") for (int n = 0; n < 2; ++n) _Pragma("unroll") for (int k = 0; k < 2; ++k) \
        { if constexpr (Epi::I8) acc[ai][bj][m][n] = mma_i8(Bt[n][k], At[m][k], acc[ai][bj][m][n]); else acc[ai][bj][m][n] = mma_bf16(Bt[n][k], At[m][k], acc[ai][bj][m][n]); } __builtin_amdgcn_s_setprio(0); } while (0)
#define PG8_WAIT_V(n) asm volatile("s_waitcnt vmcnt(" #n ")" ::: "memory")
#define PG8_WAIT_L(n) asm volatile("s_waitcnt lgkmcnt(" #n ")" ::: "memory")
#define PG8_BAR __builtin_amdgcn_s_barrier()
#define PG8_SCHED __builtin_amdgcn_sched_barrier(0)
    Unit cur, nxt; int ui = 0;
    if (!S.next(0, cur)) return;
    typedef typename AccSel<Epi::I8>::T acc_t;
    acc_t acc[2][2][4][2];
#pragma unroll
    for (int a = 0; a < 2; ++a)
#pragma unroll
        for (int b = 0; b < 2; ++b)
#pragma unroll
            for (int m = 0; m < 4; ++m)
#pragma unroll
                for (int n = 0; n < 2; ++n) acc[a][b][m][n] = (acc_t){0, 0, 0, 0};
    bf16x8 At[4][2], B0[2][2], B1[2][2];
    const char* cA = (const char*)g.A + (size_t)cur.pm * tstep; const char* cB = (const char*)g.Bt + (size_t)cur.pn * tstep;
    S.a_ready(cur);
    if constexpr (SP2) {
        PG8_STAGE(PG8_SB(0, 0), cB, voffB); PG8_STAGE(PG8_SB(0, 1), cB + hstep, voffB); PG8_STAGE(PG8_SA(0, 0), cA, voffA); PG8_STAGE(PG8_SA(0, 1), cA + hstep, voffA);
        if (wr == 1) PG8_BAR;
        PG8_WAIT_V(2); PG8_BAR;
        PG8_STAGE(PG8_SB(1, 0), cB + kstep, voffB); PG8_STAGE(PG8_SA(1, 0), cA + kstep, voffA); PG8_STAGE(PG8_SB(1, 1), cB + hstep + kstep, voffB);
        PG8_WAIT_V(6); PG8_BAR;
    } else {
        PG8_STAGE(PG8_SB(0, 0), cB, voffB); PG8_STAGE(PG8_SA(0, 0), cA, voffA); PG8_STAGE(PG8_SB(0, 1), cB + hstep, voffB); PG8_STAGE(PG8_SA(0, 1), cA + hstep, voffA);
        if (wr == 1) PG8_BAR;
        PG8_WAIT_V(4); PG8_BAR;
        PG8_STAGE(PG8_SB(1, 0), cB + kstep, voffB); PG8_STAGE(PG8_SA(1, 0), cA + kstep, voffA); PG8_STAGE(PG8_SB(1, 1), cB + hstep + kstep, voffB);
        PG8_WAIT_V(6); PG8_BAR;
    }
    for (;;) {
        const bool has_next = S.next(ui + 1, nxt);
        const char* nA = has_next ? (const char*)g.A + (size_t)nxt.pm * tstep : cA; const char* nB = has_next ? (const char*)g.Bt + (size_t)nxt.pn * tstep : cB;
        for (int t = 0; t < nt; t += 2) {
            const bool last = (t == nt - 2);
            const char* a1 = cA + (size_t)(t + 1) * kstep;
            const char* a2 = last ? nA : cA + (size_t)(t + 2) * kstep; const char* b2 = last ? nB : cB + (size_t)(t + 2) * kstep;
            const char* a3 = a2 + kstep; const char* b3 = b2 + kstep;
            if (last && has_next) S.a_ready(nxt);
            if constexpr (SP2) {
            PG8_LDB(B0, 0, 0); PG8_LDB(B1, 0, 1); PG8_SCHED; PG8_LDA(At, 0, 0); PG8_STAGE(PG8_SA(1, 1), a1 + hstep, voffA);
            PG8_WAIT_V(8); PG8_WAIT_L(0); PG8_BAR; PG8_MMA(0, 0, At, B0); PG8_MMA(0, 1, At, B1); PG8_BAR; PG8_SCHED;
            PG8_LDA(At, 0, 1); PG8_STAGE(PG8_SB(0, 0), b2, voffB); PG8_STAGE(PG8_SB(0, 1), b2 + hstep, voffB); PG8_STAGE(PG8_SA(0, 0), a2, voffA);
            PG8_WAIT_V(8); PG8_WAIT_L(0); PG8_BAR; PG8_MMA(1, 0, At, B0); PG8_MMA(1, 1, At, B1); PG8_BAR; PG8_SCHED;
            PG8_LDB(B0, 1, 0); PG8_LDB(B1, 1, 1); PG8_SCHED; PG8_LDA(At, 1, 0); PG8_STAGE(PG8_SA(0, 1), a2 + hstep, voffA);
            PG8_WAIT_V(8); PG8_WAIT_L(0); PG8_BAR; PG8_MMA(0, 0, At, B0); PG8_MMA(0, 1, At, B1); PG8_BAR; PG8_SCHED;
            PG8_LDA(At, 1, 1); PG8_STAGE(PG8_SB(1, 0), b3, voffB); PG8_STAGE(PG8_SB(1, 1), b3 + hstep, voffB); PG8_STAGE(PG8_SA(1, 0), a3, voffA);
            PG8_WAIT_V(8); PG8_WAIT_L(0); PG8_BAR; PG8_MMA(1, 0, At, B0); PG8_MMA(1, 1, At, B1); PG8_BAR; PG8_SCHED;
            } else {
            PG8_LDB(B0, 0, 0); PG8_SCHED; PG8_LDA(At, 0, 0); PG8_STAGE(PG8_SA(1, 1), a1 + hstep, voffA);
            PG8_WAIT_L(8); PG8_BAR; PG8_WAIT_L(0); PG8_MMA(0, 0, At, B0); PG8_BAR; PG8_SCHED;
            PG8_LDB(B1, 0, 1); PG8_STAGE(PG8_SB(0, 0), b2, voffB);
            PG8_BAR; PG8_WAIT_L(0); PG8_MMA(0, 1, At, B1); PG8_BAR;
            PG8_LDA(At, 0, 1); PG8_STAGE(PG8_SA(0, 0), a2, voffA);
            PG8_BAR; PG8_WAIT_L(0); PG8_MMA(1, 0, At, B0); PG8_BAR; PG8_SCHED;
            PG8_STAGE(PG8_SB(0, 1), b2 + hstep, voffB);
            PG8_WAIT_V(6); PG8_BAR; PG8_MMA(1, 1, At, B1); PG8_BAR;
            PG8_LDB(B0, 1, 0); PG8_SCHED; PG8_LDA(At, 1, 0); PG8_STAGE(PG8_SA(0, 1), a2 + hstep, voffA);
            PG8_WAIT_L(8); PG8_BAR; PG8_WAIT_L(0); PG8_MMA(0, 0, At, B0); PG8_BAR; PG8_SCHED;
            PG8_LDB(B1, 1, 1); PG8_STAGE(PG8_SB(1, 0), b3, voffB);
            PG8_BAR; PG8_WAIT_L(0); PG8_MMA(0, 1, At, B1); PG8_BAR;
            PG8_LDA(At, 1, 1); PG8_STAGE(PG8_SA(1, 0), a3, voffA);
            PG8_BAR; PG8_WAIT_L(0); PG8_MMA(1, 0, At, B0); PG8_BAR; PG8_SCHED;
            PG8_STAGE(PG8_SB(1, 1), b3 + hstep, voffB);
            PG8_WAIT_V(6); PG8_BAR; PG8_MMA(1, 1, At, B1); PG8_BAR;
            }
        }
        if constexpr (ALIGN_EPI) { if (wr == 0) PG8_BAR; }
        if constexpr (!Epi::AFTER_DRAIN) { E(acc, cur, wr, wc, fr, fq); S.done(cur); }
        if (!has_next) break;
#pragma unroll
        for (int a = 0; a < 2; ++a)
#pragma unroll
            for (int b = 0; b < 2; ++b)
#pragma unroll
                for (int m = 0; m < 4; ++m)
#pragma unroll
                    for (int n = 0; n < 2; ++n) acc[a][b][m][n] = (acc_t){0, 0, 0, 0};
        cur = nxt; cA = nA; cB = nB; ++ui;
        if constexpr (ALIGN_EPI) { if (wr == 1) PG8_BAR; }
    }
    PG8_WAIT_V(0);
    if constexpr (!ALIGN_EPI) { if (wr == 0) PG8_BAR; }
    PG8_BAR;
    if constexpr (Epi::AFTER_DRAIN) { E.fused(acc, cur, wr, wc, fr, fq, lds, wid, lane); S.done(cur); }
#undef PG8_SA
#undef PG8_SB
#undef PG8_STAGE
#undef PG8_LDA
#undef PG8_LDB
#undef PG8_MMA
#undef PG8_WAIT_V
#undef PG8_WAIT_L
#undef PG8_BAR
#undef PG8_SCHED
}
}
constexpr int NB = 16, SEQ = 2048, CTXL = 256, D = 1024;
constexpr int ML = NB * SEQ, MC = NB * CTXL, MT = ML + MC;
constexpr int INW = 4128, PW = 4096, NIN = 4352;
constexpr int DFF = 2816, NEXP = 8, DEXP = 3584;
constexpr int NWAVES = 8, NTHR = 512;
constexpr float EPS = 1e-6f;
constexpr int PH_M0 = 16, NPHASE = 21;
constexpr int CHUNK_PAN = 128, NCHK = 256 / CHUNK_PAN;
constexpr int NPOS = CTXL + SEQ, PBLK_G = 256, PBLK_H = 768;
constexpr size_t PH_OFF = (size_t)NB * 4 * NPOS * PBLK_G;
constexpr int HS_ROWS = 2 * ML + NEXP * 256;

constexpr size_t MiB = 1u << 20;
constexpr size_t WS_CTL = 0, CTL_ZERO_BYTES = 1 * MiB;
constexpr size_t WS_MODS = 1 * MiB, WS_ROUTE = 2 * MiB, WS_GR = 4 * MiB, WS_WIN = 7 * MiB, WS_WOUT = 24 * MiB, WS_F13 = 28 * MiB, WS_F2 = 39 * MiB;
constexpr size_t WS_XC = 45 * MiB, WS_H = 61 * MiB, WS_OB = 133 * MiB, WS_G = 205 * MiB, WS_P = 277 * MiB, WS_END = 565 * MiB;
constexpr size_t WS_MIX = WS_P, WS_ACT0 = WS_P, WS_HS = WS_OB, WS_ACT = 265 * MiB, WS_HSQ = 503 * MiB, WS_END2 = 576 * MiB;
constexpr size_t DO_M2 = 0, DO_M13Q = 64 * MiB;
constexpr size_t WS_HQ = WS_H, WS_SB13 = WS_GR + 2621440, WS_SBIN = WS_GR + 2883584, WS_SBF = WS_SBIN + 32768, WS_SBO = WS_SBF + 32768, WS_SAR = WS_SBO + 8192;
constexpr size_t WS_X3 = WS_H, WS_HQ2 = WS_OB;
constexpr size_t WS_WINQ = WS_WIN + MiB, WS_MIXQ = WS_MIX;
static_assert(WS_GR + (size_t)MT * 32 * 2 <= WS_WIN && WS_WIN + 2ull * NIN * 1024 * 2 <= WS_WOUT && WS_F13 + 5632ull * 1024 * 2 <= WS_F2 && WS_F2 + 1024ull * DFF * 2 <= WS_XC, "ws map 1");
static_assert(WS_XC + (size_t)MC * D * 4 <= WS_H && WS_H + (size_t)MT * D * 2 <= WS_OB && WS_OB + (size_t)MT * D * 2 <= WS_G && WS_G + (size_t)MT * D * 2 <= WS_P && WS_P + (size_t)MT * PW * 2 <= WS_END, "ws map 2");
static_assert(WS_ACT0 + (size_t)MT * DFF * 2 <= WS_END && WS_HS + (size_t)HS_ROWS * D * 2 <= WS_ACT && WS_ACT + (size_t)(CHUNK_PAN + 8) * 256 * DEXP * 2 <= WS_HSQ && DO_M2 + 8ull * 1024 * DEXP * 2 <= DO_M13Q && DO_M13Q + 8ull * 7168 * 1024 <= (size_t)ML * D * 4 && WS_HSQ + (size_t)HS_ROWS * D <= WS_END2, "ws map 3");
static_assert(WS_HQ + (size_t)ML * D <= WS_OB && WS_SB13 + 8 * 7168 * 4 <= WS_SBIN && WS_SAR + (size_t)MT * 4 <= WS_WIN && WS_HQ + (size_t)MT * D <= WS_OB && WS_WINQ + 2ull * 4096 * 1024 <= WS_WOUT, "mix vs moe weights; int8 rows; scales");
constexpr int MO_LAT = 0, MO_CTX = 2 * 16 * 6144, MO_LB = MO_CTX + 2 * 6144;
constexpr size_t RT_SEL = 0, RT_W = 512 * 1024, RT_CNT = 768 * 1024, RT_GW = 1024 * 1024, RT_SA = 1536 * 1024, RT_SAN = 1792 * 1024;
constexpr int CW_TMO = 0, CW_CODE = 1, CW_BAR = 4096, CW_CM = 131072;
constexpr int RING_BYTES = 131072, LDSCTL_OFF = RING_BYTES, MISC_OFF = LDSCTL_OFF + 320, TAB_OFF = LDSCTL_OFF + 512, LDS_BYTES = 147456;

#define GAS __attribute__((address_space(1)))
#define LAS __attribute__((address_space(3)))
typedef unsigned short bf16;
typedef unsigned v4u __attribute__((ext_vector_type(4)));
typedef unsigned v2u __attribute__((ext_vector_type(2)));
typedef int v4i __attribute__((ext_vector_type(4)));
typedef float f32x4 __attribute__((ext_vector_type(4)));
typedef float f32x2v __attribute__((ext_vector_type(2)));
#define LDS_WAIT() asm volatile("s_waitcnt lgkmcnt(0)" ::: "memory")
#define VM_WAIT() asm volatile("s_waitcnt vmcnt(0)" ::: "memory")
typedef float f32x2_t __attribute__((ext_vector_type(2)));
typedef __bf16 bf16x2_t __attribute__((ext_vector_type(2)));
__device__ __forceinline__ unsigned cvtpk(float lo, float hi) { f32x2_t v = {lo, hi}; bf16x2_t b = __builtin_convertvector(v, bf16x2_t); return __builtin_bit_cast(unsigned, b); }
__device__ __forceinline__ unsigned f2bf(float f) { unsigned u = __builtin_bit_cast(unsigned, f); return (u + 0x7fffu + ((u >> 16) & 1u)) >> 16; }
__device__ __forceinline__ unsigned pk2(float lo, float hi) { return cvtpk(lo, hi); }
__device__ __forceinline__ float bf2f(unsigned b) { return __builtin_bit_cast(float, b << 16); }
__device__ __forceinline__ float bflo(unsigned w) { return __builtin_bit_cast(float, w << 16); }
__device__ __forceinline__ float bfhi(unsigned w) { return __builtin_bit_cast(float, w & 0xffff0000u); }
__device__ __forceinline__ float wave_sum(float v) {
#pragma unroll
    for (int o = 1; o < 64; o <<= 1) v += __shfl_xor(v, o);
    return v;
}
__device__ __forceinline__ float silu_f(float x) { return x * __builtin_amdgcn_rcpf(1.f + __expf(-x)); }
__device__ __forceinline__ float logsig_f(float x) { return fminf(x, 0.f) - __logf(1.f + __expf(-fabsf(x))); }

#define XB_TMO      128
#define XB_XCNT(j)  (256  + 64 * (j))
#define XB_XSUB(j)  (1280 + 64 * (j))
#define XB_XGEN(j)  (2304 + 64 * (j))
#define XB_TOP      3328
#define XB_TOPGEN   3392
#define XCD_BAR_WORDS 3456
#define XB_SPIN_CAP (1u << 18)

__device__ __forceinline__ unsigned xb_ld(unsigned* p)              { return __hip_atomic_load(p, __ATOMIC_RELAXED, __HIP_MEMORY_SCOPE_AGENT); }
__device__ __forceinline__ unsigned xb_add(unsigned* p, unsigned v) { return __hip_atomic_fetch_add(p, v, __ATOMIC_RELAXED, __HIP_MEMORY_SCOPE_AGENT); }
__device__ __forceinline__ unsigned xb_xcc_id() { return (unsigned)__builtin_amdgcn_s_getreg((3 << 11) | 20) & 0xFu; }
#define XB_SPIN(cond, bar) do { unsigned _sp = 0; while (cond) { __builtin_amdgcn_s_sleep(1); \
    if ((++_sp & 255u) == 0u) { if (xb_ld(&(bar)[XB_TMO])) break; if (_sp > XB_SPIN_CAP) { atomicAdd(&(bar)[XB_TMO], 1u); break; } } } } while (0)

struct XcdBarrier {
    unsigned* bar; unsigned x;
    volatile LAS unsigned* st;
};

__device__ __forceinline__ XcdBarrier xcd_barrier_post(unsigned* bar, volatile LAS unsigned* st) {
    XcdBarrier b; b.bar = bar; b.x = xb_xcc_id(); b.st = st;
    if (threadIdx.x == 0) (void)xb_add(&bar[XB_XCNT(b.x)], 1u);
    return b;
}
__device__ __forceinline__ void xcd_barrier_complete(unsigned* bar, unsigned x, unsigned& nloc, unsigned& nx) {
    const unsigned G = gridDim.x * gridDim.y * gridDim.z;
    unsigned sum, cnt, mine, sp = 0u;
    for (;;) {
        sum = 0u; cnt = 0u; mine = 0u;
#pragma unroll
        for (unsigned j = 0; j < 16; ++j) { const unsigned c = xb_ld(&bar[XB_XCNT(j)]); sum += c; cnt += (c > 0u) ? 1u : 0u; mine = (j == x) ? c : mine; }
        if (sum == G) break;
        __builtin_amdgcn_s_sleep(1);
        if ((++sp & 255u) == 0u) { if (xb_ld(&bar[XB_TMO])) break; if (sp > XB_SPIN_CAP) { atomicAdd(&bar[XB_TMO], 1u); break; } }
    }
    nloc = mine > 0u ? mine : 1u; nx = cnt > 0u ? cnt : 1u;
}

template <bool LIGHT = false> __device__ __forceinline__ void xcd_barrier(const XcdBarrier& b) {
    asm volatile("s_waitcnt vmcnt(0)" ::: "memory");
    __syncthreads();
    if (threadIdx.x == 0) {
        unsigned* bar = b.bar;
        __builtin_amdgcn_s_waitcnt(0);
        unsigned nloc = b.st[0], nx = b.st[1];
        if (nloc == 0u) { xcd_barrier_complete(bar, b.x, nloc, nx); b.st[0] = nloc; b.st[1] = nx; }
        const unsigned old = xb_add(&bar[XB_XSUB(b.x)], 1u);
        const unsigned gen = old / nloc;
        if (old + 1u == (gen + 1u) * nloc) {
            if constexpr (!LIGHT) __builtin_amdgcn_fence(__ATOMIC_RELEASE, "agent");
            asm volatile("s_waitcnt vmcnt(0)" ::: "memory");
            const unsigned og = xb_add(&bar[XB_TOP], 1u);
            const unsigned tg = og / nx;
            if (og + 1u == (tg + 1u) * nx) xb_add(&bar[XB_TOPGEN], 1u);
            else XB_SPIN(xb_ld(&bar[XB_TOPGEN]) == tg, bar);
            if constexpr (!LIGHT) __builtin_amdgcn_fence(__ATOMIC_ACQUIRE, "agent");
            xb_add(&bar[XB_XGEN(b.x)], 1u);
            asm volatile("s_waitcnt vmcnt(0)" ::: "memory");
        } else {
            XB_SPIN(xb_ld(&bar[XB_XGEN(b.x)]) == gen, bar);
            if constexpr (!LIGHT) __builtin_amdgcn_fence(__ATOMIC_ACQUIRE, "agent");
            asm volatile("s_waitcnt vmcnt(0)" ::: "memory");
        }
    }
    __syncthreads();
}
using pg8::Unit;
template <bool Q> struct EpiInProjT {
    static constexpr bool PERM = true, AFTER_DRAIN = false, I8 = Q;
    typedef typename pg8::AccSel<Q>::T acc_t;
    bf16* P; bf16* G; bf16* GR; const float* LB; const float* SA; const float* SB;
    __device__ __forceinline__ void cvt8(const acc_t& v0, const acc_t& v1, const Unit& u, int row, int ct, float (&a)[8]) const {
        if constexpr (Q) { const float s = SA[row]; const f32x4 b0 = *(const f32x4*)(SB + u.pn * 256 + ct), b1 = *(const f32x4*)(SB + u.pn * 256 + ct + 4);
            a[0] = (float)v0[0] * (s * b0.x); a[1] = (float)v0[1] * (s * b0.y); a[2] = (float)v0[2] * (s * b0.z); a[3] = (float)v0[3] * (s * b0.w); a[4] = (float)v1[0] * (s * b1.x); a[5] = (float)v1[1] * (s * b1.y); a[6] = (float)v1[2] * (s * b1.z); a[7] = (float)v1[3] * (s * b1.w); }
        else { a[0] = v0[0]; a[1] = v0[1]; a[2] = v0[2]; a[3] = v0[3]; a[4] = v1[0]; a[5] = v1[1]; a[6] = v1[2]; a[7] = v1[3]; } }
    __device__ __forceinline__ void operator()(const acc_t (&acc)[2][2][4][2], const Unit& u, int wr, int wc, int fr, int fq) const {
        const int pn = u.pn;
        const int row0 = u.pm * 256 + wr * 64 + fr, cin = wc * 32 + 8 * fq;
        if (pn == 16) {
            if (wc == 0) {
#pragma unroll
                for (int ai = 0; ai < 2; ++ai)
#pragma unroll
                    for (int m = 0; m < 4; ++m) { float a[8]; cvt8(acc[ai][0][m][0], acc[ai][0][m][1], u, row0 + ai * 128 + m * 16, 8 * fq, a); v4u w; w.x = pk2(a[0], a[1]); w.y = pk2(a[2], a[3]); w.z = pk2(a[4], a[5]); w.w = pk2(a[6], a[7]);
                        *(v4u*)(GR + (size_t)(row0 + ai * 128 + m * 16) * 32 + 8 * fq) = w; }
            }
            return;
        }
        if (pn == 4 || pn == 5 || pn >= 14) {
            const int dcol = (pn >= 14) ? 512 + 256 * (pn - 14) : 256 * (pn - 4);
#pragma unroll
            for (int ai = 0; ai < 2; ++ai)
#pragma unroll
                for (int m = 0; m < 4; ++m)
#pragma unroll
                    for (int bj = 0; bj < 2; ++bj) { float a[8]; cvt8(acc[ai][bj][m][0], acc[ai][bj][m][1], u, row0 + ai * 128 + m * 16, bj * 128 + cin, a);
                        v4u w; w.x = pk2(a[0], a[1]); w.y = pk2(a[2], a[3]); w.z = pk2(a[4], a[5]); w.w = pk2(a[6], a[7]);
                        *(v4u*)(G + (size_t)(row0 + ai * 128 + m * 16) * 1024 + dcol + bj * 128 + cin) = w; }
            return;
        }
        const bool gla = pn <= 3; const int blk = gla ? PBLK_G : PBLK_H;
        int mode = 1, hdv[2], tof[2], tof2 = 0; const float* lbp = LB;
#pragma unroll
        for (int bj = 0; bj < 2; ++bj) { const int c = bj * 128 + cin;
            if (pn == 0) { mode = 0; hdv[bj] = c >> 6; tof[bj] = (c & 63); }
            else if (pn == 1) { hdv[bj] = c >> 6; tof[bj] = 64 + (c & 63); }
            else if (pn <= 3) { hdv[bj] = 2 * (pn - 2) + bj; tof[bj] = 128 + cin; }
            else if (pn <= 7) { mode = 2; hdv[bj] = 2 * (pn - 6) + bj; tof[bj] = 384 + cin; }
            else if (pn <= 9) { mode = 3; hdv[bj] = 2 * (pn - 8) + bj; tof[bj] = 512 + cin; tof2 = 128; lbp = LB + 256 * (pn - 8); }
            else if (pn <= 11) { mode = 3; hdv[bj] = 2 * (pn - 10) + bj; tof[bj] = cin; tof2 = 128; lbp = LB + 512 + 256 * (pn - 10); }
            else { hdv[bj] = 2 * (pn - 12) + bj; tof[bj] = 256 + cin; } }
        bf16* Pp = P + (gla ? 0 : PH_OFF);
        float lb[2][8];
        if (mode == 3) {
#pragma unroll
            for (int bj = 0; bj < 2; ++bj)
#pragma unroll
                for (int j = 0; j < 8; ++j) lb[bj][j] = lbp[bj * 128 + cin + j];
        }
#pragma unroll
        for (int ai = 0; ai < 2; ++ai)
#pragma unroll
            for (int m = 0; m < 4; ++m) {
                const int row = row0 + ai * 128 + m * 16; int b, pos;
                if (row < ML) { b = row >> 11; const int t = row & (SEQ - 1); pos = CTXL + (gla ? t : ((t & 63) * 32 + (t >> 6))); } else { b = (row - ML) >> 8; pos = (row - ML) & (CTXL - 1); }
#pragma unroll
                for (int bj = 0; bj < 2; ++bj) {
                    bf16* dp = Pp + ((size_t)(b * 4 + hdv[bj]) * NPOS + pos) * blk + tof[bj];
                    float a[8]; cvt8(acc[ai][bj][m][0], acc[ai][bj][m][1], u, row, bj * 128 + cin, a);
                    if (mode == 3) {
#pragma unroll
                        for (int j = 0; j < 8; ++j) { const float e = __expf(-fabsf(a[j])), r = __builtin_amdgcn_rcpf(1.f + e), sn = a[j] >= 0.f ? e * r : r;
                            a[j] = (1.f - lb[bj][j]) * sn; } }
                    else if (mode == 0) {
#pragma unroll
                        for (int j = 0; j < 8; ++j) a[j] *= 0.125f; }
                    else if (mode == 2) {
#pragma unroll
                        for (int j = 0; j < 8; ++j) a[j] = silu_f(a[j]); }
                    v4u w; w.x = pk2(a[0], a[1]); w.y = pk2(a[2], a[3]); w.z = pk2(a[4], a[5]); w.w = pk2(a[6], a[7]);
                    *(v4u*)dp = w;
                }
            }
    }
};
template <bool Q> struct EpiResidT {
    static constexpr bool PERM = false, AFTER_DRAIN = false, I8 = Q;
    typedef typename pg8::AccSel<Q>::T acc_t;
    const float* base_lat; const float* base_ctx; float* out_lat; float* out_ctx; const float* gate_lat; const float* gate_ctx; const float* SA; const float* SB;
    __device__ __forceinline__ void operator()(const acc_t (&acc)[2][2][4][2], const Unit& u, int wr, int wc, int fr, int fq) const {
        const int prow = u.pm * 256; const float* base; float* out; const float* gate; int r0;
        if (prow < ML) { base = base_lat; out = out_lat; gate = gate_lat + (prow >> 11) * 6144; r0 = prow; }
        else { base = base_ctx; out = out_ctx; gate = gate_ctx; r0 = prow - ML; }
        const int row0 = r0 + wr * 64 + fr, col0 = u.pn * 256 + wc * 32 + 4 * fq;
        pg8::f32x4 gv[2][2];
#pragma unroll
        for (int bj = 0; bj < 2; ++bj)
#pragma unroll
            for (int n = 0; n < 2; ++n) { gv[bj][n] = *(const pg8::f32x4*)(gate + col0 + bj * 128 + n * 16); if constexpr (Q) gv[bj][n] = gv[bj][n] * *(const pg8::f32x4*)(SB + col0 + bj * 128 + n * 16); }
#pragma unroll
        for (int ai = 0; ai < 2; ++ai) {
            pg8::f32x4 bs[4][2][2];
#pragma unroll
            for (int m = 0; m < 4; ++m) { const size_t off = (size_t)(row0 + ai * 128 + m * 16) * D + col0;
#pragma unroll
                for (int bj = 0; bj < 2; ++bj)
#pragma unroll
                    for (int n = 0; n < 2; ++n) bs[m][bj][n] = *(const pg8::f32x4*)(base + off + bj * 128 + n * 16); }
#pragma unroll
            for (int m = 0; m < 4; ++m) { const size_t off = (size_t)(row0 + ai * 128 + m * 16) * D + col0;
#pragma unroll
                for (int bj = 0; bj < 2; ++bj)
#pragma unroll
                    for (int n = 0; n < 2; ++n) { pg8::f32x4 av; if constexpr (Q) { const float s = SA[u.pm * 256 + wr * 64 + fr + ai * 128 + m * 16]; av = (pg8::f32x4){(float)acc[ai][bj][m][n][0] * s, (float)acc[ai][bj][m][n][1] * s, (float)acc[ai][bj][m][n][2] * s, (float)acc[ai][bj][m][n][3] * s}; } else av = acc[ai][bj][m][n];
                        *(pg8::f32x4*)(out + off + bj * 128 + n * 16) = bs[m][bj][n] + gv[bj][n] * av; } }
            asm volatile("" ::: "memory"); }
    }
};
template <bool F32IN> struct EpiResidB {
    static constexpr bool PERM = true, AFTER_DRAIN = false, I8 = false;
    const void* in_lat; const void* in_ctx; bf16* out_lat; bf16* out_ctx; const float* gate_lat; const float* gate_ctx;
    __device__ __forceinline__ void operator()(const pg8::f32x4 (&acc)[2][2][4][2], const Unit& u, int wr, int wc, int fr, int fq) const {
        const int prow = u.pm * 256; const unsigned char* base; bf16* out; const float* gate; int r0;
        if (prow < ML) { base = (const unsigned char*)in_lat; out = out_lat; gate = gate_lat + (prow >> 11) * 6144; r0 = prow; }
        else { base = (const unsigned char*)in_ctx; out = out_ctx; gate = gate_ctx; r0 = prow - ML; }
        const int row0 = r0 + wr * 64 + fr, col0 = u.pn * 256 + wc * 32 + 8 * fq;
        pg8::f32x4 gv[2][2];
#pragma unroll
        for (int bj = 0; bj < 2; ++bj)
#pragma unroll
            for (int n = 0; n < 2; ++n) gv[bj][n] = *(const pg8::f32x4*)(gate + col0 + bj * 128 + n * 4);
        if constexpr (F32IN) {
#pragma unroll
            for (int ai = 0; ai < 2; ++ai) {
                pg8::f32x4 bs[4][2][2];
#pragma unroll
                for (int m = 0; m < 4; ++m) { const size_t off = (size_t)(row0 + ai * 128 + m * 16) * D + col0;
#pragma unroll
                    for (int bj = 0; bj < 2; ++bj)
#pragma unroll
                        for (int n = 0; n < 2; ++n) bs[m][bj][n] = *(const pg8::f32x4*)((const float*)base + off + bj * 128 + n * 4); }
#pragma unroll
                for (int m = 0; m < 4; ++m) { const size_t off = (size_t)(row0 + ai * 128 + m * 16) * D + col0;
#pragma unroll
                    for (int bj = 0; bj < 2; ++bj) { const pg8::f32x4 v0 = bs[m][bj][0] + gv[bj][0] * acc[ai][bj][m][0], v1 = bs[m][bj][1] + gv[bj][1] * acc[ai][bj][m][1];
                        v4u w; w.x = pk2(v0[0], v0[1]); w.y = pk2(v0[2], v0[3]); w.z = pk2(v1[0], v1[1]); w.w = pk2(v1[2], v1[3]);
                        *(v4u*)(out + off + bj * 128) = w; } }
                asm volatile("" ::: "memory"); }
        } else {
#pragma unroll
            for (int ai = 0; ai < 2; ++ai) {
                v4u bs[4][2];
#pragma unroll
                for (int m = 0; m < 4; ++m) { const size_t off = (size_t)(row0 + ai * 128 + m * 16) * D + col0;
#pragma unroll
                    for (int bj = 0; bj < 2; ++bj) bs[m][bj] = *(const v4u*)((const bf16*)base + off + bj * 128); }
#pragma unroll
                for (int m = 0; m < 4; ++m) { const size_t off = (size_t)(row0 + ai * 128 + m * 16) * D + col0;
#pragma unroll
                    for (int bj = 0; bj < 2; ++bj) { const v4u b = bs[m][bj]; const pg8::f32x4 a0 = acc[ai][bj][m][0], a1 = acc[ai][bj][m][1], g0 = gv[bj][0], g1 = gv[bj][1];
                        v4u w; w.x = pk2(bflo(b.x) + g0[0] * a0[0], bfhi(b.x) + g0[1] * a0[1]); w.y = pk2(bflo(b.y) + g0[2] * a0[2], bfhi(b.y) + g0[3] * a0[3]);
                        w.z = pk2(bflo(b.z) + g1[0] * a1[0], bfhi(b.z) + g1[1] * a1[1]); w.w = pk2(bflo(b.w) + g1[2] * a1[2], bfhi(b.w) + g1[3] * a1[3]);
                        *(v4u*)(out + off + bj * 128) = w; } }
                asm volatile("" ::: "memory"); }
        }
    }
};
typedef EpiInProjT<false> EpiInProj; typedef EpiResidT<false> EpiResid;
struct EpiSwiGLU {
    static constexpr bool PERM = true, AFTER_DRAIN = false, I8 = false;
    bf16* ACT; int ldc, tiles, pm_off;
    __device__ __forceinline__ void operator()(const pg8::f32x4 (&acc)[2][2][4][2], const Unit& u, int wr, int wc, int fr, int fq) const {
        const int row0 = (u.pm - pm_off) * 256 + wr * 64 + fr, col0 = (u.pn % tiles) * 128 + wc * 32 + 8 * fq;
#pragma unroll
        for (int ai = 0; ai < 2; ++ai)
#pragma unroll
            for (int m = 0; m < 4; ++m) {
                const pg8::f32x4 g0 = acc[ai][0][m][0], g1 = acc[ai][0][m][1], u0 = acc[ai][1][m][0], u1 = acc[ai][1][m][1];
                float o[8];
#pragma unroll
                for (int j = 0; j < 4; ++j) { o[j] = silu_f(g0[j]) * u0[j]; o[4 + j] = silu_f(g1[j]) * u1[j]; }
                v4u w; w.x = pk2(o[0], o[1]); w.y = pk2(o[2], o[3]); w.z = pk2(o[4], o[5]); w.w = pk2(o[6], o[7]);
                *(v4u*)(ACT + (size_t)(row0 + ai * 128 + m * 16) * ldc + col0) = w;
            }
    }
};
struct EpiSwiGLUQ {
    static constexpr bool PERM = true, AFTER_DRAIN = false, I8 = true;
    bf16* ACT; int ldc, tiles, pm_off; const float* SA; const float* SB;
    __device__ __forceinline__ void operator()(const pg8::i32x4 (&acc)[2][2][4][2], const Unit& u, int wr, int wc, int fr, int fq) const {
        const int arow0 = u.pm * 256 + wr * 64 + fr, row0 = (u.pm - pm_off) * 256 + wr * 64 + fr, cin = wc * 32 + 8 * fq, col0 = (u.pn % tiles) * 128 + cin;
        float sg[8], su[8];
        { const f32x4 a0 = *(const f32x4*)(SB + (size_t)u.pn * 256 + cin), a1 = *(const f32x4*)(SB + (size_t)u.pn * 256 + cin + 4), b0 = *(const f32x4*)(SB + (size_t)u.pn * 256 + 128 + cin), b1 = *(const f32x4*)(SB + (size_t)u.pn * 256 + 128 + cin + 4);
          sg[0] = a0.x; sg[1] = a0.y; sg[2] = a0.z; sg[3] = a0.w; sg[4] = a1.x; sg[5] = a1.y; sg[6] = a1.z; sg[7] = a1.w; su[0] = b0.x; su[1] = b0.y; su[2] = b0.z; su[3] = b0.w; su[4] = b1.x; su[5] = b1.y; su[6] = b1.z; su[7] = b1.w; }
        float sa[2][4];
#pragma unroll
        for (int ai = 0; ai < 2; ++ai)
#pragma unroll
            for (int m = 0; m < 4; ++m) sa[ai][m] = SA[arow0 + ai * 128 + m * 16];
#pragma unroll
        for (int ai = 0; ai < 2; ++ai)
#pragma unroll
            for (int m = 0; m < 4; ++m) {
                const pg8::i32x4 g0 = acc[ai][0][m][0], g1 = acc[ai][0][m][1], u0 = acc[ai][1][m][0], u1 = acc[ai][1][m][1]; const float s = sa[ai][m];
                float o[8];
#pragma unroll
                for (int j = 0; j < 4; ++j) { o[j] = silu_f((float)g0[j] * (s * sg[j])) * ((float)u0[j] * (s * su[j])); o[4 + j] = silu_f((float)g1[j] * (s * sg[4 + j])) * ((float)u1[j] * (s * su[4 + j])); }
                v4u w; w.x = pk2(o[0], o[1]); w.y = pk2(o[2], o[3]); w.z = pk2(o[4], o[5]); w.w = pk2(o[6], o[7]);
                *(v4u*)(ACT + (size_t)(row0 + ai * 128 + m * 16) * ldc + col0) = w;
            }
    }
};
struct EpiMoeOut {
    static constexpr bool PERM = true, AFTER_DRAIN = false, I8 = false;
    bf16* Y; const float* GW; int pm_off;
    __device__ __forceinline__ void operator()(const pg8::f32x4 (&acc)[2][2][4][2], const Unit& u, int wr, int wc, int fr, int fq) const {
        const int row0 = (u.pm + pm_off) * 256 + wr * 64 + fr, col0 = (u.pn & 3) * 256 + wc * 32 + 8 * fq;
        float gwv[2][4];
#pragma unroll
        for (int ai = 0; ai < 2; ++ai)
#pragma unroll
            for (int m = 0; m < 4; ++m) gwv[ai][m] = GW[row0 + ai * 128 + m * 16];
#pragma unroll
        for (int ai = 0; ai < 2; ++ai)
#pragma unroll
            for (int m = 0; m < 4; ++m) { const int row = row0 + ai * 128 + m * 16; const float gw = gwv[ai][m];
#pragma unroll
                for (int bj = 0; bj < 2; ++bj) { const pg8::f32x4 v0 = acc[ai][bj][m][0] * gw, v1 = acc[ai][bj][m][1] * gw;
                    v4u w; w.x = pk2(v0[0], v0[1]); w.y = pk2(v0[2], v0[3]); w.z = pk2(v1[0], v1[1]); w.w = pk2(v1[2], v1[3]);
                    *(v4u*)(Y + (size_t)row * D + col0 + bj * 128) = w; } }
    }
};
struct MoeOrder {
    int nM, nN, nwg, G, c, pan0, a_local, nb, keep; int pb[8];
    __device__ __forceinline__ void init(int nM_, int nN_, int G_, int c_, int pan0_, int a_local_) { nM = nM_; nN = nN_; nwg = nM * nN; G = G_; c = c_; pan0 = pan0_; a_local = a_local_; nb = 0; keep = 4; }
    __device__ __forceinline__ bool next(int i, Unit& u) const {
        long L = (long)i * G + c;
        if (nb > 0) { const int rounds = (nwg + G - 1) / G;
            if (c < nb) { if (i >= keep) return false; }
            else if (i >= rounds) { const int e = c - nb + (i - rounds) * (G - nb); if (e >= (rounds - keep) * nb) return false; L = (long)(keep + e / nb) * G + (e % nb); } }
        if (L >= nwg) return false;
        int wgid = (int)L; { const int q = nwg / 8, r = nwg % 8, xcd = wgid % 8, off = wgid / 8; wgid = (xcd < r ? xcd * (q + 1) : r * (q + 1) + (xcd - r) * q) + off; }
        const int nig = 8 * nN, gid = wgid / nig, fm = gid * 8, gsz = (nM - fm) < 8 ? (nM - fm) : 8;
        const int pml = fm + ((wgid % nig) % gsz), pnl = (wgid % nig) / gsz, gp = pan0 + pml;
        int e = 0;
#pragma unroll
        for (int j = 1; j < 8; ++j) e += (gp >= pb[j]) ? 1 : 0;
        u.pm = a_local ? pml : gp; u.pn = e * nN + pnl; return true;
    }
    __device__ __forceinline__ void a_ready(const Unit&) const {}
    __device__ __forceinline__ void done(const Unit&) const {}
};


#if defined(PROBE_EXTRA)
        struct EpiNull { static constexpr bool PERM = true, AFTER_DRAIN = false, I8 = false; float* sink;
            __device__ __forceinline__ void operator()(const pg8::f32x4 (&acc)[2][2][4][2], const Unit& u, int wr, int wc, int fr, int fq) const { float s = 0.f;
#pragma unroll
                for (int a = 0; a < 2; ++a)
#pragma unroll
                    for (int b = 0; b < 2; ++b)
#pragma unroll
                        for (int mm = 0; mm < 4; ++mm)
#pragma unroll
                            for (int n = 0; n < 2; ++n) s += acc[a][b][mm][n][0] + acc[a][b][mm][n][1] + acc[a][b][mm][n][2] + acc[a][b][mm][n][3];
                if (s == 123456.789f) sink[threadIdx.x] = s; } };
        struct SameOrder : pg8::StaticOrder { int same; __device__ __forceinline__ bool next(int i, Unit& u) const { const bool r = pg8::StaticOrder::next(i, u); if (same) { u.pm = 0; u.pn = 0; } return r; } };

#endif
struct Args { const float* in[23]; float* out; unsigned char* ws; int ph_lo, ph_hi; };
typedef const __attribute__((address_space(4))) Args* KA;
__device__ __forceinline__ KA kargs() { KA p = (KA)__builtin_amdgcn_kernarg_segment_ptr(); asm volatile("" : "+s"(p)); return p; }
enum { I_X = 0, I_C, I_CTX, I_CCTX, I_WMOD, I_BMOD, I_N1G, I_N2G, I_WIN, I_GW2, I_GB, I_GLAG, I_HGG, I_HLB, I_WOUT, I_F1, I_F3, I_F2, I_ROUTER, I_M1, I_M3, I_M2, I_FNG };

__device__ __forceinline__ void tr_block(const float* W, int ldw, int col0, int k0, bf16* WT, int K, int drow0, LAS float* scr, int lane) {
    f32x4 v[8]; const int lr = lane >> 3, lc = 4 * (lane & 7);
#pragma unroll
    for (int i = 0; i < 8; ++i) v[i] = *(const f32x4*)(W + (size_t)(k0 + 8 * i + lr) * ldw + col0 + lc);
#pragma unroll
    for (int i = 0; i < 8; ++i) { LAS float* s = scr + (8 * i + lr) * 33 + lc; s[0] = v[i].x; s[1] = v[i].y; s[2] = v[i].z; s[3] = v[i].w; }
    LDS_WAIT(); asm volatile("" ::: "memory");
    const int c = lane & 7;
#pragma unroll
    for (int j = 0; j < 4; ++j) { const int n = (lane >> 3) + 8 * j; const LAS float* s = scr + (8 * c) * 33 + n;
        v4u o; o.x = pk2(s[0 * 33], s[1 * 33]); o.y = pk2(s[2 * 33], s[3 * 33]); o.z = pk2(s[4 * 33], s[5 * 33]); o.w = pk2(s[6 * 33], s[7 * 33]);
        *(v4u*)(WT + (size_t)(drow0 + n) * K + k0 + 8 * c) = o; }
    LDS_WAIT(); asm volatile("" ::: "memory");
}

__device__ __forceinline__ void tr_block_q(const float* W, int ldw, int col0, int k0, signed char* WQ, int K, int drow0, const float* sc, LAS float* scr, int lane) {
    f32x4 v[8]; const int lr = lane >> 3, lc = 4 * (lane & 7);
#pragma unroll
    for (int i = 0; i < 8; ++i) v[i] = *(const f32x4*)(W + (size_t)(k0 + 8 * i + lr) * ldw + col0 + lc);
#pragma unroll
    for (int i = 0; i < 8; ++i) { LAS float* s = scr + (8 * i + lr) * 33 + lc; s[0] = v[i].x; s[1] = v[i].y; s[2] = v[i].z; s[3] = v[i].w; }
    LDS_WAIT(); asm volatile("" ::: "memory");
    const int c = lane & 7;
#pragma unroll
    for (int j = 0; j < 4; ++j) { const int n = (lane >> 3) + 8 * j; const LAS float* s = scr + (8 * c) * 33 + n; const float inv = __builtin_amdgcn_rcpf(sc[drow0 + n]);
        int q[8];
#pragma unroll
        for (int e = 0; e < 8; ++e) { const float t = fminf(fmaxf(__builtin_rintf(s[e * 33] * inv), -127.f), 127.f); q[e] = (int)t & 255; }
        v2u o; o.x = (unsigned)q[0] | ((unsigned)q[1] << 8) | ((unsigned)q[2] << 16) | ((unsigned)q[3] << 24); o.y = (unsigned)q[4] | ((unsigned)q[5] << 8) | ((unsigned)q[6] << 16) | ((unsigned)q[7] << 24);
        *(v2u*)(WQ + (size_t)(drow0 + n) * K + k0 + 8 * c) = o; }
    LDS_WAIT(); asm volatile("" ::: "memory");
}

__device__ __forceinline__ void colmax_rows_item(KA a, int it, int tid) {
    const int e = it >> 5, which = (it >> 4) & 1, rb = it & 15;
    const float* W = (which ? a->in[I_M3] : a->in[I_M1]) + (size_t)e * 1024 * DEXP + (size_t)(64 * rb) * DEXP + tid;
    float mx[7];
#pragma unroll
    for (int j = 0; j < 7; ++j) mx[j] = 0.f;
    for (int r = 0; r < 64; r += 4) { float w[4][7];
#pragma unroll
        for (int i = 0; i < 4; ++i)
#pragma unroll
            for (int j = 0; j < 7; ++j) w[i][j] = W[(size_t)(r + i) * DEXP + 512 * j];
#pragma unroll
        for (int i = 0; i < 4; ++i)
#pragma unroll
            for (int j = 0; j < 7; ++j) mx[j] = fmaxf(mx[j], fabsf(w[i][j])); }
    unsigned* cm = (unsigned*)(a->ws + WS_CTL) + CW_CM + (e * 2 + which) * DEXP + tid;
#pragma unroll
    for (int j = 0; j < 7; ++j) atomicMax(cm + 512 * j, __builtin_bit_cast(unsigned, mx[j]));
}
__device__ __forceinline__ void colscale_item(KA a, int it, LAS unsigned char* lds, int tid, int lane, int wave) {
    LAS float* red = (LAS float*)lds;
    const int e = it / 112, r = it % 112, which = r / 56, g = r % 56;
    const float* W = (which ? a->in[I_M3] : a->in[I_M1]) + (size_t)e * 1024 * DEXP + 64 * g + lane;
    float mx = 0.f;
    for (int k0 = wave * 128; k0 < wave * 128 + 128; k0 += 32) { float w[32];
#pragma unroll
        for (int i = 0; i < 32; ++i) w[i] = W[(size_t)(k0 + i) * DEXP];
#pragma unroll
        for (int i = 0; i < 32; ++i) mx = fmaxf(mx, fabsf(w[i])); }
    red[wave * 64 + lane] = mx;
    __syncthreads();
    if (tid < 64) { float m = red[tid];
#pragma unroll
        for (int w = 1; w < 8; ++w) m = fmaxf(m, red[w * 64 + tid]);
        ((float*)(a->ws + WS_SB13))[(size_t)e * 7168 + 256 * (g >> 1) + 128 * which + 64 * (g & 1) + tid] = fmaxf(m, 1e-30f) * (1.f / 127.f); }
    __syncthreads();
}

__device__ __forceinline__ void colscale32(const float* W, int ldw, int K, int col0, float* dst, LAS unsigned char* lds, int tid, int lane, int wave) {
    LAS float* red = (LAS float*)lds; const int c = lane & 31, rh = lane >> 5; const float* p = W + (size_t)(wave * (K / 8) + rh) * ldw + col0 + c;
    float mx = 0.f;
    for (int k0 = 0; k0 < K / 16; k0 += 32) { float w[32];
#pragma unroll
        for (int i = 0; i < 32; ++i) w[i] = p[(size_t)(2 * (k0 + i)) * ldw];
#pragma unroll
        for (int i = 0; i < 32; ++i) mx = fmaxf(mx, fabsf(w[i])); }
    red[(wave * 2 + rh) * 32 + c] = mx;
    __syncthreads();
    if (tid < 32) { float m = red[tid];
#pragma unroll
        for (int w = 1; w < 16; ++w) m = fmaxf(m, red[w * 32 + tid]);
        dst[tid] = fmaxf(m, 1e-30f) * (1.f / 127.f); }
    __syncthreads();
}
constexpr int NS_WIN = 2 * 129, NS_F13 = 2 * 88, NS_WOUT = 2 * 32, NS_MAIN = NS_WIN + NS_F13;
__device__ __forceinline__ void colscale_item_main(KA a, int it, LAS unsigned char* lds, int tid, int lane, int wave) {
    unsigned char* ws = a->ws;
    if (it < NS_WIN) { const int l = it / 129, nb = it % 129; if (nb == 48) return; const int drow = nb < 48 ? 32 * nb : 32 * (nb - 1);
        colscale32(a->in[I_WIN] + (size_t)l * 1024 * INW, INW, 1024, 32 * nb, (float*)(ws + WS_SBIN) + l * 4096 + drow, lds, tid, lane, wave); return; }
    it -= NS_WIN;
    if (it < NS_F13) { const int which = it / 88, c = 32 * (it % 88); colscale32(which ? a->in[I_F3] : a->in[I_F1], DFF, 1024, c, (float*)(ws + WS_SBF) + 256 * (c >> 7) + 128 * which + (c & 127), lds, tid, lane, wave); return; }
    it -= NS_F13;
    { const int l = it / 32, nb = it % 32; colscale32(a->in[I_WOUT] + (size_t)l * 1024 * 1024, 1024, 1024, 32 * nb, (float*)(ws + WS_SBO) + l * 1024 + 32 * nb, lds, tid, lane, wave); }
}
constexpr int NQ_WIN = 2 * 16 * 129, NQ_F13 = 16 * 176, NQ_WOUT = 2 * 16 * 32, NQ_MAIN = NQ_WIN + NQ_F13;
__device__ __forceinline__ void conv_item_q(KA a, int it, LAS float* scr, int lane) {
    unsigned char* ws = a->ws;
    if (it < NQ_WIN) { const int l = it / 2064, r = it % 2064, kb = r / 129, nb = r % 129; if (nb == 48) return; const int drow = nb < 48 ? 32 * nb : 32 * (nb - 1);
        tr_block_q(a->in[I_WIN] + (size_t)l * 1024 * INW, INW, 32 * nb, 64 * kb, (signed char*)(ws + WS_WINQ) + (size_t)l * 4096 * 1024, 1024, drow, (const float*)(ws + WS_SBIN) + l * 4096, scr, lane); return; }
    it -= NQ_WIN;
    if (it < NQ_F13) { const int kb = it / 176, db = it % 176, drow = 32 * db, pn = drow >> 8, half = (drow >> 7) & 1, off = drow & 127;
        tr_block_q(half ? a->in[I_F3] : a->in[I_F1], DFF, 128 * pn + off, 64 * kb, (signed char*)(ws + WS_F13), 1024, drow, (const float*)(ws + WS_SBF), scr, lane); return; }
    it -= NQ_F13;
    { const int l = it / 512, r = it % 512, kb = r / 32, nb = r % 32;
      tr_block_q(a->in[I_WOUT] + (size_t)l * 1024 * 1024, 1024, 32 * nb, 64 * kb, (signed char*)(ws + WS_WOUT) + (size_t)l * 1024 * 1024, 1024, 32 * nb, (const float*)(ws + WS_SBO) + l * 1024, scr, lane); }
}
__device__ __forceinline__ void quant_row(const f32x4 (&y)[4], unsigned* qrow, float* srow, int lane) {
    float am = 0.f;
#pragma unroll
    for (int j = 0; j < 4; ++j) am = fmaxf(fmaxf(am, fmaxf(fabsf(y[j].x), fabsf(y[j].y))), fmaxf(fabsf(y[j].z), fabsf(y[j].w)));
#pragma unroll
    for (int o = 1; o < 64; o <<= 1) am = fmaxf(am, __shfl_xor(am, o));
    am = fmaxf(am, 1e-30f); const float inv = 127.f / am;
#pragma unroll
    for (int j = 0; j < 4; ++j) { const int q0 = (int)__builtin_rintf(y[j].x * inv), q1 = (int)__builtin_rintf(y[j].y * inv), q2 = (int)__builtin_rintf(y[j].z * inv), q3 = (int)__builtin_rintf(y[j].w * inv);
        qrow[lane + 64 * j] = (unsigned)(q0 & 255) | ((unsigned)(q1 & 255) << 8) | ((unsigned)(q2 & 255) << 16) | ((unsigned)(q3 & 255) << 24); }
    if (lane == 0) *srow = am * (1.f / 127.f);
}
constexpr int NI_F2 = 44 * 32, NI_MAIN = 32 + 2 * 512 + NI_F2;
constexpr int NI_M13E = 16 * 224, NI_M2E = 56 * 32, NI_M13 = 8 * NI_M13E, NI_MOE = NI_M13 + 8 * NI_M2E;
__device__ __forceinline__ void conv_item_main(KA a, int it, LAS float* scr, int lane) {
    unsigned char* ws = a->ws;
    if (it < 32) { const int l = it / 16, kb = it % 16; tr_block(a->in[I_WIN] + (size_t)l * 1024 * INW, INW, 1536, 64 * kb, (bf16*)(ws + WS_WIN) + (size_t)l * 32 * 1024, 1024, 0, scr, lane); return; }
    it -= 32;
    if (it < 2 * 512) { const int l = it / 512, r = it % 512, kb = r / 32, nb = r % 32; tr_block(a->in[I_WOUT] + (size_t)l * 1024 * 1024, 1024, 32 * nb, 64 * kb, (bf16*)(ws + WS_WOUT) + (size_t)l * 1024 * 1024, 1024, 32 * nb, scr, lane); return; }
    it -= 2 * 512;
    { const int kb = it / 32, nb = it % 32; tr_block(a->in[I_F2], 1024, 32 * nb, 64 * kb, (bf16*)(ws + WS_F2), DFF, 32 * nb, scr, lane); }
}
__device__ __forceinline__ void conv_item_moe(KA a, int it, LAS float* scr, int lane) {
    unsigned char* ws = a->ws;
    if (it < NI_M13) { const int e = it / NI_M13E, r = it % NI_M13E, kb = r / 224, db = r % 224, drow = 32 * db, pn = drow >> 8, half = (drow >> 7) & 1, off = drow & 127;
        tr_block_q((half ? a->in[I_M3] : a->in[I_M1]) + (size_t)e * 1024 * DEXP, DEXP, 128 * pn + off, 64 * kb, (signed char*)a->out + DO_M13Q + (size_t)e * 7168 * 1024, 1024, drow, (const float*)(ws + WS_SB13) + (size_t)e * 7168, scr, lane); return; }
    it -= NI_M13;
    { const int e = it / NI_M2E, r = it % NI_M2E, kb = r / 32, nb = r % 32;
      tr_block(a->in[I_M2] + (size_t)e * DEXP * 1024, 1024, 32 * nb, 64 * kb, (bf16*)((unsigned char*)a->out + DO_M2) + (size_t)e * 1024 * DEXP, DEXP, 32 * nb, scr, lane); }
}
__device__ __forceinline__ void mod_item(KA a, int it, LAS unsigned char* lds, int tid, int lane, int wave) {
    LAS float* sc = (LAS float*)lds; LAS float* red = (LAS float*)(lds + 69632);
    const int l = it / 96, n0 = 64 * (it % 96);
    for (int idx = tid; idx < 17 * 1024; idx += NTHR) { const int r = idx >> 10, k = idx & 1023; const float v = r < 16 ? a->in[I_C][r * 1024 + k] : a->in[I_CCTX][k]; sc[k * 17 + r] = silu_f(v); }
    __syncthreads();
    float acc[17];
#pragma unroll
    for (int r = 0; r < 17; ++r) acc[r] = 0.f;
    const float* wm = a->in[I_WMOD] + (size_t)l * 1024 * 6144 + n0 + lane;
    for (int k0 = wave * 128; k0 < wave * 128 + 128; k0 += 32) { float w[32];
#pragma unroll
        for (int i = 0; i < 32; ++i) w[i] = wm[(size_t)(k0 + i) * 6144];
#pragma unroll
        for (int i = 0; i < 32; ++i)
#pragma unroll
            for (int r = 0; r < 17; ++r) acc[r] += sc[(k0 + i) * 17 + r] * w[i]; }
#pragma unroll
    for (int r = 0; r < 17; ++r) red[(wave * 17 + r) * 64 + lane] = acc[r];
    __syncthreads();
    float* mods = (float*)(a->ws + WS_MODS);
    for (int idx = tid; idx < 17 * 64; idx += NTHR) { const int r = idx >> 6, ln = idx & 63; float s = a->in[I_BMOD][l * 6144 + n0 + ln];
#pragma unroll
        for (int w = 0; w < 8; ++w) s += red[(w * 17 + r) * 64 + ln];
        if (r < 16) mods[MO_LAT + (l * 16 + r) * 6144 + n0 + ln] = s; else mods[MO_CTX + l * 6144 + n0 + ln] = s; }
    __syncthreads();
}
__device__ __forceinline__ void ada_norm_row(const float* xrow, bf16* orow, const float* g, const float* shift, const float* scale, int lane, f32x4 (&y)[4]) {
    const f32x4* xr = (const f32x4*)xrow + lane; float s = 0.f;
#pragma unroll
    for (int j = 0; j < 4; ++j) { y[j] = xr[64 * j]; s += (y[j].x * y[j].x + y[j].y * y[j].y) + (y[j].z * y[j].z + y[j].w * y[j].w); }
    const float rstd = rsqrtf(wave_sum(s) * (1.f / D) + EPS);
    v2u* o8 = (v2u*)orow + lane;
#pragma unroll
    for (int j = 0; j < 4; ++j) { const f32x4 gv = ((const f32x4*)g)[lane + 64 * j], sh = ((const f32x4*)shift)[lane + 64 * j], sc = ((const f32x4*)scale)[lane + 64 * j];
        y[j] = y[j] * rstd * gv * (sc + 1.f) + sh; v2u w; w.x = pk2(y[j].x, y[j].y); w.y = pk2(y[j].z, y[j].w); o8[64 * j] = w; }
}
__device__ __forceinline__ int scan_row(int grp, int b, int dir, int step) {
    if (step < CTXL) { const int t = dir ? (CTXL - 1 - step) : step; return ML + b * CTXL + t; }
    int lp = step - CTXL; if (dir) lp = SEQ - 1 - lp;
    const int t = grp ? ((lp & 31) * 64 + (lp >> 5)) : lp;
    return b * SEQ + t;
}
template <int DK> __device__ __forceinline__ void scan_simple(LAS unsigned char* lds, const bf16* P, const bf16* GR, const float* w2, const float* gb, bf16* OUT, int grp, int b, int hd, int dir, int tid) {
    LAS float* qs = (LAS float*)lds; LAS float* ks = qs + 32 * 128; LAS float* fs = ks + 32 * 128; LAS float* vs = fs + 32 * 128; LAS float* red = vs + 32 * 128;
    const int j = tid & 127, cg = tid >> 7; constexpr int CPT = DK / 4;
    float st[CPT];
#pragma unroll
    for (int i = 0; i < CPT; ++i) st[i] = 0.f;
    for (int blk = 0; blk < (CTXL + SEQ) / 32; ++blk) {
        for (int idx = tid; idx < 32 * DK; idx += NTHR) { const int t = idx / DK, c = idx % DK, row = scan_row(grp, b, dir, blk * 32 + t); const bf16* pr = P + (size_t)row * PW; float q, k, lf;
            if (DK == 64) { q = bf2f(pr[hd * 64 + c]); k = bf2f(pr[256 + hd * 64 + c]); float lg = gb[hd * 64 + c]; const bf16* gr = GR + (size_t)row * 32 + dir * 16;
#pragma unroll
                for (int r = 0; r < 16; ++r) lg += bf2f(gr[r]) * w2[r * 256 + hd * 64 + c];
                lf = logsig_f(lg) * (1.f / 16.f); }
            else { q = bf2f(pr[1024 + hd * 128 + c]); k = bf2f(pr[(dir ? 2560 : 1536) + hd * 128 + c]); lf = bf2f(pr[(dir ? 3072 : 2048) + hd * 128 + c]); }
            qs[t * 128 + c] = q; ks[t * 128 + c] = k; fs[t * 128 + c] = __expf(lf); }
        for (int idx = tid; idx < 32 * 128; idx += NTHR) { const int t = idx >> 7, jj = idx & 127, row = scan_row(grp, b, dir, blk * 32 + t); vs[idx] = bf2f(P[(size_t)row * PW + (DK == 64 ? 512 : 3584) + hd * 128 + jj]); }
        __syncthreads();
        for (int t = 0; t < 32; ++t) { const float vv = vs[t * 128 + j]; float acc = 0.f;
#pragma unroll
            for (int i = 0; i < CPT; ++i) { const int c = cg * CPT + i; st[i] = st[i] * fs[t * 128 + c] + ks[t * 128 + c] * vv; acc += st[i] * qs[t * 128 + c]; }
            red[(t * 4 + cg) * 128 + j] = acc; }
        __syncthreads();
        for (int idx = tid; idx < 4096; idx += NTHR) { const int t = idx >> 7, jj = idx & 127, row = scan_row(grp, b, dir, blk * 32 + t);
            const float o = (red[(t * 4 + 0) * 128 + jj] + red[(t * 4 + 1) * 128 + jj]) + (red[(t * 4 + 2) * 128 + jj] + red[(t * 4 + 3) * 128 + jj]);
            OUT[(size_t)row * D + grp * 512 + hd * 128 + jj] = (bf16)f2bf(o); }
        __syncthreads();
    }
}
__device__ __forceinline__ void mix_row(const bf16* of, const bf16* ob, const bf16* gate, const float* gla_g, const float* hg_g, bf16* out, int lane) {
    const v4u* pf = (const v4u*)of + 2 * lane; const v4u* pb = (const v4u*)ob + 2 * lane; const v4u* pg = (const v4u*)gate + 2 * lane;
    const v4u f0 = pf[0], f1 = pf[1], b0 = pb[0], b1 = pb[1], g0 = pg[0], g1 = pg[1];
    const unsigned fw[8] = {f0.x, f0.y, f0.z, f0.w, f1.x, f1.y, f1.z, f1.w}, bw[8] = {b0.x, b0.y, b0.z, b0.w, b1.x, b1.y, b1.z, b1.w}, gw[8] = {g0.x, g0.y, g0.z, g0.w, g1.x, g1.y, g1.z, g1.w};
    float o[16]; float ss = 0.f;
#pragma unroll
    for (int i = 0; i < 8; ++i) { o[2 * i] = bflo(fw[i]) + bflo(bw[i]); o[2 * i + 1] = bfhi(fw[i]) + bfhi(bw[i]); ss += o[2 * i] * o[2 * i] + o[2 * i + 1] * o[2 * i + 1]; }
    ss += __shfl_xor(ss, 1); ss += __shfl_xor(ss, 2); ss += __shfl_xor(ss, 4);
    const float rstd = rsqrtf(ss * (1.f / 128.f) + EPS);
    const float* ng = ((lane >> 5) ? hg_g : gla_g) + (lane & 7) * 16;
    unsigned w[8];
#pragma unroll
    for (int i = 0; i < 8; ++i) { const float a = o[2 * i] * rstd * ng[2 * i] * silu_f(bflo(gw[i])), c = o[2 * i + 1] * rstd * ng[2 * i + 1] * silu_f(bfhi(gw[i])); w[i] = pk2(a, c); }
    v4u* po = (v4u*)out + 2 * lane; po[0] = (v4u){w[0], w[1], w[2], w[3]}; po[1] = (v4u){w[4], w[5], w[6], w[7]};
}

__device__ __forceinline__ void xload(const float* xrow, int lane, f32x4 (&y)[4]) {
    const f32x4* xr = (const f32x4*)xrow + lane;
#pragma unroll
    for (int j = 0; j < 4; ++j) y[j] = xr[64 * j];
}
__device__ __forceinline__ void xloadb(const bf16* xrow, int lane, v2u (&r)[4]) {
    const v2u* xr = (const v2u*)xrow + lane;
#pragma unroll
    for (int j = 0; j < 4; ++j) r[j] = xr[64 * j];
}
__device__ __forceinline__ void xcvt(const v2u (&r)[4], f32x4 (&y)[4]) {
#pragma unroll
    for (int j = 0; j < 4; ++j) y[j] = (f32x4){bflo(r[j].x), bfhi(r[j].x), bflo(r[j].y), bfhi(r[j].y)};
}
__device__ __forceinline__ void norm_finish(bf16* orow, const float* g, const float* shift, const float* scale, int lane, f32x4 (&y)[4]) {
    float s = 0.f;
#pragma unroll
    for (int j = 0; j < 4; ++j) s += (y[j].x * y[j].x + y[j].y * y[j].y) + (y[j].z * y[j].z + y[j].w * y[j].w);
    const float rstd = rsqrtf(wave_sum(s) * (1.f / D) + EPS);
    v2u* o8 = (v2u*)orow + lane;
#pragma unroll
    for (int j = 0; j < 4; ++j) { const f32x4 gv = ((const f32x4*)g)[lane + 64 * j], sh = ((const f32x4*)shift)[lane + 64 * j], sc = ((const f32x4*)scale)[lane + 64 * j];
        y[j] = y[j] * rstd * gv * (sc + 1.f) + sh; v2u w; w.x = pk2(y[j].x, y[j].y); w.y = pk2(y[j].z, y[j].w); o8[64 * j] = w; }
}
__device__ __forceinline__ void norm_finish_q(unsigned* qrow, float* srow, const float* g, const float* shift, const float* scale, int lane, f32x4 (&y)[4]) {
    float s = 0.f;
#pragma unroll
    for (int j = 0; j < 4; ++j) s += (y[j].x * y[j].x + y[j].y * y[j].y) + (y[j].z * y[j].z + y[j].w * y[j].w);
    const float rstd = rsqrtf(wave_sum(s) * (1.f / D) + EPS);
#pragma unroll
    for (int j = 0; j < 4; ++j) { const f32x4 gv = ((const f32x4*)g)[lane + 64 * j], sh = ((const f32x4*)shift)[lane + 64 * j], sc = ((const f32x4*)scale)[lane + 64 * j]; y[j] = y[j] * rstd * gv * (sc + 1.f) + sh; }
    quant_row(y, qrow, srow, lane);
}
struct MixIn { v4u f0, f1, b0, b1, g0, g1; };
__device__ __forceinline__ void mix_load(const bf16* of, const bf16* ob, const bf16* gate, int lane, MixIn& r) {
    const v4u* pf = (const v4u*)of + 2 * lane; const v4u* pb = (const v4u*)ob + 2 * lane; const v4u* pg = (const v4u*)gate + 2 * lane;
    r.f0 = pf[0]; r.f1 = pf[1]; r.b0 = pb[0]; r.b1 = pb[1]; r.g0 = pg[0]; r.g1 = pg[1];
}
__device__ __forceinline__ void mix_finish(const MixIn& r, const float* gla_g, const float* hg_g, signed char* out, float* srow, int lane) {
    const unsigned fw[8] = {r.f0.x, r.f0.y, r.f0.z, r.f0.w, r.f1.x, r.f1.y, r.f1.z, r.f1.w}, bw[8] = {r.b0.x, r.b0.y, r.b0.z, r.b0.w, r.b1.x, r.b1.y, r.b1.z, r.b1.w}, gw[8] = {r.g0.x, r.g0.y, r.g0.z, r.g0.w, r.g1.x, r.g1.y, r.g1.z, r.g1.w};
    float o[16]; float ss = 0.f;
#pragma unroll
    for (int i = 0; i < 8; ++i) { o[2 * i] = bflo(fw[i]) + bflo(bw[i]); o[2 * i + 1] = bfhi(fw[i]) + bfhi(bw[i]); ss += o[2 * i] * o[2 * i] + o[2 * i + 1] * o[2 * i + 1]; }
    ss += __shfl_xor(ss, 1); ss += __shfl_xor(ss, 2); ss += __shfl_xor(ss, 4);
    const float rstd = rsqrtf(ss * (1.f / 128.f) + EPS);
    const float* ng = ((lane >> 5) ? hg_g : gla_g) + (lane & 7) * 16;
    float mv[16]; float am = 0.f;
#pragma unroll
    for (int i = 0; i < 8; ++i) { mv[2 * i] = o[2 * i] * rstd * ng[2 * i] * silu_f(bflo(gw[i])); mv[2 * i + 1] = o[2 * i + 1] * rstd * ng[2 * i + 1] * silu_f(bfhi(gw[i])); am = fmaxf(am, fmaxf(fabsf(mv[2 * i]), fabsf(mv[2 * i + 1]))); }
#pragma unroll
    for (int of = 1; of < 64; of <<= 1) am = fmaxf(am, __shfl_xor(am, of));
    am = fmaxf(am, 1e-30f); const float inv = 127.f / am; unsigned w[4];
#pragma unroll
    for (int i = 0; i < 4; ++i) { const int q0 = (int)__builtin_rintf(mv[4 * i] * inv), q1 = (int)__builtin_rintf(mv[4 * i + 1] * inv), q2 = (int)__builtin_rintf(mv[4 * i + 2] * inv), q3 = (int)__builtin_rintf(mv[4 * i + 3] * inv);
        w[i] = (unsigned)(q0 & 255) | ((unsigned)(q1 & 255) << 8) | ((unsigned)(q2 & 255) << 16) | ((unsigned)(q3 & 255) << 24); }
    ((v4u*)out)[lane] = (v4u){w[0], w[1], w[2], w[3]};
    if (lane == 0) *srow = am * (1.f / 127.f);
}
__device__ __forceinline__ void mix_finish_bf(const MixIn& r, const float* gla_g, const float* hg_g, bf16* out, int lane) {
    const unsigned fw[8] = {r.f0.x, r.f0.y, r.f0.z, r.f0.w, r.f1.x, r.f1.y, r.f1.z, r.f1.w}, bw[8] = {r.b0.x, r.b0.y, r.b0.z, r.b0.w, r.b1.x, r.b1.y, r.b1.z, r.b1.w}, gw[8] = {r.g0.x, r.g0.y, r.g0.z, r.g0.w, r.g1.x, r.g1.y, r.g1.z, r.g1.w};
    float o[16]; float ss = 0.f;
#pragma unroll
    for (int i = 0; i < 8; ++i) { o[2 * i] = bflo(fw[i]) + bflo(bw[i]); o[2 * i + 1] = bfhi(fw[i]) + bfhi(bw[i]); ss += o[2 * i] * o[2 * i] + o[2 * i + 1] * o[2 * i + 1]; }
    ss += __shfl_xor(ss, 1); ss += __shfl_xor(ss, 2); ss += __shfl_xor(ss, 4);
    const float rstd = rsqrtf(ss * (1.f / 128.f) + EPS);
    const float* ng = ((lane >> 5) ? hg_g : gla_g) + (lane & 7) * 16;
    unsigned w[8];
#pragma unroll
    for (int i = 0; i < 8; ++i) { const float a = o[2 * i] * rstd * ng[2 * i] * silu_f(bflo(gw[i])), c = o[2 * i + 1] * rstd * ng[2 * i + 1] * silu_f(bfhi(gw[i])); w[i] = pk2(a, c); }
    v4u* po = (v4u*)out + 2 * lane; po[0] = (v4u){w[0], w[1], w[2], w[3]}; po[1] = (v4u){w[4], w[5], w[6], w[7]};
}
template <bool ATOMIC> __device__ __forceinline__ void moe_tab(KA a, LAS unsigned char* lds, int tid, int wg) {
    LAS int* tab = (LAS int*)(lds + TAB_OFF);
    if (tid < 32) tab[tid] = 0;
    __syncthreads();
    if (tid < 256) { int c[8];
        if constexpr (ATOMIC) {
#pragma unroll
            for (int e = 0; e < 8; ++e) c[e] = __hip_atomic_load((int*)(a->ws + WS_ROUTE + RT_CNT) + 8 * tid + e, __ATOMIC_RELAXED, __HIP_MEMORY_SCOPE_AGENT); }
        else { const v4i* cp = (const v4i*)(a->ws + WS_ROUTE + RT_CNT) + 2 * tid; const v4i c0 = cp[0], c1 = cp[1]; c[0] = c0.x; c[1] = c0.y; c[2] = c0.z; c[3] = c0.w; c[4] = c1.x; c[5] = c1.y; c[6] = c1.z; c[7] = c1.w; }
#pragma unroll
        for (int e = 0; e < 8; ++e) { __hip_atomic_fetch_add(&tab[e], c[e], __ATOMIC_RELAXED, __HIP_MEMORY_SCOPE_WORKGROUP); if (tid < wg) __hip_atomic_fetch_add(&tab[8 + e], c[e], __ATOMIC_RELAXED, __HIP_MEMORY_SCOPE_WORKGROUP); } }
    __syncthreads();
    if (tid == 0) { int pb = 0; for (int e = 0; e < 8; ++e) { tab[16 + e] = pb; pb += (tab[e] + 255) >> 8; } tab[24] = pb; }
    __syncthreads();
}


#ifndef STAG_TICKS
#define STAG_TICKS 400
#endif
#ifndef STAG_NCLS
#define STAG_NCLS 8
#endif
__device__ __forceinline__ void stagger_start(int vc) {
    const int cls = (vc >> 3) % STAG_NCLS;
    if (cls) { const unsigned long long t0 = __builtin_amdgcn_s_memrealtime(), w = (unsigned long long)cls * STAG_TICKS; while (__builtin_amdgcn_s_memrealtime() - t0 < w) __builtin_amdgcn_s_sleep(4); }
}
typedef short bf16x8 __attribute__((ext_vector_type(8)));
typedef float f32x16 __attribute__((ext_vector_type(16)));
#define MFMA32(a, b, c) __builtin_amdgcn_mfma_f32_32x32x16_bf16((a), (b), (c), 0, 0, 0)
#define SCHED_FENCE() __builtin_amdgcn_sched_barrier(0)
__device__ __forceinline__ int perm16(int c) { return (c & ~12) | ((c & 4) << 1) | ((c & 8) >> 1); }
template <int DK> __device__ __forceinline__ int rm_swz(int t) { return (DK == 128) ? (t & 15) : ((t >> 1) & 7); }
template <int DK> __device__ __forceinline__ int rm_addr(int t, int pos) { return t * (2 * DK) + ((((pos >> 3) ^ rm_swz<DK>(t))) << 4) + ((pos & 7) << 1); }
__device__ __forceinline__ int ti_addr(int row, int tok) { return row * 64 + ((((tok >> 3) ^ ((row >> 2) & 3))) << 4) + ((tok & 7) << 1); }
constexpr int SC_IMG = 25600, SC_QI = 0, SC_KDT = 8192, SC_VT = 16384, SC_DV = 24576;
constexpr int SC_QK = 3 * SC_IMG, SC_QKSET = 16384, SC_S = SC_QK + 2 * SC_QKSET;
static_assert(SC_S + 4096 <= RING_BYTES, "scan LDS map");
constexpr int NCHUNK = (CTXL + SEQ) / 32;
constexpr float LOG2E = 1.4426950408889634f;
__device__ __forceinline__ void chunk_rows(int grp, int b, int dir, int ch, int& rbase, int& rstep) {
    if (ch < CTXL / 32) { rbase = ML + b * CTXL + (dir ? CTXL - 1 - ch * 32 : ch * 32); rstep = dir ? -1 : 1; }
    else { const int cc = ch - CTXL / 32;
        if (grp) { rbase = b * SEQ + (dir ? 31 * 64 + 63 - cc : cc); rstep = dir ? -64 : 64; }
        else { rbase = b * SEQ + (dir ? SEQ - 1 - cc * 32 : cc * 32); rstep = dir ? -1 : 1; } }
}
template <int V> struct IC { static constexpr int value = V; };
template <int DK, int DIRT> __device__ __forceinline__ void scan_mfma(LAS unsigned char* lds, const bf16* P, const bf16* GR, const float* w2, const float* gb, bf16* OUT, int grp, int b, int hd, int tid) {
    constexpr int dir = DIRT;
    const int lane = tid & 63, wave = __builtin_amdgcn_readfirstlane(tid >> 6);
    constexpr int NCP = DK / 8, NTG = 64 / NCP, TPL = 32 / NTG, NT = DK / 32, NKS = DK / 16, RP = 2 * DK;
    constexpr int BLK = (DK == 64) ? PBLK_G : PBLK_H;
    const int qcol = (DK == 64) ? 0 : 384, kcol = (DK == 64) ? 64 : (dir ? 0 : 512), lcol = dir ? 128 : 640, vcol = (DK == 64) ? 128 : 256;
    const char* Pblk = (const char*)(P + ((DK == 64) ? 0 : PH_OFF) + (size_t)(b * 4 + hd) * NPOS * BLK);
    const int ocol = grp * 512 + hd * 128;
    if (wave < 4) {
        const int sw = wave;
        f32x16 ST[NT];
#pragma unroll
        for (int T = 0; T < NT; ++T)
#pragma unroll
            for (int r = 0; r < 16; ++r) ST[T][r] = 0.f;
        for (int it = -2; it < NCHUNK; ++it) {
            if (it >= 0) {
                int i31 = lane & 31, h = lane >> 5; asm volatile("" : "+v"(i31), "+v"(h));
                const LAS unsigned char* img = lds + (it % 3) * SC_IMG; const LAS unsigned char* simg = lds + SC_S + (it & 1) * 2048;
                const int aq0 = i31 * RP + ((h ^ rm_swz<DK>(i31)) << 4);
                const int x2 = (i31 >> 2) & 3, at0 = i31 * 64 + ((h ^ x2) << 4);
                const int vrow = 32 * sw * 64;
                bf16x8 bq[NKS], va[2], sb[2], kd[NT][2]; f32x4 d4[NT][4];
#pragma unroll
                for (int ks = 0; ks < NKS; ++ks) bq[ks] = *(const LAS bf16x8*)(img + SC_QI + (aq0 ^ (ks << 5)));
#pragma unroll
                for (int s = 0; s < 2; ++s) { va[s] = *(const LAS bf16x8*)(img + SC_VT + vrow + (at0 ^ (s << 5))); sb[s] = *(const LAS bf16x8*)(simg + (at0 ^ (s << 5))); }
#pragma unroll
                for (int T = 0; T < 2; ++T) {
#pragma unroll
                    for (int g = 0; g < 4; ++g) d4[T][g] = *(const LAS f32x4*)(img + SC_DV + 16 * h + 128 * T + 32 * g);
#pragma unroll
                    for (int s = 0; s < 2; ++s) kd[T][s] = *(const LAS bf16x8*)(img + SC_KDT + 2048 * T + (at0 ^ (s << 5))); }
                SCHED_FENCE();
                f32x16 oacc;
#pragma unroll
                for (int r = 0; r < 16; ++r) oacc[r] = 0.f;
#pragma unroll
                for (int T = 0; T < NT; ++T)
#pragma unroll
                    for (int s = 0; s < 2; ++s) {
                        v4u p; p.x = cvtpk(ST[T][8 * s], ST[T][8 * s + 1]); p.y = cvtpk(ST[T][8 * s + 2], ST[T][8 * s + 3]); p.z = cvtpk(ST[T][8 * s + 4], ST[T][8 * s + 5]); p.w = cvtpk(ST[T][8 * s + 6], ST[T][8 * s + 7]);
                        oacc = MFMA32(__builtin_bit_cast(bf16x8, p), bq[2 * T + s], oacc); }
#pragma unroll
                for (int s = 0; s < 2; ++s) oacc = MFMA32(va[s], sb[s], oacc);
                SCHED_FENCE();
                if constexpr (NT == 4) {
#pragma unroll
                    for (int T = 2; T < 4; ++T) {
#pragma unroll
                        for (int g = 0; g < 4; ++g) d4[T][g] = *(const LAS f32x4*)(img + SC_DV + 16 * h + 128 * T + 32 * g);
#pragma unroll
                        for (int s = 0; s < 2; ++s) kd[T][s] = *(const LAS bf16x8*)(img + SC_KDT + 2048 * T + (at0 ^ (s << 5))); }
                }
#pragma unroll
                for (int T = 0; T < 2; ++T) {
#pragma unroll
                    for (int g = 0; g < 4; ++g) { ST[T][4 * g] *= d4[T][g].x; ST[T][4 * g + 1] *= d4[T][g].y; ST[T][4 * g + 2] *= d4[T][g].z; ST[T][4 * g + 3] *= d4[T][g].w; }
#pragma unroll
                    for (int s = 0; s < 2; ++s) ST[T] = MFMA32(kd[T][s], va[s], ST[T]); }
                SCHED_FENCE();
                { int rbase, rstep; chunk_rows(grp, b, dir, it, rbase, rstep); const int row = rbase + i31 * rstep; bf16* op = OUT + (size_t)row * D + ocol + 32 * sw + 4 * h;
#pragma unroll
                  for (int g = 0; g < 4; ++g) { v2u w; w.x = cvtpk(oacc[4 * g], oacc[4 * g + 1]); w.y = cvtpk(oacc[4 * g + 2], oacc[4 * g + 3]); *(v2u*)(op + 8 * g) = w; } }
                if constexpr (NT == 4) {
#pragma unroll
                    for (int T = 2; T < 4; ++T) {
#pragma unroll
                        for (int g = 0; g < 4; ++g) { ST[T][4 * g] *= d4[T][g].x; ST[T][4 * g + 1] *= d4[T][g].y; ST[T][4 * g + 2] *= d4[T][g].z; ST[T][4 * g + 3] *= d4[T][g].w; }
#pragma unroll
                        for (int s = 0; s < 2; ++s) ST[T] = MFMA32(kd[T][s], va[s], ST[T]); }
                }
            }
            asm volatile("s_waitcnt lgkmcnt(0)" ::: "memory"); __builtin_amdgcn_s_barrier(); asm volatile("" ::: "memory");
        }
    } else {
        const int pw = wave - 4;
        const int tg = lane / NCP, cp = lane % NCP, c0 = (DK / 4) * pw + 2 * cp, t0 = tg * TPL;
        const int pos0 = (c0 & ~15) | perm16(c0 & 15);
        const int tgv = lane >> 4, cpv = lane & 15, d0 = 32 * pw + 2 * cpv, tv0 = 8 * tgv;
        float w2r[2][16]; float gb0 = 0.f, gb1 = 0.f;
        if (DK == 64) {
#pragma unroll
            for (int r = 0; r < 16; ++r) { w2r[0][r] = w2[r * 256 + hd * 64 + c0]; w2r[1][r] = w2[r * 256 + hd * 64 + c0 + 1]; }
            gb0 = gb[hd * 64 + c0]; gb1 = gb[hd * 64 + c0 + 1];
        }
        constexpr int AHEAD = (DK == 128) ? 2 : 1;
        unsigned rq[AHEAD][TPL], rk[AHEAD][TPL], rl[AHEAD][TPL], rv[AHEAD][8]; v4u rg[AHEAD][TPL][2];
        auto load_chunk = [&](auto setc, int ch) { constexpr int SI = decltype(setc)::value;
            const int pb = dir ? ((ch < CTXL / 32) ? CTXL - 1 - 32 * ch : CTXL + SEQ - 1 - 32 * (ch - CTXL / 32)) : 32 * ch, ps = dir ? -1 : 1;
            const int stp = ps * BLK * 2;
            int o1 = ((pb + t0 * ps) * BLK + c0) * 2, o2 = ((pb + tv0 * ps) * BLK + vcol + d0) * 2;
            if constexpr (DK == 128) {
                const int oq = o1 + 2 * qcol, ok = o1 + 2 * kcol;
                static_assert(BLK * 2 * 2 <= 4095, "immediate offsets");
#define SC_LD(dst, off, IMM) asm volatile("global_load_dword %0, %1, %2 offset:" #IMM : "=v"(dst) : "v"(off), "s"(Pblk) : "memory")
#define SC_LD3(arr, base, j) do { if constexpr (DIRT != 0) { const int b_ = (base) + (7 - 3 * (j)) * stp; SC_LD(arr[SI][7 - 3 * (j)], b_, 0); SC_LD(arr[SI][6 - 3 * (j)], b_, 1536); if (5 - 3 * (j) >= 0) SC_LD(arr[SI][(5 - 3 * (j)) & 7], b_, 3072); } \
        else { const int b_ = (base) + (3 * (j)) * stp; SC_LD(arr[SI][3 * (j)], b_, 0); SC_LD(arr[SI][3 * (j) + 1], b_, 1536); if (3 * (j) + 2 < 8) SC_LD(arr[SI][(3 * (j) + 2) & 7], b_, 3072); } } while (0)
#pragma unroll
                for (int j = 0; j < 3; ++j) { SC_LD3(rq, oq, j); SC_LD3(rk, ok, j); SC_LD3(rv, o2, j); }
#undef SC_LD3
#undef SC_LD
                return;
            }
#pragma unroll
            for (int t = 0; t < TPL; ++t) {
                rq[SI][t] = *(const unsigned*)(Pblk + o1 + 2 * qcol); rk[SI][t] = *(const unsigned*)(Pblk + o1 + 2 * kcol);
                o1 += stp; }
            if (DK == 64) { int rbase, rstep; chunk_rows(grp, b, dir, ch, rbase, rstep); int o3 = ((rbase + t0 * rstep) * 32 + dir * 16) * 2; const int st3 = rstep * 64;
#pragma unroll
                for (int t = 0; t < TPL; ++t) { const v4u* gp = (const v4u*)((const char*)GR + o3); rg[SI][t][0] = gp[0]; rg[SI][t][1] = gp[1]; o3 += st3; } }
#pragma unroll
            for (int t = 0; t < 8; ++t) { rv[SI][t] = *(const unsigned*)(Pblk + o2); o2 += stp; }
        };
        load_chunk(IC<0>{}, 0); if constexpr (AHEAD == 2) load_chunk(IC<1>{}, 1);
        auto prep_step = [&](auto setc, int it) { constexpr int SI = decltype(setc)::value;
            const int cw = it + 2;
            int rm0 = t0 * RP + ((((pos0 >> 3) ^ rm_swz<DK>(t0))) << 4) + ((pos0 & 7) << 1), ti0 = ti_addr(c0, t0), ti1 = ti_addr(c0 + 1, t0), tv_0 = ti_addr(d0, tv0), tv_1 = ti_addr(d0 + 1, tv0), dvo = c0 * 4;
            if (cw < NCHUNK) {
                if constexpr (DK == 128) {
#define SC_W16(arr) "+v"(arr[SI][0]), "+v"(arr[SI][1]), "+v"(arr[SI][2]), "+v"(arr[SI][3]), "+v"(arr[SI][4]), "+v"(arr[SI][5]), "+v"(arr[SI][6]), "+v"(arr[SI][7])
                    if (cw + 1 < NCHUNK) asm volatile("s_waitcnt vmcnt(24)" ::: "memory"); else asm volatile("s_waitcnt vmcnt(0)" ::: "memory");
                    SCHED_FENCE();
                    asm volatile("" : SC_W16(rq), SC_W16(rk));
                    asm volatile("" : SC_W16(rv));
#undef SC_W16
                    SCHED_FENCE();
                }
                LAS unsigned char* img = lds + (cw % 3) * SC_IMG;
                static_assert(SC_IMG % 256 == 0 && SC_QI % 256 == 0 && SC_QK % 256 == 0 && SC_QKSET % 256 == 0, "image bases");
                const int R0q = rm0 + (cw % 3) * SC_IMG + SC_QI, R0k = rm0 + SC_QK + (cw & 1) * SC_QKSET;
                float c0v[TPL], c1v[TPL], off0, off1, cL0, cL1;
                if constexpr (DK == 64) {
                    float a0 = 0.f, a1 = 0.f;
#pragma unroll
                    for (int t = 0; t < TPL; ++t) { float g0 = gb0, g1 = gb1; const unsigned gw[8] = {rg[SI][t][0].x, rg[SI][t][0].y, rg[SI][t][0].z, rg[SI][t][0].w, rg[SI][t][1].x, rg[SI][t][1].y, rg[SI][t][1].z, rg[SI][t][1].w};
#pragma unroll
                        for (int r = 0; r < 8; ++r) { const float e0 = bflo(gw[r]), e1 = bfhi(gw[r]); g0 += e0 * w2r[0][2 * r] + e1 * w2r[0][2 * r + 1]; g1 += e0 * w2r[1][2 * r] + e1 * w2r[1][2 * r + 1]; }
                        const float l0 = (fminf(g0, 0.f) * LOG2E - __builtin_amdgcn_logf(1.f + __builtin_amdgcn_exp2f(-fabsf(g0) * LOG2E))) * (1.f / 16.f);
                        const float l1 = (fminf(g1, 0.f) * LOG2E - __builtin_amdgcn_logf(1.f + __builtin_amdgcn_exp2f(-fabsf(g1) * LOG2E))) * (1.f / 16.f);
                        a0 += l0; a1 += l1; c0v[t] = a0; c1v[t] = a1; }
                    float s0 = c0v[TPL - 1], s1 = c1v[TPL - 1];
#pragma unroll
                    for (int d = NCP; d < 64; d <<= 1) { const float u0 = __shfl_up(s0, d), u1 = __shfl_up(s1, d); if (lane >= d) { s0 += u0; s1 += u1; } }
                    const float bl0 = __shfl(s0, (NTG - 1) * NCP + cp), bl1 = __shfl(s1, (NTG - 1) * NCP + cp);
                    off0 = s0 - c0v[TPL - 1]; off1 = s1 - c1v[TPL - 1];
                    cL0 = __builtin_amdgcn_exp2f(bl0); cL1 = __builtin_amdgcn_exp2f(bl1);
                } else {
                    float a0 = 1.f, a1 = 1.f;
#pragma unroll
                    for (int t = 0; t < TPL; ++t) { a0 *= 1.f - bflo(rk[SI][t]); a1 *= 1.f - bfhi(rk[SI][t]); c0v[t] = a0; c1v[t] = a1; }
                    float s0 = a0, s1 = a1;
#pragma unroll
                    for (int d = NCP; d < 64; d <<= 1) { const float u0 = __shfl_up(s0, d), u1 = __shfl_up(s1, d); if (lane >= d) { s0 *= u0; s1 *= u1; } }
                    cL0 = __shfl(s0, (NTG - 1) * NCP + cp); cL1 = __shfl(s1, (NTG - 1) * NCP + cp);
                    const float p0 = __shfl_up(s0, NCP), p1 = __shfl_up(s1, NCP);
                    off0 = lane >= NCP ? p0 : 1.f; off1 = lane >= NCP ? p1 : 1.f;
                }
                unsigned kdp0[TPL / 2], kdp1[TPL / 2]; float kdprev0 = 0.f, kdprev1 = 0.f;
#pragma unroll
                for (int t = 0; t < TPL; ++t) {
                    float E0, E1, Rc0, Rc1;
                    if constexpr (DK == 64) { const float e0 = fmaxf(off0 + c0v[t], -100.f), e1 = fmaxf(off1 + c1v[t], -100.f);
                        E0 = __builtin_amdgcn_exp2f(e0); E1 = __builtin_amdgcn_exp2f(e1); Rc0 = __builtin_amdgcn_exp2f(-e0); Rc1 = __builtin_amdgcn_exp2f(-e1); }
                    else { E0 = fmaxf(off0 * c0v[t], 0x1p-100f); E1 = fmaxf(off1 * c1v[t], 0x1p-100f); Rc0 = __builtin_amdgcn_rcpf(E0); Rc1 = __builtin_amdgcn_rcpf(E1); }
                    const float ks0 = bflo(rk[SI][t]) * Rc0, ks1 = bfhi(rk[SI][t]) * Rc1;
                    const int xr = ((DK == 128) ? t : (t >> 1)) << 4;
                    *(LAS unsigned*)(lds + (R0q ^ xr) + t * RP) = cvtpk(bflo(rq[SI][t]) * E0, bfhi(rq[SI][t]) * E1);
                    *(LAS unsigned*)(lds + (R0k ^ xr) + t * RP) = cvtpk(ks0, ks1);
                    const float kd0 = ks0 * cL0, kd1 = ks1 * cL1;
                    if (t & 1) { kdp0[t >> 1] = cvtpk(kdprev0, kd0); kdp1[t >> 1] = cvtpk(kdprev1, kd1); } else { kdprev0 = kd0; kdprev1 = kd1; }
                }
                if constexpr (TPL == 8) { *(LAS v4u*)(img + SC_KDT + ti0) = (v4u){kdp0[0], kdp0[1], kdp0[TPL / 2 - 2], kdp0[TPL / 2 - 1]}; *(LAS v4u*)(img + SC_KDT + ti1) = (v4u){kdp1[0], kdp1[1], kdp1[TPL / 2 - 2], kdp1[TPL / 2 - 1]}; }
                else { *(LAS v2u*)(img + SC_KDT + ti0) = (v2u){kdp0[0], kdp0[1]}; *(LAS v2u*)(img + SC_KDT + ti1) = (v2u){kdp1[0], kdp1[1]}; }
                if (tg == 0) *(LAS f32x2v*)(img + SC_DV + dvo) = (f32x2v){cL0, cL1};
                { v4u lo, hi;
                  lo.x = __builtin_amdgcn_perm(rv[SI][1], rv[SI][0], 0x05040100u); lo.y = __builtin_amdgcn_perm(rv[SI][3], rv[SI][2], 0x05040100u); lo.z = __builtin_amdgcn_perm(rv[SI][5], rv[SI][4], 0x05040100u); lo.w = __builtin_amdgcn_perm(rv[SI][7], rv[SI][6], 0x05040100u);
                  hi.x = __builtin_amdgcn_perm(rv[SI][1], rv[SI][0], 0x07060302u); hi.y = __builtin_amdgcn_perm(rv[SI][3], rv[SI][2], 0x07060302u); hi.z = __builtin_amdgcn_perm(rv[SI][5], rv[SI][4], 0x07060302u); hi.w = __builtin_amdgcn_perm(rv[SI][7], rv[SI][6], 0x07060302u);
                  *(LAS v4u*)(img + SC_VT + tv_0) = lo; *(LAS v4u*)(img + SC_VT + tv_1) = hi; }
                if (cw + AHEAD < NCHUNK) load_chunk(setc, cw + AHEAD);
            }
            const int cs = it + 1;
            if (cs >= 0 && cs < NCHUNK && pw == (cs & 3)) {
                const LAS unsigned char* qk = lds + SC_QK + (cs & 1) * SC_QKSET; const LAS unsigned char* qim = lds + (cs % 3) * SC_IMG + SC_QI; LAS unsigned char* simg = lds + SC_S + (cs & 1) * 2048;
                int i31 = lane & 31, h = lane >> 5; asm volatile("" : "+v"(i31), "+v"(h));
                const int aq0 = i31 * RP + ((h ^ rm_swz<DK>(i31)) << 4);
                bf16x8 ka[NKS], qb[NKS];
#pragma unroll
                for (int ks = 0; ks < NKS; ++ks) { ka[ks] = *(const LAS bf16x8*)(qk + (aq0 ^ (ks << 5))); qb[ks] = *(const LAS bf16x8*)(qim + (aq0 ^ (ks << 5))); }
                SCHED_FENCE();
                f32x16 sacc;
#pragma unroll
                for (int r = 0; r < 16; ++r) sacc[r] = 0.f;
#pragma unroll
                for (int ks = 0; ks < NKS; ++ks) sacc = MFMA32(ka[ks], qb[ks], sacc);
                const int sa0 = i31 * 64 + 8 * h, x2 = (i31 >> 2) & 3;
#pragma unroll
                for (int g = 0; g < 4; ++g) { float m[4];
#pragma unroll
                    for (int e = 0; e < 4; ++e) { const int j = 8 * g + 4 * h + e; m[e] = (i31 >= j) ? sacc[4 * g + e] : 0.f; }
                    *(LAS v2u*)(simg + sa0 + ((g ^ x2) << 4)) = (v2u){cvtpk(m[0], m[1]), cvtpk(m[2], m[3])}; }
            }
            asm volatile("s_waitcnt lgkmcnt(0)" ::: "memory"); __builtin_amdgcn_s_barrier(); asm volatile("" ::: "memory");
        };
        static_assert((NCHUNK & 1) == 0, "interval loop is unrolled by two");
        for (int it = -2; it < NCHUNK; it += 2) { prep_step(IC<0>{}, it); if constexpr (AHEAD == 2) prep_step(IC<1>{}, it + 1); else prep_step(IC<0>{}, it + 1); }
    }
}

__global__ void __launch_bounds__(NTHR, 2) fwd_kernel(Args args) {
    extern __shared__ __attribute__((aligned(16))) unsigned char lds_raw[];
    LAS unsigned char* lds = (LAS unsigned char*)lds_raw;
    {   const int t0 = threadIdx.x;
        for (int u = t0; u < (LDS_BYTES - LDSCTL_OFF) / 4; u += NTHR) ((LAS unsigned*)(lds + LDSCTL_OFF))[u] = 0u;
        __syncthreads();
        if (t0 == 0) { volatile LAS unsigned* M = (volatile LAS unsigned*)(lds + MISC_OFF); unsigned* barw = (unsigned*)(kargs()->ws + WS_CTL) + CW_BAR; const unsigned x = xb_xcc_id();
            const unsigned rk = xb_add(&barw[XB_XCNT(x)], 1u); M[12] = x; M[13] = rk; M[14] = blockIdx.x; }
        __syncthreads(); }
#define IN(k) (kargs()->ph_lo <= (k) && (k) < kargs()->ph_hi)
#define BARL() do { XcdBarrier bar_; bar_.bar = (unsigned*)(kargs()->ws + WS_CTL) + CW_BAR; bar_.x = xb_xcc_id(); bar_.st = (volatile LAS unsigned*)(lds + MISC_OFF) + 8; xcd_barrier<true>(bar_); } while (0)
#define BAR(k) do { if (IN(k) && IN((k) + 1)) { XcdBarrier bar_; bar_.bar = (unsigned*)(kargs()->ws + WS_CTL) + CW_BAR; bar_.x = xb_xcc_id(); bar_.st = (volatile LAS unsigned*)(lds + MISC_OFF) + 8; xcd_barrier(bar_); } } while (0)
#define PH_VIEW() KA A = kargs(); unsigned char* ws = A->ws; float* mods = (float*)(ws + WS_MODS); bf16* Hb = (bf16*)(ws + WS_H); bf16* OBb = (bf16*)(ws + WS_OB); bf16* Gb = (bf16*)(ws + WS_G); bf16* Pb = (bf16*)(ws + WS_P); \
    bf16* GRb = (bf16*)(ws + WS_GR); bf16* MIXb = (bf16*)(ws + WS_MIX); bf16* XBC = (bf16*)(ws + WS_XC); bf16* XBL = (bf16*)A->out; (void)mods; (void)Hb; (void)OBb; (void)Gb; (void)Pb; (void)GRb; (void)MIXb; (void)XBC; (void)XBL; \
    int tid = threadIdx.x; asm volatile("" : "+v"(tid)); const int lane = tid & 63, wave = __builtin_amdgcn_readfirstlane(tid >> 6), wg = blockIdx.x, G = gridDim.x, gw = wg * NWAVES + wave, NGW = G * NWAVES; \
    (void)lane; (void)wave; (void)wg; (void)G; (void)gw; (void)NGW
#define LAYER_VIEW() const float* xlat = A->in[I_X]; const float* xctx = A->in[I_CTX]; \
    const float* mlat = mods + MO_LAT + l * 16 * 6144; const float* mctx = mods + MO_CTX + l * 6144; (void)xlat; (void)xctx; (void)mlat; (void)mctx
    LAS int* tab = (LAS int*)(lds + TAB_OFF);
#define VCU() ((int)__builtin_amdgcn_readfirstlane(((volatile LAS unsigned*)(lds + MISC_OFF))[14]))

    if (IN(0)) { PH_VIEW();
        LAS float* scr = (LAS float*)(lds + wave * 16384);
        for (int it = gw; it < NI_MAIN; it += NGW) conv_item_main(A, it, scr, lane);
        __syncthreads();
        for (int it = wg; it < 192; it += G) mod_item(A, it, lds, tid, lane, wave);
        for (int it = wg; it < 256; it += G) colmax_rows_item(A, it, tid);
        for (int it = wg; it < NS_MAIN; it += G) colscale_item_main(A, it, lds, tid, lane, wave);
        if (wg == G - 1) for (int i = tid; i < 1024; i += NTHR) { const int d = i >> 9, ch = i & 511; const float a0 = A->in[I_HLB][d * 512 + ch], a1 = A->in[I_HLB][(2 + d) * 512 + ch];
            mods[MO_LB + d * 512 + ch] = 0.f; mods[MO_LB + 1024 + d * 512 + ch] = 1.f / (1.f + __expf(a0 - a1)); }
    }
    BAR(0);
#if !MK_MULTI
    if (threadIdx.x == 0 && IN(0) && IN(1)) { volatile LAS unsigned* M = (volatile LAS unsigned*)(lds + MISC_OFF); unsigned* barw = (unsigned*)(kargs()->ws + WS_CTL) + CW_BAR; const unsigned per = gridDim.x / 8; bool ok = (gridDim.x % 8) == 0;
        for (unsigned j = 0; j < 16; ++j) { const unsigned cnt = xb_ld(&barw[XB_XCNT(j)]); ok = ok && (j < 8 ? cnt == per : cnt == 0u); }
        if (ok) M[14] = M[13] * 8u + M[12]; }
    __syncthreads();
#endif
#pragma nounroll
    for (int l = 0; l < 2; ++l) {
        const int pb = l ? 10 : 1;
        if (IN(pb)) { PH_VIEW(); LAYER_VIEW();
            typedef float f32x4m __attribute__((ext_vector_type(4)));
            const bf16* W32 = (const bf16*)(ws + WS_WIN) + (size_t)l * 32 * 1024;
            const int fm = lane & 15, kq = lane >> 4;
            bf16x8 wb[2][4];
#pragma unroll
            for (int nt = 0; nt < 2; ++nt)
#pragma unroll
                for (int s = 0; s < 4; ++s) wb[nt][s] = *(const bf16x8*)(W32 + (size_t)(nt * 16 + fm) * 1024 + 128 * wave + 32 * s + 8 * kq);
            LAS unsigned char* tile = lds; LAS float* red = (LAS float*)(lds + 32768);
            v4u yb[2][4];
#define N1LOAD(rr_, m_) do { const int mm_ = (m_); if (l) { const v2u* xr_ = (const v2u*)(mm_ < ML ? XBL + (size_t)mm_ * D : XBC + (size_t)(mm_ - ML) * D) + lane; \
        _Pragma("unroll") for (int j = 0; j < 4; ++j) { const v2u w_ = xr_[64 * j]; yb[rr_][j] = (v4u){w_.x, w_.y, 0u, 0u}; } } \
    else { const float* xr_ = mm_ < ML ? xlat + (size_t)mm_ * D : xctx + (size_t)(mm_ - ML) * D; _Pragma("unroll") for (int j = 0; j < 4; ++j) yb[rr_][j] = ((const v4u*)xr_)[lane + 64 * j]; } } while (0)
#pragma unroll
            for (int rr = 0; rr < 2; ++rr) N1LOAD(rr, wg * 144 + 2 * wave + rr);
            for (int blk = 0; blk < 9; ++blk) {
                const int r0 = wg * 144 + blk * 16;
#pragma unroll
                for (int rr = 0; rr < 2; ++rr) { const int lr = 2 * wave + rr, m = r0 + lr; const bool lat = m < ML; const float* md = lat ? mlat + (m >> 11) * 6144 : mctx;
                    f32x4 y[4]; float ss = 0.f;
#pragma unroll
                    for (int j = 0; j < 4; ++j) { const v4u w_ = yb[rr][j]; if (l) y[j] = (f32x4){bflo(w_.x), bfhi(w_.x), bflo(w_.y), bfhi(w_.y)}; else y[j] = __builtin_bit_cast(f32x4, w_);
                        ss += (y[j].x * y[j].x + y[j].y * y[j].y) + (y[j].z * y[j].z + y[j].w * y[j].w); }
                    if (blk + 1 < 9) N1LOAD(rr, m + 16);
                    const float rstd = rsqrtf(wave_sum(ss) * (1.f / D) + EPS);
                    const float* g1 = A->in[I_N1G] + l * D;
#pragma unroll
                    for (int j = 0; j < 4; ++j) { const f32x4 gv = ((const f32x4*)g1)[lane + 64 * j], sh = ((const f32x4*)md)[lane + 64 * j], sc = ((const f32x4*)(md + 1024))[lane + 64 * j];
                        y[j] = y[j] * rstd * gv * (sc + 1.f) + sh; const v2u w = (v2u){pk2(y[j].x, y[j].y), pk2(y[j].z, y[j].w)};
                        const int ch = (lane + 64 * j) >> 1; *(LAS v2u*)(tile + lr * 2048 + ((ch ^ lr) << 4) + (lane & 1) * 8) = w; }
                    quant_row(y, (unsigned*)(ws + WS_HQ) + (size_t)m * 256, (float*)(ws + WS_SAR) + m, lane); }
                __syncthreads();
                f32x4m c0 = {0.f, 0.f, 0.f, 0.f}, c1 = {0.f, 0.f, 0.f, 0.f};
#pragma unroll
                for (int s = 0; s < 4; ++s) { const bf16x8 af = *(const LAS bf16x8*)(tile + fm * 2048 + (((16 * wave + 4 * s + kq) ^ fm) << 4));
                    c0 = __builtin_amdgcn_mfma_f32_16x16x32_bf16(af, wb[0][s], c0, 0, 0, 0); c1 = __builtin_amdgcn_mfma_f32_16x16x32_bf16(af, wb[1][s], c1, 0, 0, 0); }
#pragma unroll
                for (int e = 0; e < 4; ++e) { red[(wave * 16 + 4 * kq + e) * 32 + fm] = c0[e]; red[(wave * 16 + 4 * kq + e) * 32 + 16 + fm] = c1[e]; }
                __syncthreads();
                { float s = 0.f;
#pragma unroll
                  for (int w = 0; w < 8; ++w) s += red[w * 512 + tid];
                  GRb[(size_t)(r0 + (tid >> 5)) * 32 + (tid & 31)] = (bf16)f2bf(s); }
            }
#undef N1LOAD
            if (l == 0) { __syncthreads(); LAS float* scr = (LAS float*)(lds + wave * 16384); for (int it = gw; it < NQ_MAIN; it += NGW) conv_item_q(A, it, scr, lane);
                for (int idx = wg * NTHR + tid; idx < 8 * 7168; idx += G * NTHR) { const int e = idx / 7168, row = idx % 7168, which = (row >> 7) & 1, col = 128 * (row >> 8) + (row & 127);
                    ((float*)(ws + WS_SB13))[idx] = fmaxf(__builtin_bit_cast(float, ((const unsigned*)(ws + WS_CTL))[CW_CM + (e * 2 + which) * DEXP + col]), 1e-30f) * (1.f / 127.f); } }
        }
        BAR(pb);
        if (IN(pb + 1)) { PH_VIEW(); LAYER_VIEW();
            pg8::Gemm g{(const bf16*)(ws + WS_HQ), (const bf16*)(ws + WS_WINQ + (size_t)l * 4096 * 1024), MT, PW, D / 2}; pg8::StaticOrder S; S.init(MT, PW, G, VCU());
            EpiInProjT<true> E{Pb, Gb, GRb, mods + MO_LB + l * 1024, (const float*)(ws + WS_SAR), (const float*)(ws + WS_SBIN) + l * 4096};
            pg8::gemm_phase<EpiInProjT<true>, pg8::StaticOrder, true, true>(lds, g, S, E);
        }
        BAR(pb + 1);
        if (IN(pb + 2)) { PH_VIEW(); LAYER_VIEW();
            for (int s = wg; s < 256; s += G) { const int grp = s >> 7, r = s & 127, b = r >> 3, hd = (r >> 1) & 3, dir = r & 1;
                bf16* OUT = dir ? OBb : Hb;
                const float* w2 = A->in[I_GW2] + (size_t)(l * 2 + dir) * 16 * 256; const float* gb = A->in[I_GB] + (l * 2 + dir) * 256;
                if (grp == 0) { if (dir) scan_mfma<64, 1>(lds, Pb, GRb, w2, gb, OUT, grp, b, hd, tid); else scan_mfma<64, 0>(lds, Pb, GRb, w2, gb, OUT, grp, b, hd, tid); }
                else { if (dir) scan_mfma<128, 1>(lds, Pb, GRb, w2, gb, OUT, grp, b, hd, tid); else scan_mfma<128, 0>(lds, Pb, GRb, w2, gb, OUT, grp, b, hd, tid); } }
        }
        BAR(pb + 2);
        if (IN(pb + 3)) { PH_VIEW(); LAYER_VIEW();
            const int nrow = l ? ML : MT;
            for (int m = gw; m < nrow; m += 2 * NGW) { const int m2 = m + NGW; MixIn ra, rb;
                mix_load(Hb + (size_t)m * D, OBb + (size_t)m * D, Gb + (size_t)m * D, lane, ra);
                { const int mc = m2 < nrow ? m2 : m; mix_load(Hb + (size_t)mc * D, OBb + (size_t)mc * D, Gb + (size_t)mc * D, lane, rb); }
                mix_finish_bf(ra, A->in[I_GLAG] + l * 128, A->in[I_HGG] + l * 128, MIXb + (size_t)m * D, lane);
                if (m2 < nrow) mix_finish_bf(rb, A->in[I_GLAG] + l * 128, A->in[I_HGG] + l * 128, MIXb + (size_t)m2 * D, lane); }
            if (l == 1) { LAS float* scr = (LAS float*)(lds + wave * 16384); for (int it = gw; it < NI_M13; it += NGW) conv_item_moe(A, it, scr, lane); }
        }
        BAR(pb + 3);
        if (IN(pb + 4)) { PH_VIEW(); LAYER_VIEW();
            const int Mw = l ? ML : MT;
            pg8::Gemm g{MIXb, (const bf16*)(ws + WS_WOUT) + (size_t)l * 1024 * 1024, Mw, D, D}; pg8::StaticOrder S; S.init(Mw, D, G, VCU());
            if (l == 0) { EpiResidB<true> E{xlat, xctx, XBL, XBC, mlat + 2048, mctx + 2048}; pg8::gemm_phase<EpiResidB<true>, pg8::StaticOrder, true, true>(lds, g, S, E); }
            else { EpiResidB<false> E{XBL, XBC, (bf16*)(ws + WS_X3), XBC, mlat + 2048, mctx + 2048}; pg8::gemm_phase<EpiResidB<false>, pg8::StaticOrder, true, true>(lds, g, S, E); }
        }
        BAR(pb + 4);
        if (l == 0) {
            if (IN(6)) { PH_VIEW(); LAYER_VIEW();
                for (int m = gw; m < MT; m += 2 * NGW) { const int m2 = m + NGW; f32x4 ya[4], yb[4]; v2u ra[4], rb[4];
                    xloadb(m < ML ? XBL + (size_t)m * D : XBC + (size_t)(m - ML) * D, lane, ra);
                    { const int mc = m2 < MT ? m2 : m; xloadb(mc < ML ? XBL + (size_t)mc * D : XBC + (size_t)(mc - ML) * D, lane, rb); }
                    xcvt(ra, ya); xcvt(rb, yb);
                    { const float* md = m < ML ? mlat + (m >> 11) * 6144 : mctx; norm_finish_q((unsigned*)(ws + WS_HQ) + (size_t)m * 256, (float*)(ws + WS_SAR) + m, A->in[I_N2G], md + 3072, md + 4096, lane, ya); }
                    if (m2 < MT) { const float* md = m2 < ML ? mlat + (m2 >> 11) * 6144 : mctx; norm_finish_q((unsigned*)(ws + WS_HQ) + (size_t)m2 * 256, (float*)(ws + WS_SAR) + m2, A->in[I_N2G], md + 3072, md + 4096, lane, yb); } }
            }
            BAR(6);
            if (IN(7)) { PH_VIEW(); LAYER_VIEW();
                pg8::Gemm g{(const bf16*)(ws + WS_HQ), (const bf16*)(ws + WS_F13), MT, 2 * DFF, D / 2}; MoeOrder S; S.init(MC / 256, 22, G, VCU(), ML / 256, 0);
#pragma unroll
                for (int e = 0; e < 8; ++e) S.pb[e] = 1 << 30;
                EpiSwiGLUQ E{(bf16*)(ws + WS_ACT0), DFF, 22, 0, (const float*)(ws + WS_SAR), (const float*)(ws + WS_SBF)};
                pg8::gemm_phase<EpiSwiGLUQ, MoeOrder, true, true>(lds, g, S, E);
            }
            BAR(7);
            if (IN(8)) { PH_VIEW(); LAYER_VIEW();
                { pg8::Gemm g{(const bf16*)(ws + WS_ACT0), (const bf16*)(ws + WS_F2), MT, D, DFF}; MoeOrder S; S.init(MC / 256, 4, G, VCU(), ML / 256, 0);
#pragma unroll
                  for (int e = 0; e < 8; ++e) S.pb[e] = 1 << 30;
                  EpiResidB<false> E{XBL, XBC, XBL, XBC, mlat + 5120, mctx + 5120};
                  pg8::gemm_phase<EpiResidB<false>, MoeOrder, true, true>(lds, g, S, E); }
                { pg8::Gemm g{(const bf16*)(ws + WS_HQ), (const bf16*)(ws + WS_F13), MT, 2 * DFF, D / 2}; MoeOrder S; S.init(ML / 256, 22, G, VCU(), 0, 0); S.nb = (MC / 256) * 4; S.keep = 7;
#pragma unroll
                  for (int e = 0; e < 8; ++e) S.pb[e] = 1 << 30;
                  EpiSwiGLUQ E{(bf16*)(ws + WS_ACT0), DFF, 22, 0, (const float*)(ws + WS_SAR), (const float*)(ws + WS_SBF)};
                  pg8::gemm_phase<EpiSwiGLUQ, MoeOrder, true, true>(lds, g, S, E); }
            }
            BAR(8);
            if (IN(9)) { PH_VIEW(); LAYER_VIEW();
                pg8::Gemm g{(const bf16*)(ws + WS_ACT0), (const bf16*)(ws + WS_F2), MT, D, DFF}; MoeOrder S; S.init(ML / 256, 4, G, VCU(), 0, 0);
#pragma unroll
                for (int e = 0; e < 8; ++e) S.pb[e] = 1 << 30;
                EpiResidB<false> E{XBL, XBC, XBL, XBC, mlat + 5120, mctx + 5120};
                pg8::gemm_phase<EpiResidB<false>, MoeOrder, true, true>(lds, g, S, E);
            }
            BAR(9);
        }
    }
    if (IN(15)) { PH_VIEW(); const float* mlat1 = mods + MO_LAT + 16 * 6144;
        LAS int* sE = (LAS int*)(lds + LDSCTL_OFF + 4096); LAS float* sW = (LAS float*)(lds + LDSCTL_OFF + 5120); LAS int* sL = (LAS int*)(lds + LDSCTL_OFF + 6144); LAS float* sS = (LAS float*)(lds + LDSCTL_OFF + 7168);
        f32x4 ga[4], sh4[4], rw[8][4];
        { const float* md0 = mlat1 + ((wg * 128) >> 11) * 6144;
#pragma unroll
          for (int j = 0; j < 4; ++j) { const f32x4 gv = ((const f32x4*)(A->in[I_N2G] + D))[lane + 64 * j], sc = ((const f32x4*)(md0 + 4096))[lane + 64 * j]; sh4[j] = ((const f32x4*)(md0 + 3072))[lane + 64 * j]; ga[j] = gv * (sc + 1.f);
              const f32x4* rp = (const f32x4*)(A->in[I_ROUTER] + (size_t)(4 * (lane + 64 * j)) * 8); f32x4 v[8];
#pragma unroll
              for (int q = 0; q < 8; ++q) v[q] = rp[q];
#pragma unroll
              for (int e = 0; e < 8; ++e) rw[e][j] = (f32x4){v[(e >> 2)][e & 3], v[2 + (e >> 2)][e & 3], v[4 + (e >> 2)][e & 3], v[6 + (e >> 2)][e & 3]}; } }
        const bf16* X3 = (const bf16*)(ws + WS_X3);
        f32x4 y[4]; v2u yr[4], yn[4]; xloadb(X3 + (size_t)(wg * 128 + wave * 16) * D, lane, yr);
        for (int rr = 0; rr < 16; ++rr) { const int tl = wave * 16 + rr, row = wg * 128 + tl;
            { const int rn = rr + 1 < 16 ? row + 1 : row; xloadb(X3 + (size_t)rn * D, lane, yn); }
            xcvt(yr, y);
            { float s = 0.f;
#pragma unroll
              for (int j = 0; j < 4; ++j) s += (y[j].x * y[j].x + y[j].y * y[j].y) + (y[j].z * y[j].z + y[j].w * y[j].w);
              const float rstd = rsqrtf(wave_sum(s) * (1.f / D) + EPS); float am = 0.f;
#pragma unroll
              for (int j = 0; j < 4; ++j) {
                  y[j] = y[j] * rstd * ga[j] + sh4[j]; am = fmaxf(fmaxf(am, fmaxf(fabsf(y[j].x), fabsf(y[j].y))), fmaxf(fabsf(y[j].z), fabsf(y[j].w))); }
#pragma unroll
              for (int o = 1; o < 64; o <<= 1) am = fmaxf(am, __shfl_xor(am, o));
              am = fmaxf(am, 1e-30f); const float inv = 127.f / am; LAS unsigned* hq = (LAS unsigned*)(lds + tl * 1024) + lane;
#pragma unroll
              for (int j = 0; j < 4; ++j) { const int q0 = (int)__builtin_rintf(y[j].x * inv), q1 = (int)__builtin_rintf(y[j].y * inv), q2 = (int)__builtin_rintf(y[j].z * inv), q3 = (int)__builtin_rintf(y[j].w * inv);
                  hq[64 * j] = (unsigned)(q0 & 255) | ((unsigned)(q1 & 255) << 8) | ((unsigned)(q2 & 255) << 16) | ((unsigned)(q3 & 255) << 24); }
              if (lane == 0) sS[tl] = am * (1.f / 127.f); }
            float lg[8];
            { float p[8];
#pragma unroll
              for (int e = 0; e < 8; ++e) { float a = 0.f;
#pragma unroll
                  for (int j = 0; j < 4; ++j) { const f32x4 r4 = rw[e][j]; a += (y[j].x * r4.x + y[j].y * r4.y) + (y[j].z * r4.z + y[j].w * r4.w); }
                  p[e] = a; }
              const bool h5 = (lane & 32) != 0, h4 = (lane & 16) != 0, h3 = (lane & 8) != 0; float p4[4], p2[2], p1;
#pragma unroll
              for (int i = 0; i < 4; ++i) { const float snd = h5 ? p[i] : p[i + 4], kp = h5 ? p[i + 4] : p[i]; p4[i] = kp + __shfl_xor(snd, 32); }
#pragma unroll
              for (int i = 0; i < 2; ++i) { const float snd = h4 ? p4[i] : p4[i + 2], kp = h4 ? p4[i + 2] : p4[i]; p2[i] = kp + __shfl_xor(snd, 16); }
              { const float snd = h3 ? p2[0] : p2[1], kp = h3 ? p2[1] : p2[0]; p1 = kp + __shfl_xor(snd, 8); }
              p1 += __shfl_xor(p1, 4); p1 += __shfl_xor(p1, 2); p1 += __shfl_xor(p1, 1);
#pragma unroll
              for (int e = 0; e < 8; ++e) lg[e] = __builtin_bit_cast(float, __builtin_amdgcn_readlane(__builtin_bit_cast(int, p1), e * 8)); }
            int i0 = 0; float v0 = lg[0];
#pragma unroll
            for (int e = 1; e < 8; ++e) if (lg[e] > v0) { v0 = lg[e]; i0 = e; }
            int i1 = -1; float v1 = -3.0e38f;
#pragma unroll
            for (int e = 0; e < 8; ++e) if (e != i0 && lg[e] > v1) { v1 = lg[e]; i1 = e; }
            const float w0 = 1.f / (1.f + __expf(v1 - v0));
            if (lane == 0) { sE[2 * tl] = i0; sE[2 * tl + 1] = i1; sW[2 * tl] = w0; sW[2 * tl + 1] = 1.f - w0; }
#pragma unroll
            for (int j = 0; j < 4; ++j) yr[j] = yn[j]; }
        __syncthreads();
        { int run = 0;
#pragma unroll
          for (int j = 0; j < 4; ++j) { const bool mt = sE[64 * j + lane] == wave; const unsigned long long mk = __ballot(mt);
              if (mt) sL[64 * j + lane] = run + __popcll(mk & ((1ull << lane) - 1ull)); run += __popcll(mk); }
          if (lane == 0) __hip_atomic_store((int*)(ws + WS_ROUTE + RT_CNT) + wg * 8 + wave, run, __ATOMIC_RELAXED, __HIP_MEMORY_SCOPE_AGENT); }
        BARL();
        moe_tab<true>(kargs(), lds, tid, wg);
        for (int t = wave; t < 128; t += NWAVES) { const int row = wg * 128 + t; const int e0 = sE[2 * t], e1 = sE[2 * t + 1];
            const int s0 = tab[16 + e0] * 256 + tab[8 + e0] + sL[2 * t], s1 = tab[16 + e1] * 256 + tab[8 + e1] + sL[2 * t + 1];
            const v4u a0 = *(const LAS v4u*)(lds + t * 1024 + lane * 16);
            ((v4u*)((signed char*)(ws + WS_HSQ) + (size_t)s0 * D))[lane] = a0; ((v4u*)((signed char*)(ws + WS_HSQ) + (size_t)s1 * D))[lane] = a0;
            if (lane == 0) { float* gwp = (float*)(ws + WS_ROUTE + RT_GW); gwp[s0] = sW[2 * t]; gwp[s1] = sW[2 * t + 1]; float* sap = (float*)(ws + WS_ROUTE + RT_SA); const float san = sS[t]; sap[s0] = san; sap[s1] = san;
                ((v4i*)(ws + WS_ROUTE + RT_SEL))[row] = (v4i){e0, e1, s0, s1}; } }
        __syncthreads();
        { LAS float* scr = (LAS float*)(lds + wave * 16384); for (int it = NI_M13 + gw; it < NI_MOE; it += NGW) conv_item_moe(A, it, scr, lane); }
    }
    BAR(15);
    if (kargs()->ph_lo >= PH_M0 && kargs()->ph_lo <= NPHASE - 1) moe_tab<false>(kargs(), lds, threadIdx.x, blockIdx.x);
    if (IN(PH_M0)) {
        { PH_VIEW(); pg8::Gemm g{(const bf16*)(ws + WS_HSQ), (const bf16*)((const unsigned char*)A->out + DO_M13Q), 0, 0, D / 2}; MoeOrder S; S.init(CHUNK_PAN, 28, G, VCU(), 0, 0);
#pragma unroll
          for (int e = 0; e < 8; ++e) S.pb[e] = __builtin_amdgcn_readfirstlane(tab[16 + e]);
          EpiSwiGLUQ E{(bf16*)(ws + WS_ACT), DEXP, 28, 0, (const float*)(ws + WS_ROUTE + RT_SA), (const float*)(ws + WS_SB13)};
          pg8::gemm_phase<EpiSwiGLUQ, MoeOrder, true, true>(lds, g, S, E); }
        const int R0 = tab[24] - NCHK * CHUNK_PAN;
        if (R0 > 0) { PH_VIEW(); pg8::Gemm g{(const bf16*)(ws + WS_HSQ), (const bf16*)((const unsigned char*)A->out + DO_M13Q), 0, 0, D / 2}; MoeOrder S; S.init(R0, 28, G, VCU(), NCHK * CHUNK_PAN, 0);
#pragma unroll
          for (int e = 0; e < 8; ++e) S.pb[e] = __builtin_amdgcn_readfirstlane(tab[16 + e]);
          EpiSwiGLUQ E{(bf16*)(ws + WS_ACT), DEXP, 28, (NCHK - 1) * CHUNK_PAN, (const float*)(ws + WS_ROUTE + RT_SA), (const float*)(ws + WS_SB13)};
          pg8::gemm_phase<EpiSwiGLUQ, MoeOrder, true, true>(lds, g, S, E); }
    }
    BAR(PH_M0);
#pragma nounroll
    for (int it = 1; it <= NCHK; ++it) {
        const int TP = tab[24], R = TP - NCHK * CHUNK_PAN, pa = PH_M0 - 1 + 2 * it, pbb = PH_M0 + 2 * it;
        if (IN(pa)) { PH_VIEW();
            pg8::Gemm g{(const bf16*)(ws + WS_ACT), (const bf16*)((const unsigned char*)A->out + DO_M2), 0, 0, DEXP}; MoeOrder S; S.init(CHUNK_PAN, 4, G, VCU(), CHUNK_PAN * (it - 1), 1); S.nb = 0;
#pragma unroll
            for (int e = 0; e < 8; ++e) S.pb[e] = __builtin_amdgcn_readfirstlane(tab[16 + e]);
            EpiMoeOut E{(bf16*)(ws + WS_HS), (const float*)(ws + WS_ROUTE + RT_GW), CHUNK_PAN * (it - 1)};
            pg8::gemm_phase<EpiMoeOut, MoeOrder, true, true>(lds, g, S, E);
        }
        BAR(pa);
        if (it < NCHK) {
            if (IN(pbb) && it == 1 && R > 0) { PH_VIEW();
                pg8::Gemm g{(const bf16*)(ws + WS_ACT) + (size_t)CHUNK_PAN * 256 * DEXP, (const bf16*)((const unsigned char*)A->out + DO_M2), 0, 0, DEXP}; MoeOrder S; S.init(R, 4, G, VCU(), NCHK * CHUNK_PAN, 1); S.nb = 0;
#pragma unroll
                for (int e = 0; e < 8; ++e) S.pb[e] = __builtin_amdgcn_readfirstlane(tab[16 + e]);
                EpiMoeOut E{(bf16*)(ws + WS_HS), (const float*)(ws + WS_ROUTE + RT_GW), NCHK * CHUNK_PAN};
                pg8::gemm_phase<EpiMoeOut, MoeOrder, true, true>(lds, g, S, E);
            }
            if (IN(pbb)) { PH_VIEW();
                pg8::Gemm g{(const bf16*)(ws + WS_HSQ), (const bf16*)((const unsigned char*)A->out + DO_M13Q), 0, 0, D / 2}; MoeOrder S; S.init(CHUNK_PAN, 28, G, VCU(), CHUNK_PAN * it, 0); S.nb = (it == 1) ? 4 * R : 0;
#pragma unroll
                for (int e = 0; e < 8; ++e) S.pb[e] = __builtin_amdgcn_readfirstlane(tab[16 + e]);
                EpiSwiGLUQ E{(bf16*)(ws + WS_ACT), DEXP, 28, CHUNK_PAN * it, (const float*)(ws + WS_ROUTE + RT_SA), (const float*)(ws + WS_SB13)};
                pg8::gemm_phase<EpiSwiGLUQ, MoeOrder, true, true>(lds, g, S, E);
            }
            BAR(pbb);
        }
    }
    if (IN(NPHASE - 1)) { PH_VIEW(); const float* mlat1 = mods + MO_LAT + 16 * 6144;
        unsigned bad = __hip_atomic_load((unsigned*)(ws + WS_CTL) + CW_BAR + XB_TMO, __ATOMIC_RELAXED, __HIP_MEMORY_SCOPE_AGENT);
        const bf16* Y = (const bf16*)(ws + WS_HS);
        const v4i* selt = (const v4i*)(ws + WS_ROUTE + RT_SEL);
        const bf16* X3 = (const bf16*)(ws + WS_X3);
#define FIN_LOAD(mm, sel_, X_, A_, B_) do { const v2u* xr_ = (const v2u*)(X3 + (size_t)(mm) * D) + lane; const v2u* y0_ = (const v2u*)(Y + (size_t)(sel_).z * D) + lane; const v2u* y1_ = (const v2u*)(Y + (size_t)(sel_).w * D) + lane; \
            _Pragma("unroll") for (int j = 0; j < 4; ++j) { X_[j] = xr_[64 * j]; A_[j] = y0_[64 * j]; B_[j] = y1_[64 * j]; } } while (0)
        v2u xa[4], xn[4]; v2u aa[4], ab[4], na[4], nb[4]; v4i seln = (v4i){0, 0, 0, 0};
        if (gw < ML) { const v4i s0 = selt[gw]; FIN_LOAD(gw, s0, xa, aa, ab); if (gw + NGW < ML) seln = selt[gw + NGW]; }
        for (int m = gw; m < ML; m += NGW) { const int mn = m + NGW; const float* md = mlat1 + (m >> 11) * 6144 + 5120;
            if (mn < ML) { FIN_LOAD(mn, seln, xn, na, nb); if (mn + NGW < ML) seln = selt[mn + NGW]; }
            f32x4* xr = (f32x4*)(A->out + (size_t)m * D) + lane;
            f32x4 v[4]; float s = 0.f;
#pragma unroll
            for (int j = 0; j < 4; ++j) { const f32x4 gt = ((const f32x4*)md)[lane + 64 * j]; const v2u a = aa[j], b = ab[j];
                const f32x4 yy = {bflo(a.x) + bflo(b.x), bfhi(a.x) + bfhi(b.x), bflo(a.y) + bflo(b.y), bfhi(a.y) + bfhi(b.y)};
                v[j] = (f32x4){bflo(xa[j].x), bfhi(xa[j].x), bflo(xa[j].y), bfhi(xa[j].y)} + gt * yy; s += (v[j].x * v[j].x + v[j].y * v[j].y) + (v[j].z * v[j].z + v[j].w * v[j].w); }
            const float rstd = rsqrtf(wave_sum(s) * (1.f / D) + EPS);
#pragma unroll
            for (int j = 0; j < 4; ++j) { f32x4 o = v[j] * rstd * ((const f32x4*)A->in[I_FNG])[lane + 64 * j]; if (bad) o = (f32x4){__builtin_nanf(""), __builtin_nanf(""), __builtin_nanf(""), __builtin_nanf("")}; xr[64 * j] = o; }
#pragma unroll
            for (int j = 0; j < 4; ++j) { xa[j] = xn[j]; aa[j] = na[j]; ab[j] = nb[j]; } }
#undef FIN_LOAD
    }
#undef IN
#undef BAR
}

extern "C" void kernel_launch(void* const* d_in, const int* in_sizes, int n_in, void* d_out, int out_size, void* d_ws, size_t ws_size, hipStream_t stream) {
    static int grid = 0;
    if (grid == 0) {
        if (n_in != 23 || in_sizes[0] != ML * D || out_size != ML * D || ws_size < WS_END2) { fprintf(stderr, "kernel_launch: unexpected shapes (n_in %d, in0 %d, out %d, ws %zu, need %zu); nothing launched\n", n_in, n_in > 0 ? in_sizes[0] : -1, out_size, ws_size, (size_t)WS_END2); grid = -1; return; }
        int dev = 0, cus = 0, per_cu = 0;
        if (hipGetDevice(&dev) != hipSuccess || hipDeviceGetAttribute(&cus, hipDeviceAttributeMultiprocessorCount, dev) != hipSuccess) { grid = -1; return; }
        if (hipFuncSetAttribute((const void*)fwd_kernel, hipFuncAttributeMaxDynamicSharedMemorySize, LDS_BYTES) != hipSuccess) { fprintf(stderr, "kernel_launch: hipFuncSetAttribute failed\n"); grid = -1; return; }
        if (hipOccupancyMaxActiveBlocksPerMultiprocessor(&per_cu, (const void*)fwd_kernel, NTHR, LDS_BYTES) != hipSuccess || per_cu < 1) fprintf(stderr, "kernel_launch: occupancy query reports %d\n", per_cu);
        (void)hipGetLastError();
        if (cus < 256) { fprintf(stderr, "kernel_launch: needs 256 CUs, device has %d\n", cus); grid = -1; return; }
        grid = 256;
    }
    if (grid < 0) return;
    if (hipMemsetAsync((char*)d_ws + WS_CTL, 0, CTL_ZERO_BYTES, stream) != hipSuccess) return;
    Args a{};
    for (int i = 0; i < 23; ++i) a.in[i] = (const float*)d_in[i];
    a.out = (float*)d_out; a.ws = (unsigned char*)d_ws;
#if MK_MULTI
#if defined(PROBE_EXTRA)
    { a.ph_lo = PROBE_EXTRA; a.ph_hi = PROBE_EXTRA + 1; }
#define PROBE_LAUNCH() do { Args b = a; b.ph_lo = PROBE_EXTRA; b.ph_hi = PROBE_EXTRA + 1; hipLaunchKernelGGL(fwd_kernel, dim3(grid), dim3(NTHR), LDS_BYTES, stream, b); } while (0)
#else
#define PROBE_LAUNCH() do { } while (0)
#endif
    for (int k = 0; k < NPHASE; ++k) { if (k == PROBE_AT) PROBE_LAUNCH(); a.ph_lo = k; a.ph_hi = k + 1; const int nrep = ((PROBE_REP >> k) & 1ull) ? 2 : 1; for (int r = 0; r < nrep; ++r) hipLaunchKernelGGL(fwd_kernel, dim3(grid), dim3(NTHR), LDS_BYTES, stream, a); }
#else
    a.ph_lo = 0; a.ph_hi = NPHASE; hipLaunchKernelGGL(fwd_kernel, dim3(grid), dim3(NTHR), LDS_BYTES, stream, a);
#endif
}
```

```cpp
#include <hip/hip_runtime.h>
#include <cstdio>
#include <cstdint>
#ifndef MK_MULTI
#define MK_MULTI 0
#endif
#ifndef PROBE_REP
#define PROBE_REP 0ull
#endif
#ifndef PROBE_AT
#define PROBE_AT (-1)
#endif
namespace pg8 {
#define PG8_LAS __attribute__((address_space(3)))
typedef unsigned short bf16_t;
typedef short bf16x8 __attribute__((ext_vector_type(8)));
typedef float f32x4 __attribute__((ext_vector_type(4)));
typedef unsigned u32x4 __attribute__((ext_vector_type(4)));
typedef int i32x4 __attribute__((ext_vector_type(4)));
template <bool I8> struct AccSel { typedef f32x4 T; };
template <> struct AccSel<true> { typedef i32x4 T; };
__device__ __forceinline__ f32x4 mma_bf16(bf16x8 a, bf16x8 b, f32x4 c) { return __builtin_amdgcn_mfma_f32_16x16x32_bf16(a, b, c, 0, 0, 0); }
__device__ __forceinline__ i32x4 mma_i8(bf16x8 a, bf16x8 b, i32x4 c) { return __builtin_amdgcn_mfma_i32_16x16x64_i8(__builtin_bit_cast(i32x4, a), __builtin_bit_cast(i32x4, b), c, 0, 0, 0); }
constexpr int BM = 256, BK = 64, HALF = 128, HTB = HALF * BK * 2  , STAGE_BYTES = 8 * HTB, NXCD = 8, WGM = 8;

__host__ __device__ __forceinline__ int lds_byte(int r, int c) { const int st = (r >> 4) * 2 + (c >> 5), rr = r & 15, cc = c & 31, ob = rr * 64 + cc * 2; return st * 1024 + (ob ^ (((ob >> 9) & 1) << 5)); }
__host__ __device__ __forceinline__ void stage_rc(int b, int& R, int& C) { const int st = b / 1024, sb = b % 1024, swz = sb ^ (((sb >> 9) & 1) << 5); R = (st >> 1) * 16 + swz / 64; C = (st & 1) * 32 + (swz % 64) / 2; }
__host__ __device__ __forceinline__ int perm32(int rho) { const int n = rho >> 4, i = rho & 15; return 8 * (i >> 2) + 4 * n + (i & 3); }

struct Unit { int pm, pn; };
struct Gemm { const bf16_t* A; const bf16_t* Bt; int M, N, K; };

struct StaticOrder {
    int nM, nN, nwg, G, c;
    __host__ __device__ void init(int M, int N, int G_, int c_) { nM = M / BM; nN = N / BM; nwg = nM * nN; G = G_; c = c_; }
    __host__ __device__ bool next(int i, Unit& u) const {
        const long L = (long)i * G + c; if (L >= nwg) return false;
        int wgid = (int)L; { const int q = nwg / NXCD, r = nwg % NXCD, xcd = wgid % NXCD, off = wgid / NXCD; wgid = (xcd < r ? xcd * (q + 1) : r * (q + 1) + (xcd - r) * q) + off; }
        const int nig = WGM * nN, gid = wgid / nig, fm = gid * WGM, gsz = (nM - fm) < WGM ? (nM - fm) : WGM;
        u.pm = fm + ((wgid % nig) % gsz); u.pn = (wgid % nig) / gsz; return true;
    }
    __device__ __forceinline__ void a_ready(const Unit&) const {}
    __device__ __forceinline__ void done(const Unit&) const {}
};
__device__ __forceinline__ unsigned cvt_pk_bf16(float lo, float hi) { unsigned r; asm volatile("v_cvt_pk_bf16_f32 %0, %1, %2" : "=v"(r) : "v"(lo), "v"(hi)); return r; }
typedef float f32x2 __attribute__((ext_vector_type(2)));
template <class Epi, class Sched, bool ALIGN_EPI = false, bool SP2 = false>
__device__ __forceinline__ void gemm_phase(PG8_LAS unsigned char* lds, const Gemm g, const Sched& S, const Epi& E) {
    int tid_l = threadIdx.x; asm volatile("" : "+v"(tid_l));
    const int tid = tid_l, wid = __builtin_amdgcn_readfirstlane(tid >> 6), lane = tid & 63, wr = wid >> 2, wc = wid & 3, fr = lane & 15, fq = lane >> 4;
    const int K = g.K, nt = K / BK;
    unsigned voffA[2], voffB[2];
#pragma unroll
    for (int i = 0; i < 2; ++i) { int R, C; stage_rc(tid * 16 + i * 8192, R, C); const int Rb = Epi::PERM ? ((R & ~31) + perm32(R & 31)) : R;
        voffA[i] = (unsigned)(R * K + C) * 2u; voffB[i] = (unsigned)(Rb * K + C) * 2u; }
    const size_t kstep = (size_t)(BK * 2);
    const size_t hstep = (size_t)HALF * K * 2;
    const size_t tstep = 2 * hstep;
    const unsigned ldsw = (unsigned)wid * 1024u;
    const int aoff = lds_byte(wr * 64 + fr, fq * 8), boff = lds_byte(wc * 32 + fr, fq * 8);
#define PG8_SA(b, h) (((b) * 2 + (h)) * HTB)
#define PG8_SB(b, h) ((4 + (b) * 2 + (h)) * HTB)
#define PG8_STAGE(bufoff, gbase, voff) do { _Pragma("unroll") for (int _i = 0; _i < 2; ++_i) \
        __builtin_amdgcn_global_load_lds((const unsigned*)((const char*)(gbase) + (voff)[_i]), (PG8_LAS unsigned*)(lds + (bufoff) + ldsw + _i * 8192), 16, 0, 0); } while (0)
#define PG8_LDA(dst, b, h) do { _Pragma("unroll") for (int m = 0; m < 4; ++m) _Pragma("unroll") for (int k = 0; k < 2; ++k) dst[m][k] = *(const PG8_LAS bf16x8*)(lds + PG8_SA(b, h) + aoff + m * 2048 + k * 1024); } while (0)
#define PG8_LDB(dst, b, h) do { _Pragma("unroll") for (int n = 0; n < 2; ++n) _Pragma("unroll") for (int k = 0; k < 2; ++k) dst[n][k] = *(const PG8_LAS bf16x8*)(lds + PG8_SB(b, h) + boff + n * 2048 + k * 1024); } while (0)
#define PG8_MMA(ai, bj, At, Bt) do { __builtin_amdgcn_s_setprio(1); _Pragma("unroll") for (int m = 0; m < 4; ++m) _Pragma("unroll") for (int n = 0; n < 2; ++n) _Pragma("unroll") for (int k = 0; k < 2; ++k) \
        { if constexpr (Epi::I8) acc[ai][bj][m][n] = mma_i8(Bt[n][k], At[m][k], acc[ai][bj][m][n]); else acc[ai][bj][m][n] = mma_bf16(Bt[n][k], At[m][k], acc[ai][bj][m][n]); } __builtin_amdgcn_s_setprio(0); } while (0)
#define PG8_WAIT_V(n) asm volatile("s_waitcnt vmcnt(" #n ")" ::: "memory")
#define PG8_WAIT_L(n) asm volatile("s_waitcnt lgkmcnt(" #n ")" ::: "memory")
#define PG8_BAR __builtin_amdgcn_s_barrier()
#define PG8_SCHED __builtin_amdgcn_sched_barrier(0)
    Unit cur, nxt; int ui = 0;
    if (!S.next(0, cur)) return;
    typedef typename AccSel<Epi::I8>::T acc_t;
    acc_t acc[2][2][4][2];
#pragma unroll
    for (int a = 0; a < 2; ++a)
#pragma unroll
        for (int b = 0; b < 2; ++b)
#pragma unroll
            for (int m = 0; m < 4; ++m)
#pragma unroll
                for (int n = 0; n < 2; ++n) acc[a][b][m][n] = (acc_t){0, 0, 0, 0};
    bf16x8 At[4][2], B0[2][2], B1[2][2];
    const char* cA = (const char*)g.A + (size_t)cur.pm * tstep; const char* cB = (const char*)g.Bt + (size_t)cur.pn * tstep;
    S.a_ready(cur);
    if constexpr (SP2) {
        PG8_STAGE(PG8_SB(0, 0), cB, voffB); PG8_STAGE(PG8_SB(0, 1), cB + hstep, voffB); PG8_STAGE(PG8_SA(0, 0), cA, voffA); PG8_STAGE(PG8_SA(0, 1), cA + hstep, voffA);
        if (wr == 1) PG8_BAR;
        PG8_WAIT_V(2); PG8_BAR;
        PG8_STAGE(PG8_SB(1, 0), cB + kstep, voffB); PG8_STAGE(PG8_SA(1, 0), cA + kstep, voffA); PG8_STAGE(PG8_SB(1, 1), cB + hstep + kstep, voffB);
        PG8_WAIT_V(6); PG8_BAR;
    } else {
        PG8_STAGE(PG8_SB(0, 0), cB, voffB); PG8_STAGE(PG8_SA(0, 0), cA, voffA); PG8_STAGE(PG8_SB(0, 1), cB + hstep, voffB); PG8_STAGE(PG8_SA(0, 1), cA + hstep, voffA);
        if (wr == 1) PG8_BAR;
        PG8_WAIT_V(4); PG8_BAR;
        PG8_STAGE(PG8_SB(1, 0), cB + kstep, voffB); PG8_STAGE(PG8_SA(1, 0), cA + kstep, voffA); PG8_STAGE(PG8_SB(1, 1), cB + hstep + kstep, voffB);
        PG8_WAIT_V(6); PG8_BAR;
    }
    for (;;) {
        const bool has_next = S.next(ui + 1, nxt);
        const char* nA = has_next ? (const char*)g.A + (size_t)nxt.pm * tstep : cA; const char* nB = has_next ? (const char*)g.Bt + (size_t)nxt.pn * tstep : cB;
        for (int t = 0; t < nt; t += 2) {
            const bool last = (t == nt - 2);
            const char* a1 = cA + (size_t)(t + 1) * kstep;
            const char* a2 = last ? nA : cA + (size_t)(t + 2) * kstep; const char* b2 = last ? nB : cB + (size_t)(t + 2) * kstep;
            const char* a3 = a2 + kstep; const char* b3 = b2 + kstep;
            if (last && has_next) S.a_ready(nxt);
            if constexpr (SP2) {
            PG8_LDB(B0, 0, 0); PG8_LDB(B1, 0, 1); PG8_SCHED; PG8_LDA(At, 0, 0); PG8_STAGE(PG8_SA(1, 1), a1 + hstep, voffA);
            PG8_WAIT_V(8); PG8_WAIT_L(0); PG8_BAR; PG8_MMA(0, 0, At, B0); PG8_MMA(0, 1, At, B1); PG8_BAR; PG8_SCHED;
            PG8_LDA(At, 0, 1); PG8_STAGE(PG8_SB(0, 0), b2, voffB); PG8_STAGE(PG8_SB(0, 1), b2 + hstep, voffB); PG8_STAGE(PG8_SA(0, 0), a2, voffA);
            PG8_WAIT_V(8); PG8_WAIT_L(0); PG8_BAR; PG8_MMA(1, 0, At, B0); PG8_MMA(1, 1, At, B1); PG8_BAR; PG8_SCHED;
            PG8_LDB(B0, 1, 0); PG8_LDB(B1, 1, 1); PG8_SCHED; PG8_LDA(At, 1, 0); PG8_STAGE(PG8_SA(0, 1), a2 + hstep, voffA);
            PG8_WAIT_V(8); PG8_WAIT_L(0); PG8_BAR; PG8_MMA(0, 0, At, B0); PG8_MMA(0, 1, At, B1); PG8_BAR; PG8_SCHED;
            PG8_LDA(At, 1, 1); PG8_STAGE(PG8_SB(1, 0), b3, voffB); PG8_STAGE(PG8_SB(1, 1), b3 + hstep, voffB); PG8_STAGE(PG8_SA(1, 0), a3, voffA);
            PG8_WAIT_V(8); PG8_WAIT_L(0); PG8_BAR; PG8_MMA(1, 0, At, B0); PG8_MMA(1, 1, At, B1); PG8_BAR; PG8_SCHED;
            } else {
            PG8_LDB(B0, 0, 0); PG8_SCHED; PG8_LDA(At, 0, 0); PG8_STAGE(PG8_SA(1, 1), a1 + hstep, voffA);
            PG8_WAIT_L(8); PG8_BAR; PG8_WAIT_L(0); PG8_MMA(0, 0, At, B0); PG8_BAR; PG8_SCHED;
            PG8_LDB(B1, 0, 1); PG8_STAGE(PG8_SB(0, 0), b2, voffB);
            PG8_BAR; PG8_WAIT_L(0); PG8_MMA(0, 1, At, B1); PG8_BAR;
            PG8_LDA(At, 0, 1); PG8_STAGE(PG8_SA(0, 0), a2, voffA);
            PG8_BAR; PG8_WAIT_L(0); PG8_MMA(1, 0, At, B0); PG8_BAR; PG8_SCHED;
            PG8_STAGE(PG8_SB(0, 1), b2 + hstep, voffB);
            PG8_WAIT_V(6); PG8_BAR; PG8_MMA(1, 1, At, B1); PG8_BAR;
            PG8_LDB(B0, 1, 0); PG8_SCHED; PG8_LDA(At, 1, 0); PG8_STAGE(PG8_SA(0, 1), a2 + hstep, voffA);
            PG8_WAIT_L(8); PG8_BAR; PG8_WAIT_L(0); PG8_MMA(0, 0, At, B0); PG8_BAR; PG8_SCHED;
            PG8_LDB(B1, 1, 1); PG8_STAGE(PG8_SB(1, 0), b3, voffB);
            PG8_BAR; PG8_WAIT_L(0); PG8_MMA(0, 1, At, B1); PG8_BAR;
            PG8_LDA(At, 1, 1); PG8_STAGE(PG8_SA(1, 0), a3, voffA);
            PG8_BAR; PG8_WAIT_L(0); PG8_MMA(1, 0, At, B0); PG8_BAR; PG8_SCHED;
            PG8_STAGE(PG8_SB(1, 1), b3 + hstep, voffB);
            PG8_WAIT_V(6); PG8_BAR; PG8_MMA(1, 1, At, B1); PG8_BAR;
            }
        }
        if constexpr (ALIGN_EPI) { if (wr == 0) PG8_BAR; }
        if constexpr (!Epi::AFTER_DRAIN) { E(acc, cur, wr, wc, fr, fq); S.done(cur); }
        if (!has_next) break;
#pragma unroll
        for (int a = 0; a < 2; ++a)
#pragma unroll
            for (int b = 0; b < 2; ++b)
#pragma unroll
                for (int m = 0; m < 4; ++m)
#pragma unroll
                    for (int n = 0; n < 2; ++n) acc[a][b][m][n] = (acc_t){0, 0, 0, 0};
        cur = nxt; cA = nA; cB = nB; ++ui;
        if constexpr (ALIGN_EPI) { if (wr == 1) PG8_BAR; }
    }
    PG8_WAIT_V(0);
    if constexpr (!ALIGN_EPI) { if (wr == 0) PG8_BAR; }
    PG8_BAR;
    if constexpr (Epi::AFTER_DRAIN) { E.fused(acc, cur, wr, wc, fr, fq, lds, wid, lane); S.done(cur); }
#undef PG8_SA
#undef PG8_SB
#undef PG8_STAGE
#undef PG8_LDA
#undef PG8_LDB
#undef PG8_MMA
#undef PG8_WAIT_V
#undef PG8_WAIT_L
#undef PG8_BAR
#undef PG8_SCHED
}
}
constexpr int NB = 16, SEQ = 2048, CTXL = 256, D = 1024;
constexpr int ML = NB * SEQ, MC = NB * CTXL, MT = ML + MC;
constexpr int INW = 4128, PW = 4096, NIN = 4352;
constexpr int DFF = 2816, NEXP = 8, DEXP = 3584;
constexpr int NWAVES = 8, NTHR = 512;
constexpr float EPS = 1e-6f;
constexpr int PH_M0 = 16, NPHASE = 21;
constexpr int CHUNK_PAN = 128, NCHK = 256 / CHUNK_PAN;
constexpr int NPOS = CTXL + SEQ, PBLK_G = 256, PBLK_H = 768;
constexpr size_t PH_OFF = (size_t)NB * 4 * NPOS * PBLK_G;
constexpr int HS_ROWS = 2 * ML + NEXP * 256;

constexpr size_t MiB = 1u << 20;
constexpr size_t WS_CTL = 0, CTL_ZERO_BYTES = 1 * MiB;
constexpr size_t WS_MODS = 1 * MiB, WS_ROUTE = 2 * MiB, WS_GR = 4 * MiB, WS_WIN = 7 * MiB, WS_WOUT = 24 * MiB, WS_F13 = 28 * MiB, WS_F2 = 39 * MiB;
constexpr size_t WS_XC = 45 * MiB, WS_H = 61 * MiB, WS_OB = 133 * MiB, WS_G = 205 * MiB, WS_P = 277 * MiB, WS_END = 565 * MiB;
constexpr size_t WS_MIX = WS_P, WS_ACT0 = WS_P, WS_HS = WS_OB, WS_ACT = 265 * MiB, WS_HSQ = 503 * MiB, WS_END2 = 576 * MiB;
constexpr size_t DO_M2 = 0, DO_M13Q = 64 * MiB;
constexpr size_t WS_HQ = WS_H, WS_SB13 = WS_GR + 2621440, WS_SBIN = WS_GR + 2883584, WS_SBF = WS_SBIN + 32768, WS_SBO = WS_SBF + 32768, WS_SAR = WS_SBO + 8192;
constexpr size_t WS_X3 = WS_H, WS_HQ2 = WS_OB;
constexpr size_t WS_WINQ = WS_WIN + MiB, WS_MIXQ = WS_MIX;
static_assert(WS_GR + (size_t)MT * 32 * 2 <= WS_WIN && WS_WIN + 2ull * NIN * 1024 * 2 <= WS_WOUT && WS_F13 + 5632ull * 1024 * 2 <= WS_F2 && WS_F2 + 1024ull * DFF * 2 <= WS_XC, "ws map 1");
static_assert(WS_XC + (size_t)MC * D * 4 <= WS_H && WS_H + (size_t)MT * D * 2 <= WS_OB && WS_OB + (size_t)MT * D * 2 <= WS_G && WS_G + (size_t)MT * D * 2 <= WS_P && WS_P + (size_t)MT * PW * 2 <= WS_END, "ws map 2");
static_assert(WS_ACT0 + (size_t)MT * DFF * 2 <= WS_END && WS_HS + (size_t)HS_ROWS * D * 2 <= WS_ACT && WS_ACT + (size_t)(CHUNK_PAN + 8) * 256 * DEXP * 2 <= WS_HSQ && DO_M2 + 8ull * 1024 * DEXP * 2 <= DO_M13Q && DO_M13Q + 8ull * 7168 * 1024 <= (size_t)ML * D * 4 && WS_HSQ + (size_t)HS_ROWS * D <= WS_END2, "ws map 3");
static_assert(WS_HQ + (size_t)ML * D <= WS_OB && WS_SB13 + 8 * 7168 * 4 <= WS_SBIN && WS_SAR + (size_t)MT * 4 <= WS_WIN && WS_HQ + (size_t)MT * D <= WS_OB && WS_WINQ + 2ull * 4096 * 1024 <= WS_WOUT, "mix vs moe weights; int8 rows; scales");
constexpr int MO_LAT = 0, MO_CTX = 2 * 16 * 6144, MO_LB = MO_CTX + 2 * 6144;
constexpr size_t RT_SEL = 0, RT_W = 512 * 1024, RT_CNT = 768 * 1024, RT_GW = 1024 * 1024, RT_SA = 1536 * 1024, RT_SAN = 1792 * 1024;
constexpr int CW_TMO = 0, CW_CODE = 1, CW_BAR = 4096, CW_CM = 131072;
constexpr int RING_BYTES = 131072, LDSCTL_OFF = RING_BYTES, MISC_OFF = LDSCTL_OFF + 320, TAB_OFF = LDSCTL_OFF + 512, LDS_BYTES = 147456;

#define GAS __attribute__((address_space(1)))
#define LAS __attribute__((address_space(3)))
typedef unsigned short bf16;
typedef unsigned v4u __attribute__((ext_vector_type(4)));
typedef unsigned v2u __attribute__((ext_vector_type(2)));
typedef int v4i __attribute__((ext_vector_type(4)));
typedef float f32x4 __attribute__((ext_vector_type(4)));
typedef float f32x2v __attribute__((ext_vector_type(2)));
#define LDS_WAIT() asm volatile("s_waitcnt lgkmcnt(0)" ::: "memory")
#define VM_WAIT() asm volatile("s_waitcnt vmcnt(0)" ::: "memory")
typedef float f32x2_t __attribute__((ext_vector_type(2)));
typedef __bf16 bf16x2_t __attribute__((ext_vector_type(2)));
__device__ __forceinline__ unsigned cvtpk(float lo, float hi) { f32x2_t v = {lo, hi}; bf16x2_t b = __builtin_convertvector(v, bf16x2_t); return __builtin_bit_cast(unsigned, b); }
__device__ __forceinline__ unsigned f2bf(float f) { unsigned u = __builtin_bit_cast(unsigned, f); return (u + 0x7fffu + ((u >> 16) & 1u)) >> 16; }
__device__ __forceinline__ unsigned pk2(float lo, float hi) { return cvtpk(lo, hi); }
__device__ __forceinline__ float bf2f(unsigned b) { return __builtin_bit_cast(float, b << 16); }
__device__ __forceinline__ float bflo(unsigned w) { return __builtin_bit_cast(float, w << 16); }
__device__ __forceinline__ float bfhi(unsigned w) { return __builtin_bit_cast(float, w & 0xffff0000u); }
__device__ __forceinline__ float wave_sum(float v) {
#pragma unroll
    for (int o = 1; o < 64; o <<= 1) v += __shfl_xor(v, o);
    return v;
}
__device__ __forceinline__ float silu_f(float x) { return x * __builtin_amdgcn_rcpf(1.f + __expf(-x)); }
__device__ __forceinline__ float logsig_f(float x) { return fminf(x, 0.f) - __logf(1.f + __expf(-fabsf(x))); }

#define XB_TMO      128
#define XB_XCNT(j)  (256  + 64 * (j))
#define XB_XSUB(j)  (1280 + 64 * (j))
#define XB_XGEN(j)  (2304 + 64 * (j))
#define XB_TOP      3328
#define XB_TOPGEN   3392
#define XCD_BAR_WORDS 3456
#define XB_SPIN_CAP (1u << 18)

__device__ __forceinline__ unsigned xb_ld(unsigned* p)              { return __hip_atomic_load(p, __ATOMIC_RELAXED, __HIP_MEMORY_SCOPE_AGENT); }
__device__ __forceinline__ unsigned xb_add(unsigned* p, unsigned v) { return __hip_atomic_fetch_add(p, v, __ATOMIC_RELAXED, __HIP_MEMORY_SCOPE_AGENT); }
__device__ __forceinline__ unsigned xb_xcc_id() { return (unsigned)__builtin_amdgcn_s_getreg((3 << 11) | 20) & 0xFu; }
#define XB_SPIN(cond, bar) do { unsigned _sp = 0; while (cond) { __builtin_amdgcn_s_sleep(1); \
    if ((++_sp & 255u) == 0u) { if (xb_ld(&(bar)[XB_TMO])) break; if (_sp > XB_SPIN_CAP) { atomicAdd(&(bar)[XB_TMO], 1u); break; } } } } while (0)

struct XcdBarrier {
    unsigned* bar; unsigned x;
    volatile LAS unsigned* st;
};

__device__ __forceinline__ XcdBarrier xcd_barrier_post(unsigned* bar, volatile LAS unsigned* st) {
    XcdBarrier b; b.bar = bar; b.x = xb_xcc_id(); b.st = st;
    if (threadIdx.x == 0) (void)xb_add(&bar[XB_XCNT(b.x)], 1u);
    return b;
}
__device__ __forceinline__ void xcd_barrier_complete(unsigned* bar, unsigned x, unsigned& nloc, unsigned& nx) {
    const unsigned G = gridDim.x * gridDim.y * gridDim.z;
    unsigned sum, cnt, mine, sp = 0u;
    for (;;) {
        sum = 0u; cnt = 0u; mine = 0u;
#pragma unroll
        for (unsigned j = 0; j < 16; ++j) { const unsigned c = xb_ld(&bar[XB_XCNT(j)]); sum += c; cnt += (c > 0u) ? 1u : 0u; mine = (j == x) ? c : mine; }
        if (sum == G) break;
        __builtin_amdgcn_s_sleep(1);
        if ((++sp & 255u) == 0u) { if (xb_ld(&bar[XB_TMO])) break; if (sp > XB_SPIN_CAP) { atomicAdd(&bar[XB_TMO], 1u); break; } }
    }
    nloc = mine > 0u ? mine : 1u; nx = cnt > 0u ? cnt : 1u;
}

template <bool LIGHT = false> __device__ __forceinline__ void xcd_barrier(const XcdBarrier& b) {
    asm volatile("s_waitcnt vmcnt(0)" ::: "memory");
    __syncthreads();
    if (threadIdx.x == 0) {
        unsigned* bar = b.bar;
        __builtin_amdgcn_s_waitcnt(0);
        unsigned nloc = b.st[0], nx = b.st[1];
        if (nloc == 0u) { xcd_barrier_complete(bar, b.x, nloc, nx); b.st[0] = nloc; b.st[1] = nx; }
        const unsigned old = xb_add(&bar[XB_XSUB(b.x)], 1u);
        const unsigned gen = old / nloc;
        if (old + 1u == (gen + 1u) * nloc) {
            if constexpr (!LIGHT) __builtin_amdgcn_fence(__ATOMIC_RELEASE, "agent");
            asm volatile("s_waitcnt vmcnt(0)" ::: "memory");
            const unsigned og = xb_add(&bar[XB_TOP], 1u);
            const unsigned tg = og / nx;
            if (og + 1u == (tg + 1u) * nx) xb_add(&bar[XB_TOPGEN], 1u);
            else XB_SPIN(xb_ld(&bar[XB_TOPGEN]) == tg, bar);
            if constexpr (!LIGHT) __builtin_amdgcn_fence(__ATOMIC_ACQUIRE, "agent");
            xb_add(&bar[XB_XGEN(b.x)], 1u);
            asm volatile("s_waitcnt vmcnt(0)" ::: "memory");
        } else {
            XB_SPIN(xb_ld(&bar[XB_XGEN(b.x)]) == gen, bar);
            if constexpr (!LIGHT) __builtin_amdgcn_fence(__ATOMIC_ACQUIRE, "agent");
            asm volatile("s_waitcnt vmcnt(0)" ::: "memory");
        }
    }
    __syncthreads();
}
using pg8::Unit;
template <bool Q> struct EpiInProjT {
    static constexpr bool PERM = true, AFTER_DRAIN = false, I8 = Q;
    typedef typename pg8::AccSel<Q>::T acc_t;
    bf16* P; bf16* G; bf16* GR; const float* LB; const float* SA; const float* SB;
    __device__ __forceinline__ void cvt8(const acc_t& v0, const acc_t& v1, const Unit& u, int row, int ct, float (&a)[8]) const {
        if constexpr (Q) { const float s = SA[row]; const f32x4 b0 = *(const f32x4*)(SB + u.pn * 256 + ct), b1 = *(const f32x4*)(SB + u.pn * 256 + ct + 4);
            a[0] = (float)v0[0] * (s * b0.x); a[1] = (float)v0[1] * (s * b0.y); a[2] = (float)v0[2] * (s * b0.z); a[3] = (float)v0[3] * (s * b0.w); a[4] = (float)v1[0] * (s * b1.x); a[5] = (float)v1[1] * (s * b1.y); a[6] = (float)v1[2] * (s * b1.z); a[7] = (float)v1[3] * (s * b1.w); }
        else { a[0] = v0[0]; a[1] = v0[1]; a[2] = v0[2]; a[3] = v0[3]; a[4] = v1[0]; a[5] = v1[1]; a[6] = v1[2]; a[7] = v1[3]; } }
    __device__ __forceinline__ void operator()(const acc_t (&acc)[2][2][4][2], const Unit& u, int wr, int wc, int fr, int fq) const {
        const int pn = u.pn;
        const int row0 = u.pm * 256 + wr * 64 + fr, cin = wc * 32 + 8 * fq;
        if (pn == 16) {
            if (wc == 0) {
#pragma unroll
                for (int ai = 0; ai < 2; ++ai)
#pragma unroll
                    for (int m = 0; m < 4; ++m) { float a[8]; cvt8(acc[ai][0][m][0], acc[ai][0][m][1], u, row0 + ai * 128 + m * 16, 8 * fq, a); v4u w; w.x = pk2(a[0], a[1]); w.y = pk2(a[2], a[3]); w.z = pk2(a[4], a[5]); w.w = pk2(a[6], a[7]);
                        *(v4u*)(GR + (size_t)(row0 + ai * 128 + m * 16) * 32 + 8 * fq) = w; }
            }
            return;
        }
        if (pn == 4 || pn == 5 || pn >= 14) {
            const int dcol = (pn >= 14) ? 512 + 256 * (pn - 14) : 256 * (pn - 4);
#pragma unroll
            for (int ai = 0; ai < 2; ++ai)
#pragma unroll
                for (int m = 0; m < 4; ++m)
#pragma unroll
                    for (int bj = 0; bj < 2; ++bj) { float a[8]; cvt8(acc[ai][bj][m][0], acc[ai][bj][m][1], u, row0 + ai * 128 + m * 16, bj * 128 + cin, a);
                        v4u w; w.x = pk2(a[0], a[1]); w.y = pk2(a[2], a[3]); w.z = pk2(a[4], a[5]); w.w = pk2(a[6], a[7]);
                        *(v4u*)(G + (size_t)(row0 + ai * 128 + m * 16) * 1024 + dcol + bj * 128 + cin) = w; }
            return;
        }
        const bool gla = pn <= 3; const int blk = gla ? PBLK_G : PBLK_H;
        int mode = 1, hdv[2], tof[2], tof2 = 0; const float* lbp = LB;
#pragma unroll
        for (int bj = 0; bj < 2; ++bj) { const int c = bj * 128 + cin;
            if (pn == 0) { mode = 0; hdv[bj] = c >> 6; tof[bj] = (c & 63); }
            else if (pn == 1) { hdv[bj] = c >> 6; tof[bj] = 64 + (c & 63); }
            else if (pn <= 3) { hdv[bj] = 2 * (pn - 2) + bj; tof[bj] = 128 + cin; }
            else if (pn <= 7) { mode = 2; hdv[bj] = 2 * (pn - 6) + bj; tof[bj] = 384 + cin; }
            else if (pn <= 9) { mode = 3; hdv[bj] = 2 * (pn - 8) + bj; tof[bj] = 512 + cin; tof2 = 128; lbp = LB + 256 * (pn - 8); }
            else if (pn <= 11) { mode = 3; hdv[bj] = 2 * (pn - 10) + bj; tof[bj] = cin; tof2 = 128; lbp = LB + 512 + 256 * (pn - 10); }
            else { hdv[bj] = 2 * (pn - 12) + bj; tof[bj] = 256 + cin; } }
        bf16* Pp = P + (gla ? 0 : PH_OFF);
        float lb[2][8];
        if (mode == 3) {
#pragma unroll
            for (int bj = 0; bj < 2; ++bj)
#pragma unroll
                for (int j = 0; j < 8; ++j) lb[bj][j] = lbp[bj * 128 + cin + j];
        }
#pragma unroll
        for (int ai = 0; ai < 2; ++ai)
#pragma unroll
            for (int m = 0; m < 4; ++m) {
                const int row = row0 + ai * 128 + m * 16; int b, pos;
                if (row < ML) { b = row >> 11; const int t = row & (SEQ - 1); pos = CTXL + (gla ? t : ((t & 63) * 32 + (t >> 6))); } else { b = (row - ML) >> 8; pos = (row - ML) & (CTXL - 1); }
#pragma unroll
                for (int bj = 0; bj < 2; ++bj) {
                    bf16* dp = Pp + ((size_t)(b * 4 + hdv[bj]) * NPOS + pos) * blk + tof[bj];
                    float a[8]; cvt8(acc[ai][bj][m][0], acc[ai][bj][m][1], u, row, bj * 128 + cin, a);
                    if (mode == 3) {
#pragma unroll
                        for (int j = 0; j < 8; ++j) { const float e = __expf(-fabsf(a[j])), r = __builtin_amdgcn_rcpf(1.f + e), sn = a[j] >= 0.f ? e * r : r;
                            a[j] = (1.f - lb[bj][j]) * sn; } }
                    else if (mode == 0) {
#pragma unroll
                        for (int j = 0; j < 8; ++j) a[j] *= 0.125f; }
                    else if (mode == 2) {
#pragma unroll
                        for (int j = 0; j < 8; ++j) a[j] = silu_f(a[j]); }
                    v4u w; w.x = pk2(a[0], a[1]); w.y = pk2(a[2], a[3]); w.z = pk2(a[4], a[5]); w.w = pk2(a[6], a[7]);
                    *(v4u*)dp = w;
                }
            }
    }
};
template <bool Q> struct EpiResidT {
    static constexpr bool PERM = false, AFTER_DRAIN = false, I8 = Q;
    typedef typename pg8::AccSel<Q>::T acc_t;
    const float* base_lat; const float* base_ctx; float* out_lat; float* out_ctx; const float* gate_lat; const float* gate_ctx; const float* SA; const float* SB;
    __device__ __forceinline__ void operator()(const acc_t (&acc)[2][2][4][2], const Unit& u, int wr, int wc, int fr, int fq) const {
        const int prow = u.pm * 256; const float* base; float* out; const float* gate; int r0;
        if (prow < ML) { base = base_lat; out = out_lat; gate = gate_lat + (prow >> 11) * 6144; r0 = prow; }
        else { base = base_ctx; out = out_ctx; gate = gate_ctx; r0 = prow - ML; }
        const int row0 = r0 + wr * 64 + fr, col0 = u.pn * 256 + wc * 32 + 4 * fq;
        pg8::f32x4 gv[2][2];
#pragma unroll
        for (int bj = 0; bj < 2; ++bj)
#pragma unroll
            for (int n = 0; n < 2; ++n) { gv[bj][n] = *(const pg8::f32x4*)(gate + col0 + bj * 128 + n * 16); if constexpr (Q) gv[bj][n] = gv[bj][n] * *(const pg8::f32x4*)(SB + col0 + bj * 128 + n * 16); }
#pragma unroll
        for (int ai = 0; ai < 2; ++ai) {
            pg8::f32x4 bs[4][2][2];
#pragma unroll
            for (int m = 0; m < 4; ++m) { const size_t off = (size_t)(row0 + ai * 128 + m * 16) * D + col0;
#pragma unroll
                for (int bj = 0; bj < 2; ++bj)
#pragma unroll
                    for (int n = 0; n < 2; ++n) bs[m][bj][n] = *(const pg8::f32x4*)(base + off + bj * 128 + n * 16); }
#pragma unroll
            for (int m = 0; m < 4; ++m) { const size_t off = (size_t)(row0 + ai * 128 + m * 16) * D + col0;
#pragma unroll
                for (int bj = 0; bj < 2; ++bj)
#pragma unroll
                    for (int n = 0; n < 2; ++n) { pg8::f32x4 av; if constexpr (Q) { const float s = SA[u.pm * 256 + wr * 64 + fr + ai * 128 + m * 16]; av = (pg8::f32x4){(float)acc[ai][bj][m][n][0] * s, (float)acc[ai][bj][m][n][1] * s, (float)acc[ai][bj][m][n][2] * s, (float)acc[ai][bj][m][n][3] * s}; } else av = acc[ai][bj][m][n];
                        *(pg8::f32x4*)(out + off + bj * 128 + n * 16) = bs[m][bj][n] + gv[bj][n] * av; } }
            asm volatile("" ::: "memory"); }
    }
};
template <bool F32IN> struct EpiResidB {
    static constexpr bool PERM = true, AFTER_DRAIN = false, I8 = false;
    const void* in_lat; const void* in_ctx; bf16* out_lat; bf16* out_ctx; const float* gate_lat; const float* gate_ctx;
    __device__ __forceinline__ void operator()(const pg8::f32x4 (&acc)[2][2][4][2], const Unit& u, int wr, int wc, int fr, int fq) const {
        const int prow = u.pm * 256; const unsigned char* base; bf16* out; const float* gate; int r0;
        if (prow < ML) { base = (const unsigned char*)in_lat; out = out_lat; gate = gate_lat + (prow >> 11) * 6144; r0 = prow; }
        else { base = (const unsigned char*)in_ctx; out = out_ctx; gate = gate_ctx; r0 = prow - ML; }
        const int row0 = r0 + wr * 64 + fr, col0 = u.pn * 256 + wc * 32 + 8 * fq;
        pg8::f32x4 gv[2][2];
#pragma unroll
        for (int bj = 0; bj < 2; ++bj)
#pragma unroll
            for (int n = 0; n < 2; ++n) gv[bj][n] = *(const pg8::f32x4*)(gate + col0 + bj * 128 + n * 4);
        if constexpr (F32IN) {
#pragma unroll
            for (int ai = 0; ai < 2; ++ai) {
                pg8::f32x4 bs[4][2][2];
#pragma unroll
                for (int m = 0; m < 4; ++m) { const size_t off = (size_t)(row0 + ai * 128 + m * 16) * D + col0;
#pragma unroll
                    for (int bj = 0; bj < 2; ++bj)
#pragma unroll
                        for (int n = 0; n < 2; ++n) bs[m][bj][n] = *(const pg8::f32x4*)((const float*)base + off + bj * 128 + n * 4); }
#pragma unroll
                for (int m = 0; m < 4; ++m) { const size_t off = (size_t)(row0 + ai * 128 + m * 16) * D + col0;
#pragma unroll
                    for (int bj = 0; bj < 2; ++bj) { const pg8::f32x4 v0 = bs[m][bj][0] + gv[bj][0] * acc[ai][bj][m][0], v1 = bs[m][bj][1] + gv[bj][1] * acc[ai][bj][m][1];
                        v4u w; w.x = pk2(v0[0], v0[1]); w.y = pk2(v0[2], v0[3]); w.z = pk2(v1[0], v1[1]); w.w = pk2(v1[2], v1[3]);
                        *(v4u*)(out + off + bj * 128) = w; } }
                asm volatile("" ::: "memory"); }
        } else {
#pragma unroll
            for (int ai = 0; ai < 2; ++ai) {
                v4u bs[4][2];
#pragma unroll
                for (int m = 0; m < 4; ++m) { const size_t off = (size_t)(row0 + ai * 128 + m * 16) * D + col0;
#pragma unroll
                    for (int bj = 0; bj < 2; ++bj) bs[m][bj] = *(const v4u*)((const bf16*)base + off + bj * 128); }
#pragma unroll
                for (int m = 0; m < 4; ++m) { const size_t off = (size_t)(row0 + ai * 128 + m * 16) * D + col0;
#pragma unroll
                    for (int bj = 0; bj < 2; ++bj) { const v4u b = bs[m][bj]; const pg8::f32x4 a0 = acc[ai][bj][m][0], a1 = acc[ai][bj][m][1], g0 = gv[bj][0], g1 = gv[bj][1];
                        v4u w; w.x = pk2(bflo(b.x) + g0[0] * a0[0], bfhi(b.x) + g0[1] * a0[1]); w.y = pk2(bflo(b.y) + g0[2] * a0[2], bfhi(b.y) + g0[3] * a0[3]);
                        w.z = pk2(bflo(b.z) + g1[0] * a1[0], bfhi(b.z) + g1[1] * a1[1]); w.w = pk2(bflo(b.w) + g1[2] * a1[2], bfhi(b.w) + g1[3] * a1[3]);
                        *(v4u*)(out + off + bj * 128) = w; } }
                asm volatile("" ::: "memory"); }
        }
    }
};
typedef EpiInProjT<false> EpiInProj; typedef EpiResidT<false> EpiResid;
struct EpiSwiGLU {
    static constexpr bool PERM = true, AFTER_DRAIN = false, I8 = false;
    bf16* ACT; int ldc, tiles, pm_off;
    __device__ __forceinline__ void operator()(const pg8::f32x4 (&acc)[2][2][4][2], const Unit& u, int wr, int wc, int fr, int fq) const {
        const int row0 = (u.pm - pm_off) * 256 + wr * 64 + fr, col0 = (u.pn % tiles) * 128 + wc * 32 + 8 * fq;
#pragma unroll
        for (int ai = 0; ai < 2; ++ai)
#pragma unroll
            for (int m = 0; m < 4; ++m) {
                const pg8::f32x4 g0 = acc[ai][0][m][0], g1 = acc[ai][0][m][1], u0 = acc[ai][1][m][0], u1 = acc[ai][1][m][1];
                float o[8];
#pragma unroll
                for (int j = 0; j < 4; ++j) { o[j] = silu_f(g0[j]) * u0[j]; o[4 + j] = silu_f(g1[j]) * u1[j]; }
                v4u w; w.x = pk2(o[0], o[1]); w.y = pk2(o[2], o[3]); w.z = pk2(o[4], o[5]); w.w = pk2(o[6], o[7]);
                *(v4u*)(ACT + (size_t)(row0 + ai * 128 + m * 16) * ldc + col0) = w;
            }
    }
};
struct EpiSwiGLUQ {
    static constexpr bool PERM = true, AFTER_DRAIN = false, I8 = true;
    bf16* ACT; int ldc, tiles, pm_off; const float* SA; const float* SB;
    __device__ __forceinline__ void operator()(const pg8::i32x4 (&acc)[2][2][4][2], const Unit& u, int wr, int wc, int fr, int fq) const {
        const int arow0 = u.pm * 256 + wr * 64 + fr, row0 = (u.pm - pm_off) * 256 + wr * 64 + fr, cin = wc * 32 + 8 * fq, col0 = (u.pn % tiles) * 128 + cin;
        float sg[8], su[8];
        { const f32x4 a0 = *(const f32x4*)(SB + (size_t)u.pn * 256 + cin), a1 = *(const f32x4*)(SB + (size_t)u.pn * 256 + cin + 4), b0 = *(const f32x4*)(SB + (size_t)u.pn * 256 + 128 + cin), b1 = *(const f32x4*)(SB + (size_t)u.pn * 256 + 128 + cin + 4);
          sg[0] = a0.x; sg[1] = a0.y; sg[2] = a0.z; sg[3] = a0.w; sg[4] = a1.x; sg[5] = a1.y; sg[6] = a1.z; sg[7] = a1.w; su[0] = b0.x; su[1] = b0.y; su[2] = b0.z; su[3] = b0.w; su[4] = b1.x; su[5] = b1.y; su[6] = b1.z; su[7] = b1.w; }
        float sa[2][4];
#pragma unroll
        for (int ai = 0; ai < 2; ++ai)
#pragma unroll
            for (int m = 0; m < 4; ++m) sa[ai][m] = SA[arow0 + ai * 128 + m * 16];
#pragma unroll
        for (int ai = 0; ai < 2; ++ai)
#pragma unroll
            for (int m = 0; m < 4; ++m) {
                const pg8::i32x4 g0 = acc[ai][0][m][0], g1 = acc[ai][0][m][1], u0 = acc[ai][1][m][0], u1 = acc[ai][1][m][1]; const float s = sa[ai][m];
                float o[8];
#pragma unroll
                for (int j = 0; j < 4; ++j) { o[j] = silu_f((float)g0[j] * (s * sg[j])) * ((float)u0[j] * (s * su[j])); o[4 + j] = silu_f((float)g1[j] * (s * sg[4 + j])) * ((float)u1[j] * (s * su[4 + j])); }
                v4u w; w.x = pk2(o[0], o[1]); w.y = pk2(o[2], o[3]); w.z = pk2(o[4], o[5]); w.w = pk2(o[6], o[7]);
                *(v4u*)(ACT + (size_t)(row0 + ai * 128 + m * 16) * ldc + col0) = w;
            }
    }
};
struct EpiMoeOut {
    static constexpr bool PERM = true, AFTER_DRAIN = false, I8 = false;
    bf16* Y; const float* GW; int pm_off;
    __device__ __forceinline__ void operator()(const pg8::f32x4 (&acc)[2][2][4][2], const Unit& u, int wr, int wc, int fr, int fq) const {
        const int row0 = (u.pm + pm_off) * 256 + wr * 64 + fr, col0 = (u.pn & 3) * 256 + wc * 32 + 8 * fq;
        float gwv[2][4];
#pragma unroll
        for (int ai = 0; ai < 2; ++ai)
#pragma unroll
            for (int m = 0; m < 4; ++m) gwv[ai][m] = GW[row0 + ai * 128 + m * 16];
#pragma unroll
        for (int ai = 0; ai < 2; ++ai)
#pragma unroll
            for (int m = 0; m < 4; ++m) { const int row = row0 + ai * 128 + m * 16; const float gw = gwv[ai][m];
#pragma unroll
                for (int bj = 0; bj < 2; ++bj) { const pg8::f32x4 v0 = acc[ai][bj][m][0] * gw, v1 = acc[ai][bj][m][1] * gw;
                    v4u w; w.x = pk2(v0[0], v0[1]); w.y = pk2(v0[2], v0[3]); w.z = pk2(v1[0], v1[1]); w.w = pk2(v1[2], v1[3]);
                    *(v4u*)(Y + (size_t)row * D + col0 + bj * 128) = w; } }
    }
};
struct MoeOrder {
    int nM, nN, nwg, G, c, pan0, a_local, nb, keep; int pb[8];
    __device__ __forceinline__ void init(int nM_, int nN_, int G_, int c_, int pan0_, int a_local_) { nM = nM_; nN = nN_; nwg = nM * nN; G = G_; c = c_; pan0 = pan0_; a_local = a_local_; nb = 0; keep = 4; }
    __device__ __forceinline__ bool next(int i, Unit& u) const {
        long L = (long)i * G + c;
        if (nb > 0) { const int rounds = (nwg + G - 1) / G;
            if (c < nb) { if (i >= keep) return false; }
            else if (i >= rounds) { const int e = c - nb + (i - rounds) * (G - nb); if (e >= (rounds - keep) * nb) return false; L = (long)(keep + e / nb) * G + (e % nb); } }
        if (L >= nwg) return false;
        int wgid = (int)L; { const int q = nwg / 8, r = nwg % 8, xcd = wgid % 8, off = wgid / 8; wgid = (xcd < r ? xcd * (q + 1) : r * (q + 1) + (xcd - r) * q) + off; }
        const int nig = 8 * nN, gid = wgid / nig, fm = gid * 8, gsz = (nM - fm) < 8 ? (nM - fm) : 8;
        const int pml = fm + ((wgid % nig) % gsz), pnl = (wgid % nig) / gsz, gp = pan0 + pml;
        int e = 0;
#pragma unroll
        for (int j = 1; j < 8; ++j) e += (gp >= pb[j]) ? 1 : 0;
        u.pm = a_local ? pml : gp; u.pn = e * nN + pnl; return true;
    }
    __device__ __forceinline__ void a_ready(const Unit&) const {}
    __device__ __forceinline__ void done(const Unit&) const {}
};


#if defined(PROBE_EXTRA)
        struct EpiNull { static constexpr bool PERM = true, AFTER_DRAIN = false, I8 = false; float* sink;
            __device__ __forceinline__ void operator()(const pg8::f32x4 (&acc)[2][2][4][2], const Unit& u, int wr, int wc, int fr, int fq) const { float s = 0.f;
#pragma unroll
                for (int a = 0; a < 2; ++a)
#pragma unroll
                    for (int b = 0; b < 2; ++b)
#pragma unroll
                        for (int mm = 0; mm < 4; ++mm)
#pragma unroll
                            for (int n = 0; n < 2; ++n) s += acc[a][b][mm][n][0] + acc[a][b][mm][n][1] + acc[a][b][mm][n][2] + acc[a][b][mm][n][3];
                if (s == 123456.789f) sink[threadIdx.x] = s; } };
        struct SameOrder : pg8::StaticOrder { int same; __device__ __forceinline__ bool next(int i, Unit& u) const { const bool r = pg8::StaticOrder::next(i, u); if (same) { u.pm = 0; u.pn = 0; } return r; } };

#endif
struct Args { const float* in[23]; float* out; unsigned char* ws; int ph_lo, ph_hi; };
typedef const __attribute__((address_space(4))) Args* KA;
__device__ __forceinline__ KA kargs() { KA p = (KA)__builtin_amdgcn_kernarg_segment_ptr(); asm volatile("" : "+s"(p)); return p; }
enum { I_X = 0, I_C, I_CTX, I_CCTX, I_WMOD, I_BMOD, I_N1G, I_N2G, I_WIN, I_GW2, I_GB, I_GLAG, I_HGG, I_HLB, I_WOUT, I_F1, I_F3, I_F2, I_ROUTER, I_M1, I_M3, I_M2, I_FNG };

__device__ __forceinline__ void tr_block(const float* W, int ldw, int col0, int k0, bf16* WT, int K, int drow0, LAS float* scr, int lane) {
    f32x4 v[8]; const int lr = lane >> 3, lc = 4 * (lane & 7);
#pragma unroll
    for (int i = 0; i < 8; ++i) v[i] = *(const f32x4*)(W + (size_t)(k0 + 8 * i + lr) * ldw + col0 + lc);
#pragma unroll
    for (int i = 0; i < 8; ++i) { LAS float* s = scr + (8 * i + lr) * 33 + lc; s[0] = v[i].x; s[1] = v[i].y; s[2] = v[i].z; s[3] = v[i].w; }
    LDS_WAIT(); asm volatile("" ::: "memory");
    const int c = lane & 7;
#pragma unroll
    for (int j = 0; j < 4; ++j) { const int n = (lane >> 3) + 8 * j; const LAS float* s = scr + (8 * c) * 33 + n;
        v4u o; o.x = pk2(s[0 * 33], s[1 * 33]); o.y = pk2(s[2 * 33], s[3 * 33]); o.z = pk2(s[4 * 33], s[5 * 33]); o.w = pk2(s[6 * 33], s[7 * 33]);
        *(v4u*)(WT + (size_t)(drow0 + n) * K + k0 + 8 * c) = o; }
    LDS_WAIT(); asm volatile("" ::: "memory");
}

__device__ __forceinline__ void tr_block_q(const float* W, int ldw, int col0, int k0, signed char* WQ, int K, int drow0, const float* sc, LAS float* scr, int lane) {
    f32x4 v[8]; const int lr = lane >> 3, lc = 4 * (lane & 7);
#pragma unroll
    for (int i = 0; i < 8; ++i) v[i] = *(const f32x4*)(W + (size_t)(k0 + 8 * i + lr) * ldw + col0 + lc);
#pragma unroll
    for (int i = 0; i < 8; ++i) { LAS float* s = scr + (8 * i + lr) * 33 + lc; s[0] = v[i].x; s[1] = v[i].y; s[2] = v[i].z; s[3] = v[i].w; }
    LDS_WAIT(); asm volatile("" ::: "memory");
    const int c = lane & 7;
#pragma unroll
    for (int j = 0; j < 4; ++j) { const int n = (lane >> 3) + 8 * j; const LAS float* s = scr + (8 * c) * 33 + n; const float inv = __builtin_amdgcn_rcpf(sc[drow0 + n]);
        int q[8];
#pragma unroll
        for (int e = 0; e < 8; ++e) { const float t = fminf(fmaxf(__builtin_rintf(s[e * 33] * inv), -127.f), 127.f); q[e] = (int)t & 255; }
        v2u o; o.x = (unsigned)q[0] | ((unsigned)q[1] << 8) | ((unsigned)q[2] << 16) | ((unsigned)q[3] << 24); o.y = (unsigned)q[4] | ((unsigned)q[5] << 8) | ((unsigned)q[6] << 16) | ((unsigned)q[7] << 24);
        *(v2u*)(WQ + (size_t)(drow0 + n) * K + k0 + 8 * c) = o; }
    LDS_WAIT(); asm volatile("" ::: "memory");
}

__device__ __forceinline__ void colmax_rows_item(KA a, int it, int tid) {
    const int e = it >> 5, which = (it >> 4) & 1, rb = it & 15;
    const float* W = (which ? a->in[I_M3] : a->in[I_M1]) + (size_t)e * 1024 * DEXP + (size_t)(64 * rb) * DEXP + tid;
    float mx[7];
#pragma unroll
    for (int j = 0; j < 7; ++j) mx[j] = 0.f;
    for (int r = 0; r < 64; r += 4) { float w[4][7];
#pragma unroll
        for (int i = 0; i < 4; ++i)
#pragma unroll
            for (int j = 0; j < 7; ++j) w[i][j] = W[(size_t)(r + i) * DEXP + 512 * j];
#pragma unroll
        for (int i = 0; i < 4; ++i)
#pragma unroll
            for (int j = 0; j < 7; ++j) mx[j] = fmaxf(mx[j], fabsf(w[i][j])); }
    unsigned* cm = (unsigned*)(a->ws + WS_CTL) + CW_CM + (e * 2 + which) * DEXP + tid;
#pragma unroll
    for (int j = 0; j < 7; ++j) atomicMax(cm + 512 * j, __builtin_bit_cast(unsigned, mx[j]));
}
__device__ __forceinline__ void colscale_item(KA a, int it, LAS unsigned char* lds, int tid, int lane, int wave) {
    LAS float* red = (LAS float*)lds;
    const int e = it / 112, r = it % 112, which = r / 56, g = r % 56;
    const float* W = (which ? a->in[I_M3] : a->in[I_M1]) + (size_t)e * 1024 * DEXP + 64 * g + lane;
    float mx = 0.f;
    for (int k0 = wave * 128; k0 < wave * 128 + 128; k0 += 32) { float w[32];
#pragma unroll
        for (int i = 0; i < 32; ++i) w[i] = W[(size_t)(k0 + i) * DEXP];
#pragma unroll
        for (int i = 0; i < 32; ++i) mx = fmaxf(mx, fabsf(w[i])); }
    red[wave * 64 + lane] = mx;
    __syncthreads();
    if (tid < 64) { float m = red[tid];
#pragma unroll
        for (int w = 1; w < 8; ++w) m = fmaxf(m, red[w * 64 + tid]);
        ((float*)(a->ws + WS_SB13))[(size_t)e * 7168 + 256 * (g >> 1) + 128 * which + 64 * (g & 1) + tid] = fmaxf(m, 1e-30f) * (1.f / 127.f); }
    __syncthreads();
}

__device__ __forceinline__ void colscale32(const float* W, int ldw, int K, int col0, float* dst, LAS unsigned char* lds, int tid, int lane, int wave) {
    LAS float* red = (LAS float*)lds; const int c = lane & 31, rh = lane >> 5; const float* p = W + (size_t)(wave * (K / 8) + rh) * ldw + col0 + c;
    float mx = 0.f;
    for (int k0 = 0; k0 < K / 16; k0 += 32) { float w[32];
#pragma unroll
        for (int i = 0; i < 32; ++i) w[i] = p[(size_t)(2 * (k0 + i)) * ldw];
#pragma unroll
        for (int i = 0; i < 32; ++i) mx = fmaxf(mx, fabsf(w[i])); }
    red[(wave * 2 + rh) * 32 + c] = mx;
    __syncthreads();
    if (tid < 32) { float m = red[tid];
#pragma unroll
        for (int w = 1; w < 16; ++w) m = fmaxf(m, red[w * 32 + tid]);
        dst[tid] = fmaxf(m, 1e-30f) * (1.f / 127.f); }
    __syncthreads();
}
constexpr int NS_WIN = 2 * 129, NS_F13 = 2 * 88, NS_WOUT = 2 * 32, NS_MAIN = NS_WIN + NS_F13;
__device__ __forceinline__ void colscale_item_main(KA a, int it, LAS unsigned char* lds, int tid, int lane, int wave) {
    unsigned char* ws = a->ws;
    if (it < NS_WIN) { const int l = it / 129, nb = it % 129; if (nb == 48) return; const int drow = nb < 48 ? 32 * nb : 32 * (nb - 1);
        colscale32(a->in[I_WIN] + (size_t)l * 1024 * INW, INW, 1024, 32 * nb, (float*)(ws + WS_SBIN) + l * 4096 + drow, lds, tid, lane, wave); return; }
    it -= NS_WIN;
    if (it < NS_F13) { const int which = it / 88, c = 32 * (it % 88); colscale32(which ? a->in[I_F3] : a->in[I_F1], DFF, 1024, c, (float*)(ws + WS_SBF) + 256 * (c >> 7) + 128 * which + (c & 127), lds, tid, lane, wave); return; }
    it -= NS_F13;
    { const int l = it / 32, nb = it % 32; colscale32(a->in[I_WOUT] + (size_t)l * 1024 * 1024, 1024, 1024, 32 * nb, (float*)(ws + WS_SBO) + l * 1024 + 32 * nb, lds, tid, lane, wave); }
}
constexpr int NQ_WIN = 2 * 16 * 129, NQ_F13 = 16 * 176, NQ_WOUT = 2 * 16 * 32, NQ_MAIN = NQ_WIN + NQ_F13;
__device__ __forceinline__ void conv_item_q(KA a, int it, LAS float* scr, int lane) {
    unsigned char* ws = a->ws;
    if (it < NQ_WIN) { const int l = it / 2064, r = it % 2064, kb = r / 129, nb = r % 129; if (nb == 48) return; const int drow = nb < 48 ? 32 * nb : 32 * (nb - 1);
        tr_block_q(a->in[I_WIN] + (size_t)l * 1024 * INW, INW, 32 * nb, 64 * kb, (signed char*)(ws + WS_WINQ) + (size_t)l * 4096 * 1024, 1024, drow, (const float*)(ws + WS_SBIN) + l * 4096, scr, lane); return; }
    it -= NQ_WIN;
    if (it < NQ_F13) { const int kb = it / 176, db = it % 176, drow = 32 * db, pn = drow >> 8, half = (drow >> 7) & 1, off = drow & 127;
        tr_block_q(half ? a->in[I_F3] : a->in[I_F1], DFF, 128 * pn + off, 64 * kb, (signed char*)(ws + WS_F13), 1024, drow, (const float*)(ws + WS_SBF), scr, lane); return; }
    it -= NQ_F13;
    { const int l = it / 512, r = it % 512, kb = r / 32, nb = r % 32;
      tr_block_q(a->in[I_WOUT] + (size_t)l * 1024 * 1024, 1024, 32 * nb, 64 * kb, (signed char*)(ws + WS_WOUT) + (size_t)l * 1024 * 1024, 1024, 32 * nb, (const float*)(ws + WS_SBO) + l * 1024, scr, lane); }
}
__device__ __forceinline__ void quant_row(const f32x4 (&y)[4], unsigned* qrow, float* srow, int lane) {
    float am = 0.f;
#pragma unroll
    for (int j = 0; j < 4; ++j) am = fmaxf(fmaxf(am, fmaxf(fabsf(y[j].x), fabsf(y[j].y))), fmaxf(fabsf(y[j].z), fabsf(y[j].w)));
#pragma unroll
    for (int o = 1; o < 64; o <<= 1) am = fmaxf(am, __shfl_xor(am, o));
    am = fmaxf(am, 1e-30f); const float inv = 127.f / am;
#pragma unroll
    for (int j = 0; j < 4; ++j) { const int q0 = (int)__builtin_rintf(y[j].x * inv), q1 = (int)__builtin_rintf(y[j].y * inv), q2 = (int)__builtin_rintf(y[j].z * inv), q3 = (int)__builtin_rintf(y[j].w * inv);
        qrow[lane + 64 * j] = (unsigned)(q0 & 255) | ((unsigned)(q1 & 255) << 8) | ((unsigned)(q2 & 255) << 16) | ((unsigned)(q3 & 255) << 24); }
    if (lane == 0) *srow = am * (1.f / 127.f);
}
constexpr int NI_F2 = 44 * 32, NI_MAIN = 32 + 2 * 512 + NI_F2;
constexpr int NI_M13E = 16 * 224, NI_M2E = 56 * 32, NI_M13 = 8 * NI_M13E, NI_MOE = NI_M13 + 8 * NI_M2E;
__device__ __forceinline__ void conv_item_main(KA a, int it, LAS float* scr, int lane) {
    unsigned char* ws = a->ws;
    if (it < 32) { const int l = it / 16, kb = it % 16; tr_block(a->in[I_WIN] + (size_t)l * 1024 * INW, INW, 1536, 64 * kb, (bf16*)(ws + WS_WIN) + (size_t)l * 32 * 1024, 1024, 0, scr, lane); return; }
    it -= 32;
    if (it < 2 * 512) { const int l = it / 512, r = it % 512, kb = r / 32, nb = r % 32; tr_block(a->in[I_WOUT] + (size_t)l * 1024 * 1024, 1024, 32 * nb, 64 * kb, (bf16*)(ws + WS_WOUT) + (size_t)l * 1024 * 1024, 1024, 32 * nb, scr, lane); return; }
    it -= 2 * 512;
    { const int kb = it / 32, nb = it % 32; tr_block(a->in[I_F2], 1024, 32 * nb, 64 * kb, (bf16*)(ws + WS_F2), DFF, 32 * nb, scr, lane); }
}
__device__ __forceinline__ void conv_item_moe(KA a, int it, LAS float* scr, int lane) {
    unsigned char* ws = a->ws;
    if (it < NI_M13) { const int e = it / NI_M13E, r = it % NI_M13E, kb = r / 224, db = r % 224, drow = 32 * db, pn = drow >> 8, half = (drow >> 7) & 1, off = drow & 127;
        tr_block_q((half ? a->in[I_M3] : a->in[I_M1]) + (size_t)e * 1024 * DEXP, DEXP, 128 * pn + off, 64 * kb, (signed char*)a->out + DO_M13Q + (size_t)e * 7168 * 1024, 1024, drow, (const float*)(ws + WS_SB13) + (size_t)e * 7168, scr, lane); return; }
    it -= NI_M13;
    { const int e = it / NI_M2E, r = it % NI_M2E, kb = r / 32, nb = r % 32;
      tr_block(a->in[I_M2] + (size_t)e * DEXP * 1024, 1024, 32 * nb, 64 * kb, (bf16*)((unsigned char*)a->out + DO_M2) + (size_t)e * 1024 * DEXP, DEXP, 32 * nb, scr, lane); }
}
__device__ __forceinline__ void mod_item(KA a, int it, LAS unsigned char* lds, int tid, int lane, int wave) {
    LAS float* sc = (LAS float*)lds; LAS float* red = (LAS float*)(lds + 69632);
    const int l = it / 96, n0 = 64 * (it % 96);
    for (int idx = tid; idx < 17 * 1024; idx += NTHR) { const int r = idx >> 10, k = idx & 1023; const float v = r < 16 ? a->in[I_C][r * 1024 + k] : a->in[I_CCTX][k]; sc[k * 17 + r] = silu_f(v); }
    __syncthreads();
    float acc[17];
#pragma unroll
    for (int r = 0; r < 17; ++r) acc[r] = 0.f;
    const float* wm = a->in[I_WMOD] + (size_t)l * 1024 * 6144 + n0 + lane;
    for (int k0 = wave * 128; k0 < wave * 128 + 128; k0 += 32) { float w[32];
#pragma unroll
        for (int i = 0; i < 32; ++i) w[i] = wm[(size_t)(k0 + i) * 6144];
#pragma unroll
        for (int i = 0; i < 32; ++i)
#pragma unroll
            for (int r = 0; r < 17; ++r) acc[r] += sc[(k0 + i) * 17 + r] * w[i]; }
#pragma unroll
    for (int r = 0; r < 17; ++r) red[(wave * 17 + r) * 64 + lane] = acc[r];
    __syncthreads();
    float* mods = (float*)(a->ws + WS_MODS);
    for (int idx = tid; idx < 17 * 64; idx += NTHR) { const int r = idx >> 6, ln = idx & 63; float s = a->in[I_BMOD][l * 6144 + n0 + ln];
#pragma unroll
        for (int w = 0; w < 8; ++w) s += red[(w * 17 + r) * 64 + ln];
        if (r < 16) mods[MO_LAT + (l * 16 + r) * 6144 + n0 + ln] = s; else mods[MO_CTX + l * 6144 + n0 + ln] = s; }
    __syncthreads();
}
__device__ __forceinline__ void ada_norm_row(const float* xrow, bf16* orow, const float* g, const float* shift, const float* scale, int lane, f32x4 (&y)[4]) {
    const f32x4* xr = (const f32x4*)xrow + lane; float s = 0.f;
#pragma unroll
    for (int j = 0; j < 4; ++j) { y[j] = xr[64 * j]; s += (y[j].x * y[j].x + y[j].y * y[j].y) + (y[j].z * y[j].z + y[j].w * y[j].w); }
    const float rstd = rsqrtf(wave_sum(s) * (1.f / D) + EPS);
    v2u* o8 = (v2u*)orow + lane;
#pragma unroll
    for (int j = 0; j < 4; ++j) { const f32x4 gv = ((const f32x4*)g)[lane + 64 * j], sh = ((const f32x4*)shift)[lane + 64 * j], sc = ((const f32x4*)scale)[lane + 64 * j];
        y[j] = y[j] * rstd * gv * (sc + 1.f) + sh; v2u w; w.x = pk2(y[j].x, y[j].y); w.y = pk2(y[j].z, y[j].w); o8[64 * j] = w; }
}
__device__ __forceinline__ int scan_row(int grp, int b, int dir, int step) {
    if (step < CTXL) { const int t = dir ? (CTXL - 1 - step) : step; return ML + b * CTXL + t; }
    int lp = step - CTXL; if (dir) lp = SEQ - 1 - lp;
    const int t = grp ? ((lp & 31) * 64 + (lp >> 5)) : lp;
    return b * SEQ + t;
}
template <int DK> __device__ __forceinline__ void scan_simple(LAS unsigned char* lds, const bf16* P, const bf16* GR, const float* w2, const float* gb, bf16* OUT, int grp, int b, int hd, int dir, int tid) {
    LAS float* qs = (LAS float*)lds; LAS float* ks = qs + 32 * 128; LAS float* fs = ks + 32 * 128; LAS float* vs = fs + 32 * 128; LAS float* red = vs + 32 * 128;
    const int j = tid & 127, cg = tid >> 7; constexpr int CPT = DK / 4;
    float st[CPT];
#pragma unroll
    for (int i = 0; i < CPT; ++i) st[i] = 0.f;
    for (int blk = 0; blk < (CTXL + SEQ) / 32; ++blk) {
        for (int idx = tid; idx < 32 * DK; idx += NTHR) { const int t = idx / DK, c = idx % DK, row = scan_row(grp, b, dir, blk * 32 + t); const bf16* pr = P + (size_t)row * PW; float q, k, lf;
            if (DK == 64) { q = bf2f(pr[hd * 64 + c]); k = bf2f(pr[256 + hd * 64 + c]); float lg = gb[hd * 64 + c]; const bf16* gr = GR + (size_t)row * 32 + dir * 16;
#pragma unroll
                for (int r = 0; r < 16; ++r) lg += bf2f(gr[r]) * w2[r * 256 + hd * 64 + c];
                lf = logsig_f(lg) * (1.f / 16.f); }
            else { q = bf2f(pr[1024 + hd * 128 + c]); k = bf2f(pr[(dir ? 2560 : 1536) + hd * 128 + c]); lf = bf2f(pr[(dir ? 3072 : 2048) + hd * 128 + c]); }
            qs[t * 128 + c] = q; ks[t * 128 + c] = k; fs[t * 128 + c] = __expf(lf); }
        for (int idx = tid; idx < 32 * 128; idx += NTHR) { const int t = idx >> 7, jj = idx & 127, row = scan_row(grp, b, dir, blk * 32 + t); vs[idx] = bf2f(P[(size_t)row * PW + (DK == 64 ? 512 : 3584) + hd * 128 + jj]); }
        __syncthreads();
        for (int t = 0; t < 32; ++t) { const float vv = vs[t * 128 + j]; float acc = 0.f;
#pragma unroll
            for (int i = 0; i < CPT; ++i) { const int c = cg * CPT + i; st[i] = st[i] * fs[t * 128 + c] + ks[t * 128 + c] * vv; acc += st[i] * qs[t * 128 + c]; }
            red[(t * 4 + cg) * 128 + j] = acc; }
        __syncthreads();
        for (int idx = tid; idx < 4096; idx += NTHR) { const int t = idx >> 7, jj = idx & 127, row = scan_row(grp, b, dir, blk * 32 + t);
            const float o = (red[(t * 4 + 0) * 128 + jj] + red[(t * 4 + 1) * 128 + jj]) + (red[(t * 4 + 2) * 128 + jj] + red[(t * 4 + 3) * 128 + jj]);
            OUT[(size_t)row * D + grp * 512 + hd * 128 + jj] = (bf16)f2bf(o); }
        __syncthreads();
    }
}
__device__ __forceinline__ void mix_row(const bf16* of, const bf16* ob, const bf16* gate, const float* gla_g, const float* hg_g, bf16* out, int lane) {
    const v4u* pf = (const v4u*)of + 2 * lane; const v4u* pb = (const v4u*)ob + 2 * lane; const v4u* pg = (const v4u*)gate + 2 * lane;
    const v4u f0 = pf[0], f1 = pf[1], b0 = pb[0], b1 = pb[1], g0 = pg[0], g1 = pg[1];
    const unsigned fw[8] = {f0.x, f0.y, f0.z, f0.w, f1.x, f1.y, f1.z, f1.w}, bw[8] = {b0.x, b0.y, b0.z, b0.w, b1.x, b1.y, b1.z, b1.w}, gw[8] = {g0.x, g0.y, g0.z, g0.w, g1.x, g1.y, g1.z, g1.w};
    float o[16]; float ss = 0.f;
#pragma unroll
    for (int i = 0; i < 8; ++i) { o[2 * i] = bflo(fw[i]) + bflo(bw[i]); o[2 * i + 1] = bfhi(fw[i]) + bfhi(bw[i]); ss += o[2 * i] * o[2 * i] + o[2 * i + 1] * o[2 * i + 1]; }
    ss += __shfl_xor(ss, 1); ss += __shfl_xor(ss, 2); ss += __shfl_xor(ss, 4);
    const float rstd = rsqrtf(ss * (1.f / 128.f) + EPS);
    const float* ng = ((lane >> 5) ? hg_g : gla_g) + (lane & 7) * 16;
    unsigned w[8];
#pragma unroll
    for (int i = 0; i < 8; ++i) { const float a = o[2 * i] * rstd * ng[2 * i] * silu_f(bflo(gw[i])), c = o[2 * i + 1] * rstd * ng[2 * i + 1] * silu_f(bfhi(gw[i])); w[i] = pk2(a, c); }
    v4u* po = (v4u*)out + 2 * lane; po[0] = (v4u){w[0], w[1], w[2], w[3]}; po[1] = (v4u){w[4], w[5], w[6], w[7]};
}

__device__ __forceinline__ void xload(const float* xrow, int lane, f32x4 (&y)[4]) {
    const f32x4* xr = (const f32x4*)xrow + lane;
#pragma unroll
    for (int j = 0; j < 4; ++j) y[j] = xr[64 * j];
}
__device__ __forceinline__ void xloadb(const bf16* xrow, int lane, v2u (&r)[4]) {
    const v2u* xr = (const v2u*)xrow + lane;
#pragma unroll
    for (int j = 0; j < 4; ++j) r[j] = xr[64 * j];
}
__device__ __forceinline__ void xcvt(const v2u (&r)[4], f32x4 (&y)[4]) {
#pragma unroll
    for (int j = 0; j < 4; ++j) y[j] = (f32x4){bflo(r[j].x), bfhi(r[j].x), bflo(r[j].y), bfhi(r[j].y)};
}
__device__ __forceinline__ void norm_finish(bf16* orow, const float* g, const float* shift, const float* scale, int lane, f32x4 (&y)[4]) {
    float s = 0.f;
#pragma unroll
    for (int j = 0; j < 4; ++j) s += (y[j].x * y[j].x + y[j].y * y[j].y) + (y[j].z * y[j].z + y[j].w * y[j].w);
    const float rstd = rsqrtf(wave_sum(s) * (1.f / D) + EPS);
    v2u* o8 = (v2u*)orow + lane;
#pragma unroll
    for (int j = 0; j < 4; ++j) { const f32x4 gv = ((const f32x4*)g)[lane + 64 * j], sh = ((const f32x4*)shift)[lane + 64 * j], sc = ((const f32x4*)scale)[lane + 64 * j];
        y[j] = y[j] * rstd * gv * (sc + 1.f) + sh; v2u w; w.x = pk2(y[j].x, y[j].y); w.y = pk2(y[j].z, y[j].w); o8[64 * j] = w; }
}
__device__ __forceinline__ void norm_finish_q(unsigned* qrow, float* srow, const float* g, const float* shift, const float* scale, int lane, f32x4 (&y)[4]) {
    float s = 0.f;
#pragma unroll
    for (int j = 0; j < 4; ++j) s += (y[j].x * y[j].x + y[j].y * y[j].y) + (y[j].z * y[j].z + y[j].w * y[j].w);
    const float rstd = rsqrtf(wave_sum(s) * (1.f / D) + EPS);
#pragma unroll
    for (int j = 0; j < 4; ++j) { const f32x4 gv = ((const f32x4*)g)[lane + 64 * j], sh = ((const f32x4*)shift)[lane + 64 * j], sc = ((const f32x4*)scale)[lane + 64 * j]; y[j] = y[j] * rstd * gv * (sc + 1.f) + sh; }
    quant_row(y, qrow, srow, lane);
}
struct MixIn { v4u f0, f1, b0, b1, g0, g1; };
__device__ __forceinline__ void mix_load(const bf16* of, const bf16* ob, const bf16* gate, int lane, MixIn& r) {
    const v4u* pf = (const v4u*)of + 2 * lane; const v4u* pb = (const v4u*)ob + 2 * lane; const v4u* pg = (const v4u*)gate + 2 * lane;
    r.f0 = pf[0]; r.f1 = pf[1]; r.b0 = pb[0]; r.b1 = pb[1]; r.g0 = pg[0]; r.g1 = pg[1];
}
__device__ __forceinline__ void mix_finish(const MixIn& r, const float* gla_g, const float* hg_g, signed char* out, float* srow, int lane) {
    const unsigned fw[8] = {r.f0.x, r.f0.y, r.f0.z, r.f0.w, r.f1.x, r.f1.y, r.f1.z, r.f1.w}, bw[8] = {r.b0.x, r.b0.y, r.b0.z, r.b0.w, r.b1.x, r.b1.y, r.b1.z, r.b1.w}, gw[8] = {r.g0.x, r.g0.y, r.g0.z, r.g0.w, r.g1.x, r.g1.y, r.g1.z, r.g1.w};
    float o[16]; float ss = 0.f;
#pragma unroll
    for (int i = 0; i < 8; ++i) { o[2 * i] = bflo(fw[i]) + bflo(bw[i]); o[2 * i + 1] = bfhi(fw[i]) + bfhi(bw[i]); ss += o[2 * i] * o[2 * i] + o[2 * i + 1] * o[2 * i + 1]; }
    ss += __shfl_xor(ss, 1); ss += __shfl_xor(ss, 2); ss += __shfl_xor(ss, 4);
    const float rstd = rsqrtf(ss * (1.f / 128.f) + EPS);
    const float* ng = ((lane >> 5) ? hg_g : gla_g) + (lane & 7) * 16;
    float mv[16]; float am = 0.f;
#pragma unroll
    for (int i = 0; i < 8; ++i) { mv[2 * i] = o[2 * i] * rstd * ng[2 * i] * silu_f(bflo(gw[i])); mv[2 * i + 1] = o[2 * i + 1] * rstd * ng[2 * i + 1] * silu_f(bfhi(gw[i])); am = fmaxf(am, fmaxf(fabsf(mv[2 * i]), fabsf(mv[2 * i + 1]))); }
#pragma unroll
    for (int of = 1; of < 64; of <<= 1) am = fmaxf(am, __shfl_xor(am, of));
    am = fmaxf(am, 1e-30f); const float inv = 127.f / am; unsigned w[4];
#pragma unroll
    for (int i = 0; i < 4; ++i) { const int q0 = (int)__builtin_rintf(mv[4 * i] * inv), q1 = (int)__builtin_rintf(mv[4 * i + 1] * inv), q2 = (int)__builtin_rintf(mv[4 * i + 2] * inv), q3 = (int)__builtin_rintf(mv[4 * i + 3] * inv);
        w[i] = (unsigned)(q0 & 255) | ((unsigned)(q1 & 255) << 8) | ((unsigned)(q2 & 255) << 16) | ((unsigned)(q3 & 255) << 24); }
    ((v4u*)out)[lane] = (v4u){w[0], w[1], w[2], w[3]};
    if (lane == 0) *srow = am * (1.f / 127.f);
}
__device__ __forceinline__ void mix_finish_bf(const MixIn& r, const float* gla_g, const float* hg_g, bf16* out, int lane) {
    const unsigned fw[8] = {r.f0.x, r.f0.y, r.f0.z, r.f0.w, r.f1.x, r.f1.y, r.f1.z, r.f1.w}, bw[8] = {r.b0.x, r.b0.y, r.b0.z, r.b0.w, r.b1.x, r.b1.y, r.b1.z, r.b1.w}, gw[8] = {r.g0.x, r.g0.y, r.g0.z, r.g0.w, r.g1.x, r.g1.y, r.g1.z, r.g1.w};
    float o[16]; float ss = 0.f;
#pragma unroll
    for (int i = 0; i < 8; ++i) { o[2 * i] = bflo(fw[i]) + bflo(bw[i]); o[2 * i + 1] = bfhi(fw[i]) + bfhi(bw[i]); ss += o[2 * i] * o[2 * i] + o[2 * i + 1] * o[2 * i + 1]; }
    ss += __shfl_xor(ss, 1); ss += __shfl_xor(ss, 2); ss += __shfl_xor(ss, 4);
    const float rstd = rsqrtf(ss * (1.f / 128.f) + EPS);
    const float* ng = ((lane >> 5) ? hg_g : gla_g) + (lane & 7) * 16;
    unsigned w[8];
#pragma unroll
    for (int i = 0; i < 8; ++i) { const float a = o[2 * i] * rstd * ng[2 * i] * silu_f(bflo(gw[i])), c = o[2 * i + 1] * rstd * ng[2 * i + 1] * silu_f(bfhi(gw[i])); w[i] = pk2(a, c); }
    v4u* po = (v4u*)out + 2 * lane; po[0] = (v4u){w[0], w[1], w[2], w[3]}; po[1] = (v4u){w[4], w[5], w[6], w[7]};
}
template <bool ATOMIC> __device__ __forceinline__ void moe_tab(KA a, LAS unsigned char* lds, int tid, int wg) {
    LAS int* tab = (LAS int*)(lds + TAB_OFF);
    if (tid < 32) tab[tid] = 0;
    __syncthreads();
    if (tid < 256) { int c[8];
        if constexpr (ATOMIC) {
#pragma unroll
            for (int e = 0; e < 8; ++e) c[e] = __hip_atomic_load((int*)(a->ws + WS_ROUTE + RT_CNT) + 8 * tid + e, __ATOMIC_RELAXED, __HIP_MEMORY_SCOPE_AGENT); }
        else { const v4i* cp = (const v4i*)(a->ws + WS_ROUTE + RT_CNT) + 2 * tid; const v4i c0 = cp[0], c1 = cp[1]; c[0] = c0.x; c[1] = c0.y; c[2] = c0.z; c[3] = c0.w; c[4] = c1.x; c[5] = c1.y; c[6] = c1.z; c[7] = c1.w; }
#pragma unroll
        for (int e = 0; e < 8; ++e) { __hip_atomic_fetch_add(&tab[e], c[e], __ATOMIC_RELAXED, __HIP_MEMORY_SCOPE_WORKGROUP); if (tid < wg) __hip_atomic_fetch_add(&tab[8 + e], c[e], __ATOMIC_RELAXED, __HIP_MEMORY_SCOPE_WORKGROUP); } }
    __syncthreads();
    if (tid == 0) { int pb = 0; for (int e = 0; e < 8; ++e) { tab[16 + e] = pb; pb += (tab[e] + 255) >> 8; } tab[24] = pb; }
    __syncthreads();
}


#ifndef STAG_TICKS
#define STAG_TICKS 400
#endif
#ifndef STAG_NCLS
#define STAG_NCLS 8
#endif
__device__ __forceinline__ void stagger_start(int vc) {
    const int cls = (vc >> 3) % STAG_NCLS;
    if (cls) { const unsigned long long t0 = __builtin_amdgcn_s_memrealtime(), w = (unsigned long long)cls * STAG_TICKS; while (__builtin_amdgcn_s_memrealtime() - t0 < w) __builtin_amdgcn_s_sleep(4); }
}
typedef short bf16x8 __attribute__((ext_vector_type(8)));
typedef float f32x16 __attribute__((ext_vector_type(16)));
#define MFMA32(a, b, c) __builtin_amdgcn_mfma_f32_32x32x16_bf16((a), (b), (c), 0, 0, 0)
#define SCHED_FENCE() __builtin_amdgcn_sched_barrier(0)
__device__ __forceinline__ int perm16(int c) { return (c & ~12) | ((c & 4) << 1) | ((c & 8) >> 1); }
template <int DK> __device__ __forceinline__ int rm_swz(int t) { return (DK == 128) ? (t & 15) : ((t >> 1) & 7); }
template <int DK> __device__ __forceinline__ int rm_addr(int t, int pos) { return t * (2 * DK) + ((((pos >> 3) ^ rm_swz<DK>(t))) << 4) + ((pos & 7) << 1); }
__device__ __forceinline__ int ti_addr(int row, int tok) { return row * 64 + ((((tok >> 3) ^ ((row >> 2) & 3))) << 4) + ((tok & 7) << 1); }
constexpr int SC_IMG = 25600, SC_QI = 0, SC_KDT = 8192, SC_VT = 16384, SC_DV = 24576;
constexpr int SC_QK = 3 * SC_IMG, SC_QKSET = 16384, SC_S = SC_QK + 2 * SC_QKSET;
static_assert(SC_S + 4096 <= RING_BYTES, "scan LDS map");
constexpr int NCHUNK = (CTXL + SEQ) / 32;
constexpr float LOG2E = 1.4426950408889634f;
__device__ __forceinline__ void chunk_rows(int grp, int b, int dir, int ch, int& rbase, int& rstep) {
    if (ch < CTXL / 32) { rbase = ML + b * CTXL + (dir ? CTXL - 1 - ch * 32 : ch * 32); rstep = dir ? -1 : 1; }
    else { const int cc = ch - CTXL / 32;
        if (grp) { rbase = b * SEQ + (dir ? 31 * 64 + 63 - cc : cc); rstep = dir ? -64 : 64; }
        else { rbase = b * SEQ + (dir ? SEQ - 1 - cc * 32 : cc * 32); rstep = dir ? -1 : 1; } }
}
template <int V> struct IC { static constexpr int value = V; };
template <int DK, int DIRT> __device__ __forceinline__ void scan_mfma(LAS unsigned char* lds, const bf16* P, const bf16* GR, const float* w2, const float* gb, bf16* OUT, int grp, int b, int hd, int tid) {
    constexpr int dir = DIRT;
    const int lane = tid & 63, wave = __builtin_amdgcn_readfirstlane(tid >> 6);
    constexpr int NCP = DK / 8, NTG = 64 / NCP, TPL = 32 / NTG, NT = DK / 32, NKS = DK / 16, RP = 2 * DK;
    constexpr int BLK = (DK == 64) ? PBLK_G : PBLK_H;
    const int qcol = (DK == 64) ? 0 : 384, kcol = (DK == 64) ? 64 : (dir ? 0 : 512), lcol = dir ? 128 : 640, vcol = (DK == 64) ? 128 : 256;
    const char* Pblk = (const char*)(P + ((DK == 64) ? 0 : PH_OFF) + (size_t)(b * 4 + hd) * NPOS * BLK);
    const int ocol = grp * 512 + hd * 128;
    if (wave < 4) {
        const int sw = wave;
        f32x16 ST[NT];
#pragma unroll
        for (int T = 0; T < NT; ++T)
#pragma unroll
            for (int r = 0; r < 16; ++r) ST[T][r] = 0.f;
        for (int it = -2; it < NCHUNK; ++it) {
            if (it >= 0) {
                int i31 = lane & 31, h = lane >> 5; asm volatile("" : "+v"(i31), "+v"(h));
                const LAS unsigned char* img = lds + (it % 3) * SC_IMG; const LAS unsigned char* simg = lds + SC_S + (it & 1) * 2048;
                const int aq0 = i31 * RP + ((h ^ rm_swz<DK>(i31)) << 4);
                const int x2 = (i31 >> 2) & 3, at0 = i31 * 64 + ((h ^ x2) << 4);
                const int vrow = 32 * sw * 64;
                bf16x8 bq[NKS], va[2], sb[2], kd[NT][2]; f32x4 d4[NT][4];
#pragma unroll
                for (int ks = 0; ks < NKS; ++ks) bq[ks] = *(const LAS bf16x8*)(img + SC_QI + (aq0 ^ (ks << 5)));
#pragma unroll
                for (int s = 0; s < 2; ++s) { va[s] = *(const LAS bf16x8*)(img + SC_VT + vrow + (at0 ^ (s << 5))); sb[s] = *(const LAS bf16x8*)(simg + (at0 ^ (s << 5))); }
#pragma unroll
                for (int T = 0; T < 2; ++T) {
#pragma unroll
                    for (int g = 0; g < 4; ++g) d4[T][g] = *(const LAS f32x4*)(img + SC_DV + 16 * h + 128 * T + 32 * g);
#pragma unroll
                    for (int s = 0; s < 2; ++s) kd[T][s] = *(const LAS bf16x8*)(img + SC_KDT + 2048 * T + (at0 ^ (s << 5))); }
                SCHED_FENCE();
                f32x16 oacc;
#pragma unroll
                for (int r = 0; r < 16; ++r) oacc[r] = 0.f;
#pragma unroll
                for (int T = 0; T < NT; ++T)
#pragma unroll
                    for (int s = 0; s < 2; ++s) {
                        v4u p; p.x = cvtpk(ST[T][8 * s], ST[T][8 * s + 1]); p.y = cvtpk(ST[T][8 * s + 2], ST[T][8 * s + 3]); p.z = cvtpk(ST[T][8 * s + 4], ST[T][8 * s + 5]); p.w = cvtpk(ST[T][8 * s + 6], ST[T][8 * s + 7]);
                        oacc = MFMA32(__builtin_bit_cast(bf16x8, p), bq[2 * T + s], oacc); }
#pragma unroll
                for (int s = 0; s < 2; ++s) oacc = MFMA32(va[s], sb[s], oacc);
                SCHED_FENCE();
                if constexpr (NT == 4) {
#pragma unroll
                    for (int T = 2; T < 4; ++T) {
#pragma unroll
                        for (int g = 0; g < 4; ++g) d4[T][g] = *(const LAS f32x4*)(img + SC_DV + 16 * h + 128 * T + 32 * g);
#pragma unroll
                        for (int s = 0; s < 2; ++s) kd[T][s] = *(const LAS bf16x8*)(img + SC_KDT + 2048 * T + (at0 ^ (s << 5))); }
                }
#pragma unroll
                for (int T = 0; T < 2; ++T) {
#pragma unroll
                    for (int g = 0; g < 4; ++g) { ST[T][4 * g] *= d4[T][g].x; ST[T][4 * g + 1] *= d4[T][g].y; ST[T][4 * g + 2] *= d4[T][g].z; ST[T][4 * g + 3] *= d4[T][g].w; }
#pragma unroll
                    for (int s = 0; s < 2; ++s) ST[T] = MFMA32(kd[T][s], va[s], ST[T]); }
                SCHED_FENCE();
                { int rbase, rstep; chunk_rows(grp, b, dir, it, rbase, rstep); const int row = rbase + i31 * rstep; bf16* op = OUT + (size_t)row * D + ocol + 32 * sw + 4 * h;
#pragma unroll
                  for (int g = 0; g < 4; ++g) { v2u w; w.x = cvtpk(oacc[4 * g], oacc[4 * g + 1]); w.y = cvtpk(oacc[4 * g + 2], oacc[4 * g + 3]); *(v2u*)(op + 8 * g) = w; } }
                if constexpr (NT == 4) {
#pragma unroll
                    for (int T = 2; T < 4; ++T) {
#pragma unroll
                        for (int g = 0; g < 4; ++g) { ST[T][4 * g] *= d4[T][g].x; ST[T][4 * g + 1] *= d4[T][g].y; ST[T][4 * g + 2] *= d4[T][g].z; ST[T][4 * g + 3] *= d4[T][g].w; }
#pragma unroll
                        for (int s = 0; s < 2; ++s) ST[T] = MFMA32(kd[T][s], va[s], ST[T]); }
                }
            }
            asm volatile("s_waitcnt lgkmcnt(0)" ::: "memory"); __builtin_amdgcn_s_barrier(); asm volatile("" ::: "memory");
        }
    } else {
        const int pw = wave - 4;
        const int tg = lane / NCP, cp = lane % NCP, c0 = (DK / 4) * pw + 2 * cp, t0 = tg * TPL;
        const int pos0 = (c0 & ~15) | perm16(c0 & 15);
        const int tgv = lane >> 4, cpv = lane & 15, d0 = 32 * pw + 2 * cpv, tv0 = 8 * tgv;
        float w2r[2][16]; float gb0 = 0.f, gb1 = 0.f;
        if (DK == 64) {
#pragma unroll
            for (int r = 0; r < 16; ++r) { w2r[0][r] = w2[r * 256 + hd * 64 + c0]; w2r[1][r] = w2[r * 256 + hd * 64 + c0 + 1]; }
            gb0 = gb[hd * 64 + c0]; gb1 = gb[hd * 64 + c0 + 1];
        }
        constexpr int AHEAD = (DK == 128) ? 2 : 1;
        unsigned rq[AHEAD][TPL], rk[AHEAD][TPL], rl[AHEAD][TPL], rv[AHEAD][8]; v4u rg[AHEAD][TPL][2];
        auto load_chunk = [&](auto setc, int ch) { constexpr int SI = decltype(setc)::value;
            const int pb = dir ? ((ch < CTXL / 32) ? CTXL - 1 - 32 * ch : CTXL + SEQ - 1 - 32 * (ch - CTXL / 32)) : 32 * ch, ps = dir ? -1 : 1;
            const int stp = ps * BLK * 2;
            int o1 = ((pb + t0 * ps) * BLK + c0) * 2, o2 = ((pb + tv0 * ps) * BLK + vcol + d0) * 2;
            if constexpr (DK == 128) {
                const int oq = o1 + 2 * qcol, ok = o1 + 2 * kcol;
                static_assert(BLK * 2 * 2 <= 4095, "immediate offsets");
#define SC_LD(dst, off, IMM) asm volatile("global_load_dword %0, %1, %2 offset:" #IMM : "=v"(dst) : "v"(off), "s"(Pblk) : "memory")
#define SC_LD3(arr, base, j) do { if constexpr (DIRT != 0) { const int b_ = (base) + (7 - 3 * (j)) * stp; SC_LD(arr[SI][7 - 3 * (j)], b_, 0); SC_LD(arr[SI][6 - 3 * (j)], b_, 1536); if (5 - 3 * (j) >= 0) SC_LD(arr[SI][(5 - 3 * (j)) & 7], b_, 3072); } \
        else { const int b_ = (base) + (3 * (j)) * stp; SC_LD(arr[SI][3 * (j)], b_, 0); SC_LD(arr[SI][3 * (j) + 1], b_, 1536); if (3 * (j) + 2 < 8) SC_LD(arr[SI][(3 * (j) + 2) & 7], b_, 3072); } } while (0)
#pragma unroll
                for (int j = 0; j < 3; ++j) { SC_LD3(rq, oq, j); SC_LD3(rk, ok, j); SC_LD3(rv, o2, j); }
#undef SC_LD3
#undef SC_LD
                return;
            }
#pragma unroll
            for (int t = 0; t < TPL; ++t) {
                rq[SI][t] = *(const unsigned*)(Pblk + o1 + 2 * qcol); rk[SI][t] = *(const unsigned*)(Pblk + o1 + 2 * kcol);
                o1 += stp; }
            if (DK == 64) { int rbase, rstep; chunk_rows(grp, b, dir, ch, rbase, rstep); int o3 = ((rbase + t0 * rstep) * 32 + dir * 16) * 2; const int st3 = rstep * 64;
#pragma unroll
                for (int t = 0; t < TPL; ++t) { const v4u* gp = (const v4u*)((const char*)GR + o3); rg[SI][t][0] = gp[0]; rg[SI][t][1] = gp[1]; o3 += st3; } }
#pragma unroll
            for (int t = 0; t < 8; ++t) { rv[SI][t] = *(const unsigned*)(Pblk + o2); o2 += stp; }
        };
        load_chunk(IC<0>{}, 0); if constexpr (AHEAD == 2) load_chunk(IC<1>{}, 1);
        auto prep_step = [&](auto setc, int it) { constexpr int SI = decltype(setc)::value;
            const int cw = it + 2;
            int rm0 = t0 * RP + ((((pos0 >> 3) ^ rm_swz<DK>(t0))) << 4) + ((pos0 & 7) << 1), ti0 = ti_addr(c0, t0), ti1 = ti_addr(c0 + 1, t0), tv_0 = ti_addr(d0, tv0), tv_1 = ti_addr(d0 + 1, tv0), dvo = c0 * 4;
            if (cw < NCHUNK) {
                if constexpr (DK == 128) {
#define SC_W16(arr) "+v"(arr[SI][0]), "+v"(arr[SI][1]), "+v"(arr[SI][2]), "+v"(arr[SI][3]), "+v"(arr[SI][4]), "+v"(arr[SI][5]), "+v"(arr[SI][6]), "+v"(arr[SI][7])
                    if (cw + 1 < NCHUNK) asm volatile("s_waitcnt vmcnt(24)" ::: "memory"); else asm volatile("s_waitcnt vmcnt(0)" ::: "memory");
                    SCHED_FENCE();
                    asm volatile("" : SC_W16(rq), SC_W16(rk));
                    asm volatile("" : SC_W16(rv));
#undef SC_W16
                    SCHED_FENCE();
                }
                LAS unsigned char* img = lds + (cw % 3) * SC_IMG;
                static_assert(SC_IMG % 256 == 0 && SC_QI % 256 == 0 && SC_QK % 256 == 0 && SC_QKSET % 256 == 0, "image bases");
                const int R0q = rm0 + (cw % 3) * SC_IMG + SC_QI, R0k = rm0 + SC_QK + (cw & 1) * SC_QKSET;
                float c0v[TPL], c1v[TPL], off0, off1, cL0, cL1;
                if constexpr (DK == 64) {
                    float a0 = 0.f, a1 = 0.f;
#pragma unroll
                    for (int t = 0; t < TPL; ++t) { float g0 = gb0, g1 = gb1; const unsigned gw[8] = {rg[SI][t][0].x, rg[SI][t][0].y, rg[SI][t][0].z, rg[SI][t][0].w, rg[SI][t][1].x, rg[SI][t][1].y, rg[SI][t][1].z, rg[SI][t][1].w};
#pragma unroll
                        for (int r = 0; r < 8; ++r) { const float e0 = bflo(gw[r]), e1 = bfhi(gw[r]); g0 += e0 * w2r[0][2 * r] + e1 * w2r[0][2 * r + 1]; g1 += e0 * w2r[1][2 * r] + e1 * w2r[1][2 * r + 1]; }
                        const float l0 = (fminf(g0, 0.f) * LOG2E - __builtin_amdgcn_logf(1.f + __builtin_amdgcn_exp2f(-fabsf(g0) * LOG2E))) * (1.f / 16.f);
                        const float l1 = (fminf(g1, 0.f) * LOG2E - __builtin_amdgcn_logf(1.f + __builtin_amdgcn_exp2f(-fabsf(g1) * LOG2E))) * (1.f / 16.f);
                        a0 += l0; a1 += l1; c0v[t] = a0; c1v[t] = a1; }
                    float s0 = c0v[TPL - 1], s1 = c1v[TPL - 1];
#pragma unroll
                    for (int d = NCP; d < 64; d <<= 1) { const float u0 = __shfl_up(s0, d), u1 = __shfl_up(s1, d); if (lane >= d) { s0 += u0; s1 += u1; } }
                    const float bl0 = __shfl(s0, (NTG - 1) * NCP + cp), bl1 = __shfl(s1, (NTG - 1) * NCP + cp);
                    off0 = s0 - c0v[TPL - 1]; off1 = s1 - c1v[TPL - 1];
                    cL0 = __builtin_amdgcn_exp2f(bl0); cL1 = __builtin_amdgcn_exp2f(bl1);
                } else {
                    float a0 = 1.f, a1 = 1.f;
#pragma unroll
                    for (int t = 0; t < TPL; ++t) { a0 *= 1.f - bflo(rk[SI][t]); a1 *= 1.f - bfhi(rk[SI][t]); c0v[t] = a0; c1v[t] = a1; }
                    float s0 = a0, s1 = a1;
#pragma unroll
                    for (int d = NCP; d < 64; d <<= 1) { const float u0 = __shfl_up(s0, d), u1 = __shfl_up(s1, d); if (lane >= d) { s0 *= u0; s1 *= u1; } }
                    cL0 = __shfl(s0, (NTG - 1) * NCP + cp); cL1 = __shfl(s1, (NTG - 1) * NCP + cp);
                    const float p0 = __shfl_up(s0, NCP), p1 = __shfl_up(s1, NCP);
                    off0 = lane >= NCP ? p0 : 1.f; off1 = lane >= NCP ? p1 : 1.f;
                }
                unsigned kdp0[TPL / 2], kdp1[TPL / 2]; float kdprev0 = 0.f, kdprev1 = 0.f;
#pragma unroll
                for (int t = 0; t < TPL; ++t) {
                    float E0, E1, Rc0, Rc1;
                    if constexpr (DK == 64) { const float e0 = fmaxf(off0 + c0v[t], -100.f), e1 = fmaxf(off1 + c1v[t], -100.f);
                        E0 = __builtin_amdgcn_exp2f(e0); E1 = __builtin_amdgcn_exp2f(e1); Rc0 = __builtin_amdgcn_exp2f(-e0); Rc1 = __builtin_amdgcn_exp2f(-e1); }
                    else { E0 = fmaxf(off0 * c0v[t], 0x1p-100f); E1 = fmaxf(off1 * c1v[t], 0x1p-100f); Rc0 = __builtin_amdgcn_rcpf(E0); Rc1 = __builtin_amdgcn_rcpf(E1); }
                    const float ks0 = bflo(rk[SI][t]) * Rc0, ks1 = bfhi(rk[SI][t]) * Rc1;
                    const int xr = ((DK == 128) ? t : (t >> 1)) << 4;
                    *(LAS unsigned*)(lds + (R0q ^ xr) + t * RP) = cvtpk(bflo(rq[SI][t]) * E0, bfhi(rq[SI][t]) * E1);
                    *(LAS unsigned*)(lds + (R0k ^ xr) + t * RP) = cvtpk(ks0, ks1);
                    const float kd0 = ks0 * cL0, kd1 = ks1 * cL1;
                    if (t & 1) { kdp0[t >> 1] = cvtpk(kdprev0, kd0); kdp1[t >> 1] = cvtpk(kdprev1, kd1); } else { kdprev0 = kd0; kdprev1 = kd1; }
                }
                if constexpr (TPL == 8) { *(LAS v4u*)(img + SC_KDT + ti0) = (v4u){kdp0[0], kdp0[1], kdp0[TPL / 2 - 2], kdp0[TPL / 2 - 1]}; *(LAS v4u*)(img + SC_KDT + ti1) = (v4u){kdp1[0], kdp1[1], kdp1[TPL / 2 - 2], kdp1[TPL / 2 - 1]}; }
                else { *(LAS v2u*)(img + SC_KDT + ti0) = (v2u){kdp0[0], kdp0[1]}; *(LAS v2u*)(img + SC_KDT + ti1) = (v2u){kdp1[0], kdp1[1]}; }
                if (tg == 0) *(LAS f32x2v*)(img + SC_DV + dvo) = (f32x2v){cL0, cL1};
                { v4u lo, hi;
                  lo.x = __builtin_amdgcn_perm(rv[SI][1], rv[SI][0], 0x05040100u); lo.y = __builtin_amdgcn_perm(rv[SI][3], rv[SI][2], 0x05040100u); lo.z = __builtin_amdgcn_perm(rv[SI][5], rv[SI][4], 0x05040100u); lo.w = __builtin_amdgcn_perm(rv[SI][7], rv[SI][6], 0x05040100u);
                  hi.x = __builtin_amdgcn_perm(rv[SI][1], rv[SI][0], 0x07060302u); hi.y = __builtin_amdgcn_perm(rv[SI][3], rv[SI][2], 0x07060302u); hi.z = __builtin_amdgcn_perm(rv[SI][5], rv[SI][4], 0x07060302u); hi.w = __builtin_amdgcn_perm(rv[SI][7], rv[SI][6], 0x07060302u);
                  *(LAS v4u*)(img + SC_VT + tv_0) = lo; *(LAS v4u*)(img + SC_VT + tv_1) = hi; }
                if (cw + AHEAD < NCHUNK) load_chunk(setc, cw + AHEAD);
            }
            const int cs = it + 1;
            if (cs >= 0 && cs < NCHUNK && pw == (cs & 3)) {
                LAS unsigned char* simg = lds + SC_S + (cs & 1) * 2048;
                int i31 = lane & 31, h = lane >> 5; asm volatile("" : "+v"(i31), "+v"(h));
                const int aq0 = i31 * RP + ((h ^ rm_swz<DK>(i31)) << 4);
                const int aqk = aq0 + SC_QK + (cs & 1) * SC_QKSET, aqi = aq0 + (cs % 3) * SC_IMG + SC_QI;
                bf16x8 ka[NKS], qb[NKS];
#pragma unroll
                for (int ks = 0; ks < NKS; ++ks) { ka[ks] = *(const LAS bf16x8*)(lds + (aqk ^ (ks << 5))); qb[ks] = *(const LAS bf16x8*)(lds + (aqi ^ (ks << 5))); }
                SCHED_FENCE();
                f32x16 sacc;
#pragma unroll
                for (int r = 0; r < 16; ++r) sacc[r] = 0.f;
#pragma unroll
                for (int ks = 0; ks < NKS; ++ks) sacc = MFMA32(ka[ks], qb[ks], sacc);
                const int sa0 = i31 * 64 + 8 * h, x2 = (i31 >> 2) & 3, dij = i31 - 4 * h;
#pragma unroll
                for (int g = 0; g < 4; ++g) { float m[4];
#pragma unroll
                    for (int e = 0; e < 4; ++e) m[e] = (dij >= 8 * g + e) ? sacc[4 * g + e] : 0.f;
                    *(LAS v2u*)(simg + sa0 + ((g ^ x2) << 4)) = (v2u){cvtpk(m[0], m[1]), cvtpk(m[2], m[3])}; }
            }
            asm volatile("s_waitcnt lgkmcnt(0)" ::: "memory"); __builtin_amdgcn_s_barrier(); asm volatile("" ::: "memory");
        };
        static_assert((NCHUNK & 1) == 0, "interval loop is unrolled by two");
        for (int it = -2; it < NCHUNK; it += 2) { prep_step(IC<0>{}, it); if constexpr (AHEAD == 2) prep_step(IC<1>{}, it + 1); else prep_step(IC<0>{}, it + 1); }
    }
}

__global__ void __launch_bounds__(NTHR, 2) fwd_kernel(Args args) {
    extern __shared__ __attribute__((aligned(16))) unsigned char lds_raw[];
    LAS unsigned char* lds = (LAS unsigned char*)lds_raw;
    {   const int t0 = threadIdx.x;
        for (int u = t0; u < (LDS_BYTES - LDSCTL_OFF) / 4; u += NTHR) ((LAS unsigned*)(lds + LDSCTL_OFF))[u] = 0u;
        __syncthreads();
        if (t0 == 0) { volatile LAS unsigned* M = (volatile LAS unsigned*)(lds + MISC_OFF); unsigned* barw = (unsigned*)(kargs()->ws + WS_CTL) + CW_BAR; const unsigned x = xb_xcc_id();
            const unsigned rk = xb_add(&barw[XB_XCNT(x)], 1u); M[12] = x; M[13] = rk; M[14] = blockIdx.x; }
        __syncthreads(); }
#define IN(k) (kargs()->ph_lo <= (k) && (k) < kargs()->ph_hi)
#define BARL() do { XcdBarrier bar_; bar_.bar = (unsigned*)(kargs()->ws + WS_CTL) + CW_BAR; bar_.x = xb_xcc_id(); bar_.st = (volatile LAS unsigned*)(lds + MISC_OFF) + 8; xcd_barrier<true>(bar_); } while (0)
#define BAR(k) do { if (IN(k) && IN((k) + 1)) { XcdBarrier bar_; bar_.bar = (unsigned*)(kargs()->ws + WS_CTL) + CW_BAR; bar_.x = xb_xcc_id(); bar_.st = (volatile LAS unsigned*)(lds + MISC_OFF) + 8; xcd_barrier(bar_); } } while (0)
#define PH_VIEW() KA A = kargs(); unsigned char* ws = A->ws; float* mods = (float*)(ws + WS_MODS); bf16* Hb = (bf16*)(ws + WS_H); bf16* OBb = (bf16*)(ws + WS_OB); bf16* Gb = (bf16*)(ws + WS_G); bf16* Pb = (bf16*)(ws + WS_P); \
    bf16* GRb = (bf16*)(ws + WS_GR); bf16* MIXb = (bf16*)(ws + WS_MIX); bf16* XBC = (bf16*)(ws + WS_XC); bf16* XBL = (bf16*)A->out; (void)mods; (void)Hb; (void)OBb; (void)Gb; (void)Pb; (void)GRb; (void)MIXb; (void)XBC; (void)XBL; \
    int tid = threadIdx.x; asm volatile("" : "+v"(tid)); const int lane = tid & 63, wave = __builtin_amdgcn_readfirstlane(tid >> 6), wg = blockIdx.x, G = gridDim.x, gw = wg * NWAVES + wave, NGW = G * NWAVES; \
    (void)lane; (void)wave; (void)wg; (void)G; (void)gw; (void)NGW
#define LAYER_VIEW() const float* xlat = A->in[I_X]; const float* xctx = A->in[I_CTX]; \
    const float* mlat = mods + MO_LAT + l * 16 * 6144; const float* mctx = mods + MO_CTX + l * 6144; (void)xlat; (void)xctx; (void)mlat; (void)mctx
    LAS int* tab = (LAS int*)(lds + TAB_OFF);
#define VCU() ((int)__builtin_amdgcn_readfirstlane(((volatile LAS unsigned*)(lds + MISC_OFF))[14]))

    if (IN(0)) { PH_VIEW();
        LAS float* scr = (LAS float*)(lds + wave * 16384);
        for (int it = gw; it < NI_MAIN; it += NGW) conv_item_main(A, it, scr, lane);
        __syncthreads();
        for (int it = wg; it < 192; it += G) mod_item(A, it, lds, tid, lane, wave);
        for (int it = wg; it < 256; it += G) colmax_rows_item(A, it, tid);
        for (int it = wg; it < NS_MAIN; it += G) colscale_item_main(A, it, lds, tid, lane, wave);
        if (wg == G - 1) for (int i = tid; i < 1024; i += NTHR) { const int d = i >> 9, ch = i & 511; const float a0 = A->in[I_HLB][d * 512 + ch], a1 = A->in[I_HLB][(2 + d) * 512 + ch];
            mods[MO_LB + d * 512 + ch] = 0.f; mods[MO_LB + 1024 + d * 512 + ch] = 1.f / (1.f + __expf(a0 - a1)); }
    }
    BAR(0);
#if !MK_MULTI
    if (threadIdx.x == 0 && IN(0) && IN(1)) { volatile LAS unsigned* M = (volatile LAS unsigned*)(lds + MISC_OFF); unsigned* barw = (unsigned*)(kargs()->ws + WS_CTL) + CW_BAR; const unsigned per = gridDim.x / 8; bool ok = (gridDim.x % 8) == 0;
        for (unsigned j = 0; j < 16; ++j) { const unsigned cnt = xb_ld(&barw[XB_XCNT(j)]); ok = ok && (j < 8 ? cnt == per : cnt == 0u); }
        if (ok) M[14] = M[13] * 8u + M[12]; }
    __syncthreads();
#endif
#pragma nounroll
    for (int l = 0; l < 2; ++l) {
        const int pb = l ? 10 : 1;
        if (IN(pb)) { PH_VIEW(); LAYER_VIEW();
            typedef float f32x4m __attribute__((ext_vector_type(4)));
            const bf16* W32 = (const bf16*)(ws + WS_WIN) + (size_t)l * 32 * 1024;
            const int fm = lane & 15, kq = lane >> 4;
            bf16x8 wb[2][4];
#pragma unroll
            for (int nt = 0; nt < 2; ++nt)
#pragma unroll
                for (int s = 0; s < 4; ++s) wb[nt][s] = *(const bf16x8*)(W32 + (size_t)(nt * 16 + fm) * 1024 + 128 * wave + 32 * s + 8 * kq);
            LAS unsigned char* tile = lds; LAS float* red = (LAS float*)(lds + 32768);
            v4u yb[2][4];
#define N1LOAD(rr_, m_) do { const int mm_ = (m_); if (l) { const v2u* xr_ = (const v2u*)(mm_ < ML ? XBL + (size_t)mm_ * D : XBC + (size_t)(mm_ - ML) * D) + lane; \
        _Pragma("unroll") for (int j = 0; j < 4; ++j) { const v2u w_ = xr_[64 * j]; yb[rr_][j] = (v4u){w_.x, w_.y, 0u, 0u}; } } \
    else { const float* xr_ = mm_ < ML ? xlat + (size_t)mm_ * D : xctx + (size_t)(mm_ - ML) * D; _Pragma("unroll") for (int j = 0; j < 4; ++j) yb[rr_][j] = ((const v4u*)xr_)[lane + 64 * j]; } } while (0)
#pragma unroll
            for (int rr = 0; rr < 2; ++rr) N1LOAD(rr, wg * 144 + 2 * wave + rr);
            for (int blk = 0; blk < 9; ++blk) {
                const int r0 = wg * 144 + blk * 16;
#pragma unroll
                for (int rr = 0; rr < 2; ++rr) { const int lr = 2 * wave + rr, m = r0 + lr; const bool lat = m < ML; const float* md = lat ? mlat + (m >> 11) * 6144 : mctx;
                    f32x4 y[4]; float ss = 0.f;
#pragma unroll
                    for (int j = 0; j < 4; ++j) { const v4u w_ = yb[rr][j]; if (l) y[j] = (f32x4){bflo(w_.x), bfhi(w_.x), bflo(w_.y), bfhi(w_.y)}; else y[j] = __builtin_bit_cast(f32x4, w_);
                        ss += (y[j].x * y[j].x + y[j].y * y[j].y) + (y[j].z * y[j].z + y[j].w * y[j].w); }
                    if (blk + 1 < 9) N1LOAD(rr, m + 16);
                    const float rstd = rsqrtf(wave_sum(ss) * (1.f / D) + EPS);
                    const float* g1 = A->in[I_N1G] + l * D;
#pragma unroll
                    for (int j = 0; j < 4; ++j) { const f32x4 gv = ((const f32x4*)g1)[lane + 64 * j], sh = ((const f32x4*)md)[lane + 64 * j], sc = ((const f32x4*)(md + 1024))[lane + 64 * j];
                        y[j] = y[j] * rstd * gv * (sc + 1.f) + sh; const v2u w = (v2u){pk2(y[j].x, y[j].y), pk2(y[j].z, y[j].w)};
                        const int ch = (lane + 64 * j) >> 1; *(LAS v2u*)(tile + lr * 2048 + ((ch ^ lr) << 4) + (lane & 1) * 8) = w; }
                    quant_row(y, (unsigned*)(ws + WS_HQ) + (size_t)m * 256, (float*)(ws + WS_SAR) + m, lane); }
                __syncthreads();
                f32x4m c0 = {0.f, 0.f, 0.f, 0.f}, c1 = {0.f, 0.f, 0.f, 0.f};
#pragma unroll
                for (int s = 0; s < 4; ++s) { const bf16x8 af = *(const LAS bf16x8*)(tile + fm * 2048 + (((16 * wave + 4 * s + kq) ^ fm) << 4));
                    c0 = __builtin_amdgcn_mfma_f32_16x16x32_bf16(af, wb[0][s], c0, 0, 0, 0); c1 = __builtin_amdgcn_mfma_f32_16x16x32_bf16(af, wb[1][s], c1, 0, 0, 0); }
#pragma unroll
                for (int e = 0; e < 4; ++e) { red[(wave * 16 + 4 * kq + e) * 32 + fm] = c0[e]; red[(wave * 16 + 4 * kq + e) * 32 + 16 + fm] = c1[e]; }
                __syncthreads();
                { float s = 0.f;
#pragma unroll
                  for (int w = 0; w < 8; ++w) s += red[w * 512 + tid];
                  GRb[(size_t)(r0 + (tid >> 5)) * 32 + (tid & 31)] = (bf16)f2bf(s); }
            }
#undef N1LOAD
            if (l == 0) { __syncthreads(); LAS float* scr = (LAS float*)(lds + wave * 16384); for (int it = gw; it < NQ_MAIN; it += NGW) conv_item_q(A, it, scr, lane);
                for (int idx = wg * NTHR + tid; idx < 8 * 7168; idx += G * NTHR) { const int e = idx / 7168, row = idx % 7168, which = (row >> 7) & 1, col = 128 * (row >> 8) + (row & 127);
                    ((float*)(ws + WS_SB13))[idx] = fmaxf(__builtin_bit_cast(float, ((const unsigned*)(ws + WS_CTL))[CW_CM + (e * 2 + which) * DEXP + col]), 1e-30f) * (1.f / 127.f); } }
        }
        BAR(pb);
        if (IN(pb + 1)) { PH_VIEW(); LAYER_VIEW();
            pg8::Gemm g{(const bf16*)(ws + WS_HQ), (const bf16*)(ws + WS_WINQ + (size_t)l * 4096 * 1024), MT, PW, D / 2}; pg8::StaticOrder S; S.init(MT, PW, G, VCU());
            EpiInProjT<true> E{Pb, Gb, GRb, mods + MO_LB + l * 1024, (const float*)(ws + WS_SAR), (const float*)(ws + WS_SBIN) + l * 4096};
            pg8::gemm_phase<EpiInProjT<true>, pg8::StaticOrder, true, true>(lds, g, S, E);
        }
        BAR(pb + 1);
        if (IN(pb + 2)) { PH_VIEW(); LAYER_VIEW();
            for (int s = wg; s < 256; s += G) { const int grp = s >> 7, r = s & 127, b = r >> 3, hd = (r >> 1) & 3, dir = r & 1;
                bf16* OUT = dir ? OBb : Hb;
                const float* w2 = A->in[I_GW2] + (size_t)(l * 2 + dir) * 16 * 256; const float* gb = A->in[I_GB] + (l * 2 + dir) * 256;
                if (grp == 0) { if (dir) scan_mfma<64, 1>(lds, Pb, GRb, w2, gb, OUT, grp, b, hd, tid); else scan_mfma<64, 0>(lds, Pb, GRb, w2, gb, OUT, grp, b, hd, tid); }
                else { if (dir) scan_mfma<128, 1>(lds, Pb, GRb, w2, gb, OUT, grp, b, hd, tid); else scan_mfma<128, 0>(lds, Pb, GRb, w2, gb, OUT, grp, b, hd, tid); } }
        }
        BAR(pb + 2);
        if (IN(pb + 3)) { PH_VIEW(); LAYER_VIEW();
            const int nrow = l ? ML : MT;
            for (int m = gw; m < nrow; m += 2 * NGW) { const int m2 = m + NGW; MixIn ra, rb;
                mix_load(Hb + (size_t)m * D, OBb + (size_t)m * D, Gb + (size_t)m * D, lane, ra);
                { const int mc = m2 < nrow ? m2 : m; mix_load(Hb + (size_t)mc * D, OBb + (size_t)mc * D, Gb + (size_t)mc * D, lane, rb); }
                mix_finish_bf(ra, A->in[I_GLAG] + l * 128, A->in[I_HGG] + l * 128, MIXb + (size_t)m * D, lane);
                if (m2 < nrow) mix_finish_bf(rb, A->in[I_GLAG] + l * 128, A->in[I_HGG] + l * 128, MIXb + (size_t)m2 * D, lane); }
            if (l == 1) { LAS float* scr = (LAS float*)(lds + wave * 16384); for (int it = gw; it < NI_M13; it += NGW) conv_item_moe(A, it, scr, lane); }
        }
        BAR(pb + 3);
        if (IN(pb + 4)) { PH_VIEW(); LAYER_VIEW();
            const int Mw = l ? ML : MT;
            pg8::Gemm g{MIXb, (const bf16*)(ws + WS_WOUT) + (size_t)l * 1024 * 1024, Mw, D, D}; pg8::StaticOrder S; S.init(Mw, D, G, VCU());
            if (l == 0) { EpiResidB<true> E{xlat, xctx, XBL, XBC, mlat + 2048, mctx + 2048}; pg8::gemm_phase<EpiResidB<true>, pg8::StaticOrder, true, true>(lds, g, S, E); }
            else { EpiResidB<false> E{XBL, XBC, (bf16*)(ws + WS_X3), XBC, mlat + 2048, mctx + 2048}; pg8::gemm_phase<EpiResidB<false>, pg8::StaticOrder, true, true>(lds, g, S, E); }
        }
        BAR(pb + 4);
        if (l == 0) {
            if (IN(6)) { PH_VIEW(); LAYER_VIEW();
                for (int m = gw; m < MT; m += 2 * NGW) { const int m2 = m + NGW; f32x4 ya[4], yb[4]; v2u ra[4], rb[4];
                    xloadb(m < ML ? XBL + (size_t)m * D : XBC + (size_t)(m - ML) * D, lane, ra);
                    { const int mc = m2 < MT ? m2 : m; xloadb(mc < ML ? XBL + (size_t)mc * D : XBC + (size_t)(mc - ML) * D, lane, rb); }
                    xcvt(ra, ya); xcvt(rb, yb);
                    { const float* md = m < ML ? mlat + (m >> 11) * 6144 : mctx; norm_finish_q((unsigned*)(ws + WS_HQ) + (size_t)m * 256, (float*)(ws + WS_SAR) + m, A->in[I_N2G], md + 3072, md + 4096, lane, ya); }
                    if (m2 < MT) { const float* md = m2 < ML ? mlat + (m2 >> 11) * 6144 : mctx; norm_finish_q((unsigned*)(ws + WS_HQ) + (size_t)m2 * 256, (float*)(ws + WS_SAR) + m2, A->in[I_N2G], md + 3072, md + 4096, lane, yb); } }
            }
            BAR(6);
            if (IN(7)) { PH_VIEW(); LAYER_VIEW();
                pg8::Gemm g{(const bf16*)(ws + WS_HQ), (const bf16*)(ws + WS_F13), MT, 2 * DFF, D / 2}; MoeOrder S; S.init(MC / 256, 22, G, VCU(), ML / 256, 0);
#pragma unroll
                for (int e = 0; e < 8; ++e) S.pb[e] = 1 << 30;
                EpiSwiGLUQ E{(bf16*)(ws + WS_ACT0), DFF, 22, 0, (const float*)(ws + WS_SAR), (const float*)(ws + WS_SBF)};
                pg8::gemm_phase<EpiSwiGLUQ, MoeOrder, true, true>(lds, g, S, E);
            }
            BAR(7);
            if (IN(8)) { PH_VIEW(); LAYER_VIEW();
                { pg8::Gemm g{(const bf16*)(ws + WS_ACT0), (const bf16*)(ws + WS_F2), MT, D, DFF}; MoeOrder S; S.init(MC / 256, 4, G, VCU(), ML / 256, 0);
#pragma unroll
                  for (int e = 0; e < 8; ++e) S.pb[e] = 1 << 30;
                  EpiResidB<false> E{XBL, XBC, XBL, XBC, mlat + 5120, mctx + 5120};
                  pg8::gemm_phase<EpiResidB<false>, MoeOrder, true, true>(lds, g, S, E); }
                { pg8::Gemm g{(const bf16*)(ws + WS_HQ), (const bf16*)(ws + WS_F13), MT, 2 * DFF, D / 2}; MoeOrder S; S.init(ML / 256, 22, G, VCU(), 0, 0); S.nb = (MC / 256) * 4; S.keep = 7;
#pragma unroll
                  for (int e = 0; e < 8; ++e) S.pb[e] = 1 << 30;
                  EpiSwiGLUQ E{(bf16*)(ws + WS_ACT0), DFF, 22, 0, (const float*)(ws + WS_SAR), (const float*)(ws + WS_SBF)};
                  pg8::gemm_phase<EpiSwiGLUQ, MoeOrder, true, true>(lds, g, S, E); }
            }
            BAR(8);
            if (IN(9)) { PH_VIEW(); LAYER_VIEW();
                pg8::Gemm g{(const bf16*)(ws + WS_ACT0), (const bf16*)(ws + WS_F2), MT, D, DFF}; MoeOrder S; S.init(ML / 256, 4, G, VCU(), 0, 0);
#pragma unroll
                for (int e = 0; e < 8; ++e) S.pb[e] = 1 << 30;
                EpiResidB<false> E{XBL, XBC, XBL, XBC, mlat + 5120, mctx + 5120};
                pg8::gemm_phase<EpiResidB<false>, MoeOrder, true, true>(lds, g, S, E);
            }
            BAR(9);
        }
    }
    if (IN(15)) { PH_VIEW(); const float* mlat1 = mods + MO_LAT + 16 * 6144;
        LAS int* sE = (LAS int*)(lds + LDSCTL_OFF + 4096); LAS float* sW = (LAS float*)(lds + LDSCTL_OFF + 5120); LAS int* sL = (LAS int*)(lds + LDSCTL_OFF + 6144); LAS float* sS = (LAS float*)(lds + LDSCTL_OFF + 7168);
        f32x4 ga[4], sh4[4], rw[8][4];
        { const float* md0 = mlat1 + ((wg * 128) >> 11) * 6144;
#pragma unroll
          for (int j = 0; j < 4; ++j) { const f32x4 gv = ((const f32x4*)(A->in[I_N2G] + D))[lane + 64 * j], sc = ((const f32x4*)(md0 + 4096))[lane + 64 * j]; sh4[j] = ((const f32x4*)(md0 + 3072))[lane + 64 * j]; ga[j] = gv * (sc + 1.f);
              const f32x4* rp = (const f32x4*)(A->in[I_ROUTER] + (size_t)(4 * (lane + 64 * j)) * 8); f32x4 v[8];
#pragma unroll
              for (int q = 0; q < 8; ++q) v[q] = rp[q];
#pragma unroll
              for (int e = 0; e < 8; ++e) rw[e][j] = (f32x4){v[(e >> 2)][e & 3], v[2 + (e >> 2)][e & 3], v[4 + (e >> 2)][e & 3], v[6 + (e >> 2)][e & 3]}; } }
        const bf16* X3 = (const bf16*)(ws + WS_X3);
        f32x4 y[4]; v2u yr[4], yn[4]; xloadb(X3 + (size_t)(wg * 128 + wave * 16) * D, lane, yr);
        for (int rr = 0; rr < 16; ++rr) { const int tl = wave * 16 + rr, row = wg * 128 + tl;
            { const int rn = rr + 1 < 16 ? row + 1 : row; xloadb(X3 + (size_t)rn * D, lane, yn); }
            xcvt(yr, y);
            { float s = 0.f;
#pragma unroll
              for (int j = 0; j < 4; ++j) s += (y[j].x * y[j].x + y[j].y * y[j].y) + (y[j].z * y[j].z + y[j].w * y[j].w);
              const float rstd = rsqrtf(wave_sum(s) * (1.f / D) + EPS); float am = 0.f;
#pragma unroll
              for (int j = 0; j < 4; ++j) {
                  y[j] = y[j] * rstd * ga[j] + sh4[j]; am = fmaxf(fmaxf(am, fmaxf(fabsf(y[j].x), fabsf(y[j].y))), fmaxf(fabsf(y[j].z), fabsf(y[j].w))); }
#pragma unroll
              for (int o = 1; o < 64; o <<= 1) am = fmaxf(am, __shfl_xor(am, o));
              am = fmaxf(am, 1e-30f); const float inv = 127.f / am; LAS unsigned* hq = (LAS unsigned*)(lds + tl * 1024) + lane;
#pragma unroll
              for (int j = 0; j < 4; ++j) { const int q0 = (int)__builtin_rintf(y[j].x * inv), q1 = (int)__builtin_rintf(y[j].y * inv), q2 = (int)__builtin_rintf(y[j].z * inv), q3 = (int)__builtin_rintf(y[j].w * inv);
                  hq[64 * j] = (unsigned)(q0 & 255) | ((unsigned)(q1 & 255) << 8) | ((unsigned)(q2 & 255) << 16) | ((unsigned)(q3 & 255) << 24); }
              if (lane == 0) sS[tl] = am * (1.f / 127.f); }
            float lg[8];
            { float p[8];
#pragma unroll
              for (int e = 0; e < 8; ++e) { float a = 0.f;
#pragma unroll
                  for (int j = 0; j < 4; ++j) { const f32x4 r4 = rw[e][j]; a += (y[j].x * r4.x + y[j].y * r4.y) + (y[j].z * r4.z + y[j].w * r4.w); }
                  p[e] = a; }
              const bool h5 = (lane & 32) != 0, h4 = (lane & 16) != 0, h3 = (lane & 8) != 0; float p4[4], p2[2], p1;
#pragma unroll
              for (int i = 0; i < 4; ++i) { const float snd = h5 ? p[i] : p[i + 4], kp = h5 ? p[i + 4] : p[i]; p4[i] = kp + __shfl_xor(snd, 32); }
#pragma unroll
              for (int i = 0; i < 2; ++i) { const float snd = h4 ? p4[i] : p4[i + 2], kp = h4 ? p4[i + 2] : p4[i]; p2[i] = kp + __shfl_xor(snd, 16); }
              { const float snd = h3 ? p2[0] : p2[1], kp = h3 ? p2[1] : p2[0]; p1 = kp + __shfl_xor(snd, 8); }
              p1 += __shfl_xor(p1, 4); p1 += __shfl_xor(p1, 2); p1 += __shfl_xor(p1, 1);
#pragma unroll
              for (int e = 0; e < 8; ++e) lg[e] = __builtin_bit_cast(float, __builtin_amdgcn_readlane(__builtin_bit_cast(int, p1), e * 8)); }
            int i0 = 0; float v0 = lg[0];
#pragma unroll
            for (int e = 1; e < 8; ++e) if (lg[e] > v0) { v0 = lg[e]; i0 = e; }
            int i1 = -1; float v1 = -3.0e38f;
#pragma unroll
            for (int e = 0; e < 8; ++e) if (e != i0 && lg[e] > v1) { v1 = lg[e]; i1 = e; }
            const float w0 = 1.f / (1.f + __expf(v1 - v0));
            if (lane == 0) { sE[2 * tl] = i0; sE[2 * tl + 1] = i1; sW[2 * tl] = w0; sW[2 * tl + 1] = 1.f - w0; }
#pragma unroll
            for (int j = 0; j < 4; ++j) yr[j] = yn[j]; }
        __syncthreads();
        { int run = 0;
#pragma unroll
          for (int j = 0; j < 4; ++j) { const bool mt = sE[64 * j + lane] == wave; const unsigned long long mk = __ballot(mt);
              if (mt) sL[64 * j + lane] = run + __popcll(mk & ((1ull << lane) - 1ull)); run += __popcll(mk); }
          if (lane == 0) __hip_atomic_store((int*)(ws + WS_ROUTE + RT_CNT) + wg * 8 + wave, run, __ATOMIC_RELAXED, __HIP_MEMORY_SCOPE_AGENT); }
        BARL();
        moe_tab<true>(kargs(), lds, tid, wg);
        for (int t = wave; t < 128; t += NWAVES) { const int row = wg * 128 + t; const int e0 = sE[2 * t], e1 = sE[2 * t + 1];
            const int s0 = tab[16 + e0] * 256 + tab[8 + e0] + sL[2 * t], s1 = tab[16 + e1] * 256 + tab[8 + e1] + sL[2 * t + 1];
            const v4u a0 = *(const LAS v4u*)(lds + t * 1024 + lane * 16);
            ((v4u*)((signed char*)(ws + WS_HSQ) + (size_t)s0 * D))[lane] = a0; ((v4u*)((signed char*)(ws + WS_HSQ) + (size_t)s1 * D))[lane] = a0;
            if (lane == 0) { float* gwp = (float*)(ws + WS_ROUTE + RT_GW); gwp[s0] = sW[2 * t]; gwp[s1] = sW[2 * t + 1]; float* sap = (float*)(ws + WS_ROUTE + RT_SA); const float san = sS[t]; sap[s0] = san; sap[s1] = san;
                ((v4i*)(ws + WS_ROUTE + RT_SEL))[row] = (v4i){e0, e1, s0, s1}; } }
        __syncthreads();
        { LAS float* scr = (LAS float*)(lds + wave * 16384); for (int it = NI_M13 + gw; it < NI_MOE; it += NGW) conv_item_moe(A, it, scr, lane); }
    }
    BAR(15);
    if (kargs()->ph_lo >= PH_M0 && kargs()->ph_lo <= NPHASE - 1) moe_tab<false>(kargs(), lds, threadIdx.x, blockIdx.x);
    if (IN(PH_M0)) {
        { PH_VIEW(); pg8::Gemm g{(const bf16*)(ws + WS_HSQ), (const bf16*)((const unsigned char*)A->out + DO_M13Q), 0, 0, D / 2}; MoeOrder S; S.init(CHUNK_PAN, 28, G, VCU(), 0, 0);
#pragma unroll
          for (int e = 0; e < 8; ++e) S.pb[e] = __builtin_amdgcn_readfirstlane(tab[16 + e]);
          EpiSwiGLUQ E{(bf16*)(ws + WS_ACT), DEXP, 28, 0, (const float*)(ws + WS_ROUTE + RT_SA), (const float*)(ws + WS_SB13)};
          pg8::gemm_phase<EpiSwiGLUQ, MoeOrder, true, true>(lds, g, S, E); }
        const int R0 = tab[24] - NCHK * CHUNK_PAN;
        if (R0 > 0) { PH_VIEW(); pg8::Gemm g{(const bf16*)(ws + WS_HSQ), (const bf16*)((const unsigned char*)A->out + DO_M13Q), 0, 0, D / 2}; MoeOrder S; S.init(R0, 28, G, VCU(), NCHK * CHUNK_PAN, 0);
#pragma unroll
          for (int e = 0; e < 8; ++e) S.pb[e] = __builtin_amdgcn_readfirstlane(tab[16 + e]);
          EpiSwiGLUQ E{(bf16*)(ws + WS_ACT), DEXP, 28, (NCHK - 1) * CHUNK_PAN, (const float*)(ws + WS_ROUTE + RT_SA), (const float*)(ws + WS_SB13)};
          pg8::gemm_phase<EpiSwiGLUQ, MoeOrder, true, true>(lds, g, S, E); }
    }
    BAR(PH_M0);
#pragma nounroll
    for (int it = 1; it <= NCHK; ++it) {
        const int TP = tab[24], R = TP - NCHK * CHUNK_PAN, pa = PH_M0 - 1 + 2 * it, pbb = PH_M0 + 2 * it;
        if (IN(pa)) { PH_VIEW();
            pg8::Gemm g{(const bf16*)(ws + WS_ACT), (const bf16*)((const unsigned char*)A->out + DO_M2), 0, 0, DEXP}; MoeOrder S; S.init(CHUNK_PAN, 4, G, VCU(), CHUNK_PAN * (it - 1), 1); S.nb = 0;
#pragma unroll
            for (int e = 0; e < 8; ++e) S.pb[e] = __builtin_amdgcn_readfirstlane(tab[16 + e]);
            EpiMoeOut E{(bf16*)(ws + WS_HS), (const float*)(ws + WS_ROUTE + RT_GW), CHUNK_PAN * (it - 1)};
            pg8::gemm_phase<EpiMoeOut, MoeOrder, true, true>(lds, g, S, E);
        }
        BAR(pa);
        if (it < NCHK) {
            if (IN(pbb) && it == 1 && R > 0) { PH_VIEW();
                pg8::Gemm g{(const bf16*)(ws + WS_ACT) + (size_t)CHUNK_PAN * 256 * DEXP, (const bf16*)((const unsigned char*)A->out + DO_M2), 0, 0, DEXP}; MoeOrder S; S.init(R, 4, G, VCU(), NCHK * CHUNK_PAN, 1); S.nb = 0;
#pragma unroll
                for (int e = 0; e < 8; ++e) S.pb[e] = __builtin_amdgcn_readfirstlane(tab[16 + e]);
                EpiMoeOut E{(bf16*)(ws + WS_HS), (const float*)(ws + WS_ROUTE + RT_GW), NCHK * CHUNK_PAN};
                pg8::gemm_phase<EpiMoeOut, MoeOrder, true, true>(lds, g, S, E);
            }
            if (IN(pbb)) { PH_VIEW();
                pg8::Gemm g{(const bf16*)(ws + WS_HSQ), (const bf16*)((const unsigned char*)A->out + DO_M13Q), 0, 0, D / 2}; MoeOrder S; S.init(CHUNK_PAN, 28, G, VCU(), CHUNK_PAN * it, 0); S.nb = (it == 1) ? 4 * R : 0;
#pragma unroll
                for (int e = 0; e < 8; ++e) S.pb[e] = __builtin_amdgcn_readfirstlane(tab[16 + e]);
                EpiSwiGLUQ E{(bf16*)(ws + WS_ACT), DEXP, 28, CHUNK_PAN * it, (const float*)(ws + WS_ROUTE + RT_SA), (const float*)(ws + WS_SB13)};
                pg8::gemm_phase<EpiSwiGLUQ, MoeOrder, true, true>(lds, g, S, E);
            }
            BAR(pbb);
        }
    }
    if (IN(NPHASE - 1)) { PH_VIEW(); const float* mlat1 = mods + MO_LAT + 16 * 6144;
        unsigned bad = __hip_atomic_load((unsigned*)(ws + WS_CTL) + CW_BAR + XB_TMO, __ATOMIC_RELAXED, __HIP_MEMORY_SCOPE_AGENT);
        const bf16* Y = (const bf16*)(ws + WS_HS);
        const v4i* selt = (const v4i*)(ws + WS_ROUTE + RT_SEL);
        const bf16* X3 = (const bf16*)(ws + WS_X3);
#define FIN_LOAD(mm, sel_, X_, A_, B_) do { const v2u* xr_ = (const v2u*)(X3 + (size_t)(mm) * D) + lane; const v2u* y0_ = (const v2u*)(Y + (size_t)(sel_).z * D) + lane; const v2u* y1_ = (const v2u*)(Y + (size_t)(sel_).w * D) + lane; \
            _Pragma("unroll") for (int j = 0; j < 4; ++j) { X_[j] = xr_[64 * j]; A_[j] = y0_[64 * j]; B_[j] = y1_[64 * j]; } } while (0)
        v2u xa[4], xn[4]; v2u aa[4], ab[4], na[4], nb[4]; v4i seln = (v4i){0, 0, 0, 0};
        if (gw < ML) { const v4i s0 = selt[gw]; FIN_LOAD(gw, s0, xa, aa, ab); if (gw + NGW < ML) seln = selt[gw + NGW]; }
        for (int m = gw; m < ML; m += NGW) { const int mn = m + NGW; const float* md = mlat1 + (m >> 11) * 6144 + 5120;
            if (mn < ML) { FIN_LOAD(mn, seln, xn, na, nb); if (mn + NGW < ML) seln = selt[mn + NGW]; }
            f32x4* xr = (f32x4*)(A->out + (size_t)m * D) + lane;
            f32x4 v[4]; float s = 0.f;
#pragma unroll
            for (int j = 0; j < 4; ++j) { const f32x4 gt = ((const f32x4*)md)[lane + 64 * j]; const v2u a = aa[j], b = ab[j];
                const f32x4 yy = {bflo(a.x) + bflo(b.x), bfhi(a.x) + bfhi(b.x), bflo(a.y) + bflo(b.y), bfhi(a.y) + bfhi(b.y)};
                v[j] = (f32x4){bflo(xa[j].x), bfhi(xa[j].x), bflo(xa[j].y), bfhi(xa[j].y)} + gt * yy; s += (v[j].x * v[j].x + v[j].y * v[j].y) + (v[j].z * v[j].z + v[j].w * v[j].w); }
            const float rstd = rsqrtf(wave_sum(s) * (1.f / D) + EPS);
#pragma unroll
            for (int j = 0; j < 4; ++j) { f32x4 o = v[j] * rstd * ((const f32x4*)A->in[I_FNG])[lane + 64 * j]; if (bad) o = (f32x4){__builtin_nanf(""), __builtin_nanf(""), __builtin_nanf(""), __builtin_nanf("")}; xr[64 * j] = o; }
#pragma unroll
            for (int j = 0; j < 4; ++j) { xa[j] = xn[j]; aa[j] = na[j]; ab[j] = nb[j]; } }
#undef FIN_LOAD
    }
#undef IN
#undef BAR
}

extern "C" void kernel_launch(void* const* d_in, const int* in_sizes, int n_in, void* d_out, int out_size, void* d_ws, size_t ws_size, hipStream_t stream) {
    static int grid = 0;
    if (grid == 0) {
        if (n_in != 23 || in_sizes[0] != ML * D || out_size != ML * D || ws_size < WS_END2) { fprintf(stderr, "kernel_launch: unexpected shapes (n_in %d, in0 %d, out %d, ws %zu, need %zu); nothing launched\n", n_in, n_in > 0 ? in_sizes[0] : -1, out_size, ws_size, (size_t)WS_END2); grid = -1; return; }
        int dev = 0, cus = 0, per_cu = 0;
        if (hipGetDevice(&dev) != hipSuccess || hipDeviceGetAttribute(&cus, hipDeviceAttributeMultiprocessorCount, dev) != hipSuccess) { grid = -1; return; }
        if (hipFuncSetAttribute((const void*)fwd_kernel, hipFuncAttributeMaxDynamicSharedMemorySize, LDS_BYTES) != hipSuccess) { fprintf(stderr, "kernel_launch: hipFuncSetAttribute failed\n"); grid = -1; return; }
        if (hipOccupancyMaxActiveBlocksPerMultiprocessor(&per_cu, (const void*)fwd_kernel, NTHR, LDS_BYTES) != hipSuccess || per_cu < 1) fprintf(stderr, "kernel_launch: occupancy query reports %d\n", per_cu);
        (void)hipGetLastError();
        if (cus < 256) { fprintf(stderr, "kernel_launch: needs 256 CUs, device has %d\n", cus); grid = -1; return; }
        grid = 256;
    }
    if (grid < 0) return;
    if (hipMemsetAsync((char*)d_ws + WS_CTL, 0, CTL_ZERO_BYTES, stream) != hipSuccess) return;
    Args a{};
    for (int i = 0; i < 23; ++i) a.in[i] = (const float*)d_in[i];
    a.out = (float*)d_out; a.ws = (unsigned char*)d_ws;
#if MK_MULTI
#if defined(PROBE_EXTRA)
    { a.ph_lo = PROBE_EXTRA; a.ph_hi = PROBE_EXTRA + 1; }
#define PROBE_LAUNCH() do { Args b = a; b.ph_lo = PROBE_EXTRA; b.ph_hi = PROBE_EXTRA + 1; hipLaunchKernelGGL(fwd_kernel, dim3(grid), dim3(NTHR), LDS_BYTES, stream, b); } while (0)
#else
#define PROBE_LAUNCH() do { } while (0)
#endif
    for (int k = 0; k < NPHASE; ++k) { if (k == PROBE_AT) PROBE_LAUNCH(); a.ph_lo = k; a.ph_hi = k + 1; const int nrep = ((PROBE_REP >> k) & 1ull) ? 2 : 1; for (int r = 0; r < nrep; ++r) hipLaunchKernelGGL(fwd_kernel, dim3(grid), dim3(NTHR), LDS_BYTES, stream, a); }
#else
    a.ph_lo = 0; a.ph_hi = NPHASE; hipLaunchKernelGGL(fwd_kernel, dim3(grid), dim3(NTHR), LDS_BYTES, stream, a);
#endif
}
```

```cpp
#include <hip/hip_runtime.h>
#include <cstdio>
#include <cstdint>
#ifndef MK_MULTI
#define MK_MULTI 0
#endif
#ifndef PROBE_REP
#define PROBE_REP 0ull
#endif
#ifndef PROBE_AT
#define PROBE_AT (-1)
#endif
namespace pg8 {
#define PG8_LAS __attribute__((address_space(3)))
typedef unsigned short bf16_t;
typedef short bf16x8 __attribute__((ext_vector_type(8)));
typedef float f32x4 __attribute__((ext_vector_type(4)));
typedef unsigned u32x4 __attribute__((ext_vector_type(4)));
typedef int i32x4 __attribute__((ext_vector_type(4)));
template <bool I8> struct AccSel { typedef f32x4 T; };
template <> struct AccSel<true> { typedef i32x4 T; };
__device__ __forceinline__ f32x4 mma_bf16(bf16x8 a, bf16x8 b, f32x4 c) { return __builtin_amdgcn_mfma_f32_16x16x32_bf16(a, b, c, 0, 0, 0); }
__device__ __forceinline__ i32x4 mma_i8(bf16x8 a, bf16x8 b, i32x4 c) { return __builtin_amdgcn_mfma_i32_16x16x64_i8(__builtin_bit_cast(i32x4, a), __builtin_bit_cast(i32x4, b), c, 0, 0, 0); }
constexpr int BM = 256, BK = 64, HALF = 128, HTB = HALF * BK * 2  , STAGE_BYTES = 8 * HTB, NXCD = 8, WGM = 8;

__host__ __device__ __forceinline__ int lds_byte(int r, int c) { const int st = (r >> 4) * 2 + (c >> 5), rr = r & 15, cc = c & 31, ob = rr * 64 + cc * 2; return st * 1024 + (ob ^ (((ob >> 9) & 1) << 5)); }
__host__ __device__ __forceinline__ void stage_rc(int b, int& R, int& C) { const int st = b / 1024, sb = b % 1024, swz = sb ^ (((sb >> 9) & 1) << 5); R = (st >> 1) * 16 + swz / 64; C = (st & 1) * 32 + (swz % 64) / 2; }
__host__ __device__ __forceinline__ int perm32(int rho) { const int n = rho >> 4, i = rho & 15; return 8 * (i >> 2) + 4 * n + (i & 3); }

struct Unit { int pm, pn; };
struct Gemm { const bf16_t* A; const bf16_t* Bt; int M, N, K; };

struct StaticOrder {
    int nM, nN, nwg, G, c;
    __host__ __device__ void init(int M, int N, int G_, int c_) { nM = M / BM; nN = N / BM; nwg = nM * nN; G = G_; c = c_; }
    __host__ __device__ bool next(int i, Unit& u) const {
        const long L = (long)i * G + c; if (L >= nwg) return false;
        int wgid = (int)L; { const int q = nwg / NXCD, r = nwg % NXCD, xcd = wgid % NXCD, off = wgid / NXCD; wgid = (xcd < r ? xcd * (q + 1) : r * (q + 1) + (xcd - r) * q) + off; }
        const int nig = WGM * nN, gid = wgid / nig, fm = gid * WGM, gsz = (nM - fm) < WGM ? (nM - fm) : WGM;
        u.pm = fm + ((wgid % nig) % gsz); u.pn = (wgid % nig) / gsz; return true;
    }
    __device__ __forceinline__ void a_ready(const Unit&) const {}
    __device__ __forceinline__ void done(const Unit&) const {}
};
__device__ __forceinline__ unsigned cvt_pk_bf16(float lo, float hi) { unsigned r; asm volatile("v_cvt_pk_bf16_f32 %0, %1, %2" : "=v"(r) : "v"(lo), "v"(hi)); return r; }
typedef float f32x2 __attribute__((ext_vector_type(2)));
template <class Epi, class Sched, bool ALIGN_EPI = false, bool SP2 = false>
__device__ __forceinline__ void gemm_phase(PG8_LAS unsigned char* lds, const Gemm g, const Sched& S, const Epi& E) {
    int tid_l = threadIdx.x; asm volatile("" : "+v"(tid_l));
    const int tid = tid_l, wid = __builtin_amdgcn_readfirstlane(tid >> 6), lane = tid & 63, wr = wid >> 2, wc = wid & 3, fr = lane & 15, fq = lane >> 4;
    const int K = g.K, nt = K / BK;
    unsigned voffA[2], voffB[2];
#pragma unroll
    for (int i = 0; i < 2; ++i) { int R, C; stage_rc(tid * 16 + i * 8192, R, C); const int Rb = Epi::PERM ? ((R & ~31) + perm32(R & 31)) : R;
        voffA[i] = (unsigned)(R * K + C) * 2u; voffB[i] = (unsigned)(Rb * K + C) * 2u; }
    const size_t kstep = (size_t)(BK * 2);
    const size_t hstep = (size_t)HALF * K * 2;
    const size_t tstep = 2 * hstep;
    const unsigned ldsw = (unsigned)wid * 1024u;
    const int aoff = lds_byte(wr * 64 + fr, fq * 8), boff = lds_byte(wc * 32 + fr, fq * 8);
#define PG8_SA(b, h) (((b) * 2 + (h)) * HTB)
#define PG8_SB(b, h) ((4 + (b) * 2 + (h)) * HTB)
#define PG8_STAGE(bufoff, gbase, voff) do { _Pragma("unroll") for (int _i = 0; _i < 2; ++_i) \
        __builtin_amdgcn_global_load_lds((const unsigned*)((const char*)(gbase) + (voff)[_i]), (PG8_LAS unsigned*)(lds + (bufoff) + ldsw + _i * 8192), 16, 0, 0); } while (0)
#define PG8_LDA(dst, b, h) do { _Pragma("unroll") for (int m = 0; m < 4; ++m) _Pragma("unroll") for (int k = 0; k < 2; ++k) dst[m][k] = *(const PG8_LAS bf16x8*)(lds + PG8_SA(b, h) + aoff + m * 2048 + k * 1024); } while (0)
#define PG8_LDB(dst, b, h) do { _Pragma("unroll") for (int n = 0; n < 2; ++n) _Pragma("unroll") for (int k = 0; k < 2; ++k) dst[n][k] = *(const PG8_LAS bf16x8*)(lds + PG8_SB(b, h) + boff + n * 2048 + k * 1024); } while (0)
#define PG8_MMA(ai, bj, At, Bt) do { __builtin_amdgcn_s_setprio(1); _Pragma("unroll") for (int m = 0; m < 4; ++m) _Pragma("unroll") for (int n = 0; n < 2; ++n) _Pragma("unroll") for (int k = 0; k < 2; ++k) \
        { if constexpr (Epi::I8) acc[ai][bj][m][n] = mma_i8(Bt[n][k], At[m][k], acc[ai][bj][m][n]); else acc[ai][bj][m][n] = mma_bf16(Bt[n][k], At[m][k], acc[ai][bj][m][n]); } __builtin_amdgcn_s_setprio(0); } while (0)
#define PG8_WAIT_V(n) asm volatile("s_waitcnt vmcnt(" #n ")" ::: "memory")
#define PG8_WAIT_L(n) asm volatile("s_waitcnt lgkmcnt(" #n ")" ::: "memory")
#define PG8_BAR __builtin_amdgcn_s_barrier()
#define PG8_SCHED __builtin_amdgcn_sched_barrier(0)
    Unit cur, nxt; int ui = 0;
    if (!S.next(0, cur)) return;
    typedef typename AccSel<Epi::I8>::T acc_t;
    acc_t acc[2][2][4][2];
#pragma unroll
    for (int a = 0; a < 2; ++a)
#pragma unroll
        for (int b = 0; b < 2; ++b)
#pragma unroll
            for (int m = 0; m < 4; ++m)
#pragma unroll
                for (int n = 0; n < 2; ++n) acc[a][b][m][n] = (acc_t){0, 0, 0, 0};
    bf16x8 At[4][2], B0[2][2], B1[2][2];
    const char* cA = (const char*)g.A + (size_t)cur.pm * tstep; const char* cB = (const char*)g.Bt + (size_t)cur.pn * tstep;
    S.a_ready(cur);
    if constexpr (SP2) {
        PG8_STAGE(PG8_SB(0, 0), cB, voffB); PG8_STAGE(PG8_SB(0, 1), cB + hstep, voffB); PG8_STAGE(PG8_SA(0, 0), cA, voffA); PG8_STAGE(PG8_SA(0, 1), cA + hstep, voffA);
        if (wr == 1) PG8_BAR;
        PG8_WAIT_V(2); PG8_BAR;
        PG8_STAGE(PG8_SB(1, 0), cB + kstep, voffB); PG8_STAGE(PG8_SA(1, 0), cA + kstep, voffA); PG8_STAGE(PG8_SB(1, 1), cB + hstep + kstep, voffB);
        PG8_WAIT_V(6); PG8_BAR;
    } else {
        PG8_STAGE(PG8_SB(0, 0), cB, voffB); PG8_STAGE(PG8_SA(0, 0), cA, voffA); PG8_STAGE(PG8_SB(0, 1), cB + hstep, voffB); PG8_STAGE(PG8_SA(0, 1), cA + hstep, voffA);
        if (wr == 1) PG8_BAR;
        PG8_WAIT_V(4); PG8_BAR;
        PG8_STAGE(PG8_SB(1, 0), cB + kstep, voffB); PG8_STAGE(PG8_SA(1, 0), cA + kstep, voffA); PG8_STAGE(PG8_SB(1, 1), cB + hstep + kstep, voffB);
        PG8_WAIT_V(6); PG8_BAR;
    }
    for (;;) {
        const bool has_next = S.next(ui + 1, nxt);
        const char* nA = has_next ? (const char*)g.A + (size_t)nxt.pm * tstep : cA; const char* nB = has_next ? (const char*)g.Bt + (size_t)nxt.pn * tstep : cB;
        for (int t = 0; t < nt; t += 2) {
            const bool last = (t == nt - 2);
            const char* a1 = cA + (size_t)(t + 1) * kstep;
            const char* a2 = last ? nA : cA + (size_t)(t + 2) * kstep; const char* b2 = last ? nB : cB + (size_t)(t + 2) * kstep;
            const char* a3 = a2 + kstep; const char* b3 = b2 + kstep;
            if (last && has_next) S.a_ready(nxt);
            if constexpr (SP2) {
            PG8_LDB(B0, 0, 0); PG8_LDB(B1, 0, 1); PG8_SCHED; PG8_LDA(At, 0, 0); PG8_STAGE(PG8_SA(1, 1), a1 + hstep, voffA);
            PG8_WAIT_V(8); PG8_WAIT_L(0); PG8_BAR; PG8_MMA(0, 0, At, B0); PG8_MMA(0, 1, At, B1); PG8_BAR; PG8_SCHED;
            PG8_LDA(At, 0, 1); PG8_STAGE(PG8_SB(0, 0), b2, voffB); PG8_STAGE(PG8_SB(0, 1), b2 + hstep, voffB); PG8_STAGE(PG8_SA(0, 0), a2, voffA);
            PG8_WAIT_V(8); PG8_WAIT_L(0); PG8_BAR; PG8_MMA(1, 0, At, B0); PG8_MMA(1, 1, At, B1); PG8_BAR; PG8_SCHED;
            PG8_LDB(B0, 1, 0); PG8_LDB(B1, 1, 1); PG8_SCHED; PG8_LDA(At, 1, 0); PG8_STAGE(PG8_SA(0, 1), a2 + hstep, voffA);
            PG8_WAIT_V(8); PG8_WAIT_L(0); PG8_BAR; PG8_MMA(0, 0, At, B0); PG8_MMA(0, 1, At, B1); PG8_BAR; PG8_SCHED;
            PG8_LDA(At, 1, 1); PG8_STAGE(PG8_SB(1, 0), b3, voffB); PG8_STAGE(PG8_SB(1, 1), b3 + hstep, voffB); PG8_STAGE(PG8_SA(1, 0), a3, voffA);
            PG8_WAIT_V(8); PG8_WAIT_L(0); PG8_BAR; PG8_MMA(1, 0, At, B0); PG8_MMA(1, 1, At, B1); PG8_BAR; PG8_SCHED;
            } else {
            PG8_LDB(B0, 0, 0); PG8_SCHED; PG8_LDA(At, 0, 0); PG8_STAGE(PG8_SA(1, 1), a1 + hstep, voffA);
            PG8_WAIT_L(8); PG8_BAR; PG8_WAIT_L(0); PG8_MMA(0, 0, At, B0); PG8_BAR; PG8_SCHED;
            PG8_LDB(B1, 0, 1); PG8_STAGE(PG8_SB(0, 0), b2, voffB);
            PG8_BAR; PG8_WAIT_L(0); PG8_MMA(0, 1, At, B1); PG8_BAR;
            PG8_LDA(At, 0, 1); PG8_STAGE(PG8_SA(0, 0), a2, voffA);
            PG8_BAR; PG8_WAIT_L(0); PG8_MMA(1, 0, At, B0); PG8_BAR; PG8_SCHED;
            PG8_STAGE(PG8_SB(0, 1), b2 + hstep, voffB);
            PG8_WAIT_V(6); PG8_BAR; PG8_MMA(1, 1, At, B1); PG8_BAR;
            PG8_LDB(B0, 1, 0); PG8_SCHED; PG8_LDA(At, 1, 0); PG8_STAGE(PG8_SA(0, 1), a2 + hstep, voffA);
            PG8_WAIT_L(8); PG8_BAR; PG8_WAIT_L(0); PG8_MMA(0, 0, At, B0); PG8_BAR; PG8_SCHED;
            PG8_LDB(B1, 1, 1); PG8_STAGE(PG8_SB(1, 0), b3, voffB);
            PG8_BAR; PG8_WAIT_L(0); PG8_MMA(0, 1, At, B1); PG8_BAR;
            PG8_LDA(At, 1, 1); PG8_STAGE(PG8_SA(1, 0), a3, voffA);
            PG8_BAR; PG8_WAIT_L(0); PG8_MMA(1, 0, At, B0); PG8_BAR; PG8_SCHED;
            PG8_STAGE(PG8_SB(1, 1), b3 + hstep, voffB);
            PG8_WAIT_V(6); PG8_BAR; PG8_MMA(1, 1, At, B1); PG8_BAR;
            }
        }
        if constexpr (ALIGN_EPI) { if (wr == 0) PG8_BAR; }
        if constexpr (!Epi::AFTER_DRAIN) { E(acc, cur, wr, wc, fr, fq); S.done(cur); }
        if (!has_next) break;
#pragma unroll
        for (int a = 0; a < 2; ++a)
#pragma unroll
            for (int b = 0; b < 2; ++b)
#pragma unroll
                for (int m = 0; m < 4; ++m)
#pragma unroll
                    for (int n = 0; n < 2; ++n) acc[a][b][m][n] = (acc_t){0, 0, 0, 0};
        cur = nxt; cA = nA; cB = nB; ++ui;
        if constexpr (ALIGN_EPI) { if (wr == 1) PG8_BAR; }
    }
    PG8_WAIT_V(0);
    if constexpr (!ALIGN_EPI) { if (wr == 0) PG8_BAR; }
    PG8_BAR;
    if constexpr (Epi::AFTER_DRAIN) { E.fused(acc, cur, wr, wc, fr, fq, lds, wid, lane); S.done(cur); }
#undef PG8_SA
#undef PG8_SB
#undef PG8_STAGE
#undef PG8_LDA
#undef PG8_LDB
#undef PG8_MMA
#undef PG8_WAIT_V
#undef PG8_WAIT_L
#undef PG8_BAR
#undef PG8_SCHED
}
}
constexpr int NB = 16, SEQ = 2048, CTXL = 256, D = 1024;
constexpr int ML = NB * SEQ, MC = NB * CTXL, MT = ML + MC;
constexpr int INW = 4128, PW = 4096, NIN = 4352;
constexpr int DFF = 2816, NEXP = 8, DEXP = 3584;
constexpr int NWAVES = 8, NTHR = 512;
constexpr float EPS = 1e-6f;
constexpr int PH_M0 = 16, NPHASE = 21;
constexpr int CHUNK_PAN = 128, NCHK = 256 / CHUNK_PAN;
constexpr int NPOS = CTXL + SEQ, PBLK_G = 256, PBLK_H = 768;
constexpr size_t PH_OFF = (size_t)NB * 4 * NPOS * PBLK_G;
constexpr int HS_ROWS = 2 * ML + NEXP * 256;

constexpr size_t MiB = 1u << 20;
constexpr size_t WS_CTL = 0, CTL_ZERO_BYTES = 1 * MiB;
constexpr size_t WS_MODS = 1 * MiB, WS_ROUTE = 2 * MiB, WS_GR = 4 * MiB, WS_WIN = 7 * MiB, WS_WOUT = 24 * MiB, WS_F13 = 28 * MiB, WS_F2 = 39 * MiB;
constexpr size_t WS_XC = 45 * MiB, WS_H = 61 * MiB, WS_OB = 133 * MiB, WS_G = 205 * MiB, WS_P = 277 * MiB, WS_END = 565 * MiB;
constexpr size_t WS_MIX = WS_P, WS_ACT0 = WS_P, WS_HS = WS_OB, WS_ACT = 265 * MiB, WS_HSQ = 503 * MiB, WS_END2 = 576 * MiB;
constexpr size_t DO_M2 = 0, DO_M13Q = 64 * MiB;
constexpr size_t WS_HQ = WS_H, WS_SB13 = WS_GR + 2621440, WS_SBIN = WS_GR + 2883584, WS_SBF = WS_SBIN + 32768, WS_SBO = WS_SBF + 32768, WS_SAR = WS_SBO + 8192;
constexpr size_t WS_X3 = WS_H, WS_HQ2 = WS_OB;
constexpr size_t WS_WINQ = WS_WIN + MiB, WS_MIXQ = WS_MIX;
static_assert(WS_GR + (size_t)MT * 32 * 2 <= WS_WIN && WS_WIN + 2ull * NIN * 1024 * 2 <= WS_WOUT && WS_F13 + 5632ull * 1024 * 2 <= WS_F2 && WS_F2 + 1024ull * DFF * 2 <= WS_XC, "ws map 1");
static_assert(WS_XC + (size_t)MC * D * 4 <= WS_H && WS_H + (size_t)MT * D * 2 <= WS_OB && WS_OB + (size_t)MT * D * 2 <= WS_G && WS_G + (size_t)MT * D * 2 <= WS_P && WS_P + (size_t)MT * PW * 2 <= WS_END, "ws map 2");
static_assert(WS_ACT0 + (size_t)MT * DFF * 2 <= WS_END && WS_HS + (size_t)HS_ROWS * D * 2 <= WS_ACT && WS_ACT + (size_t)(CHUNK_PAN + 8) * 256 * DEXP * 2 <= WS_HSQ && DO_M2 + 8ull * 1024 * DEXP * 2 <= DO_M13Q && DO_M13Q + 8ull * 7168 * 1024 <= (size_t)ML * D * 4 && WS_HSQ + (size_t)HS_ROWS * D <= WS_END2, "ws map 3");
static_assert(WS_HQ + (size_t)ML * D <= WS_OB && WS_SB13 + 8 * 7168 * 4 <= WS_SBIN && WS_SAR + (size_t)MT * 4 <= WS_WIN && WS_HQ + (size_t)MT * D <= WS_OB && WS_WINQ + 2ull * 4096 * 1024 <= WS_WOUT, "mix vs moe weights; int8 rows; scales");
constexpr int MO_LAT = 0, MO_CTX = 2 * 16 * 6144, MO_LB = MO_CTX + 2 * 6144;
constexpr size_t RT_SEL = 0, RT_W = 512 * 1024, RT_CNT = 768 * 1024, RT_GW = 1024 * 1024, RT_SA = 1536 * 1024, RT_SAN = 1792 * 1024;
constexpr int CW_TMO = 0, CW_CODE = 1, CW_BAR = 4096, CW_CM = 131072;
constexpr int RING_BYTES = 131072, LDSCTL_OFF = RING_BYTES, MISC_OFF = LDSCTL_OFF + 320, TAB_OFF = LDSCTL_OFF + 512, LDS_BYTES = 147456;

#define GAS __attribute__((address_space(1)))
#define LAS __attribute__((address_space(3)))
typedef unsigned short bf16;
typedef unsigned v4u __attribute__((ext_vector_type(4)));
typedef unsigned v2u __attribute__((ext_vector_type(2)));
typedef int v4i __attribute__((ext_vector_type(4)));
typedef float f32x4 __attribute__((ext_vector_type(4)));
typedef float f32x2v __attribute__((ext_vector_type(2)));
#define LDS_WAIT() asm volatile("s_waitcnt lgkmcnt(0)" ::: "memory")
#define VM_WAIT() asm volatile("s_waitcnt vmcnt(0)" ::: "memory")
typedef float f32x2_t __attribute__((ext_vector_type(2)));
typedef __bf16 bf16x2_t __attribute__((ext_vector_type(2)));
__device__ __forceinline__ unsigned cvtpk(float lo, float hi) { f32x2_t v = {lo, hi}; bf16x2_t b = __builtin_convertvector(v, bf16x2_t); return __builtin_bit_cast(unsigned, b); }
__device__ __forceinline__ unsigned f2bf(float f) { unsigned u = __builtin_bit_cast(unsigned, f); return (u + 0x7fffu + ((u >> 16) & 1u)) >> 16; }
__device__ __forceinline__ unsigned pk2(float lo, float hi) { return cvtpk(lo, hi); }
__device__ __forceinline__ float bf2f(unsigned b) { return __builtin_bit_cast(float, b << 16); }
__device__ __forceinline__ float bflo(unsigned w) { return __builtin_bit_cast(float, w << 16); }
__device__ __forceinline__ float bfhi(unsigned w) { return __builtin_bit_cast(float, w & 0xffff0000u); }
__device__ __forceinline__ float wave_sum(float v) {
#pragma unroll
    for (int o = 1; o < 64; o <<= 1) v += __shfl_xor(v, o);
    return v;
}
__device__ __forceinline__ float silu_f(float x) { return x * __builtin_amdgcn_rcpf(1.f + __expf(-x)); }
__device__ __forceinline__ float logsig_f(float x) { return fminf(x, 0.f) - __logf(1.f + __expf(-fabsf(x))); }

#define XB_TMO      128
#define XB_XCNT(j)  (256  + 64 * (j))
#define XB_XSUB(j)  (1280 + 64 * (j))
#define XB_XGEN(j)  (2304 + 64 * (j))
#define XB_TOP      3328
#define XB_TOPGEN   3392
#define XCD_BAR_WORDS 3456
#define XB_SPIN_CAP (1u << 18)

__device__ __forceinline__ unsigned xb_ld(unsigned* p)              { return __hip_atomic_load(p, __ATOMIC_RELAXED, __HIP_MEMORY_SCOPE_AGENT); }
__device__ __forceinline__ unsigned xb_add(unsigned* p, unsigned v) { return __hip_atomic_fetch_add(p, v, __ATOMIC_RELAXED, __HIP_MEMORY_SCOPE_AGENT); }
__device__ __forceinline__ unsigned xb_xcc_id() { return (unsigned)__builtin_amdgcn_s_getreg((3 << 11) | 20) & 0xFu; }
#define XB_SPIN(cond, bar) do { unsigned _sp = 0; while (cond) { __builtin_amdgcn_s_sleep(1); \
    if ((++_sp & 255u) == 0u) { if (xb_ld(&(bar)[XB_TMO])) break; if (_sp > XB_SPIN_CAP) { atomicAdd(&(bar)[XB_TMO], 1u); break; } } } } while (0)

struct XcdBarrier {
    unsigned* bar; unsigned x;
    volatile LAS unsigned* st;
};

__device__ __forceinline__ XcdBarrier xcd_barrier_post(unsigned* bar, volatile LAS unsigned* st) {
    XcdBarrier b; b.bar = bar; b.x = xb_xcc_id(); b.st = st;
    if (threadIdx.x == 0) (void)xb_add(&bar[XB_XCNT(b.x)], 1u);
    return b;
}
__device__ __forceinline__ void xcd_barrier_complete(unsigned* bar, unsigned x, unsigned& nloc, unsigned& nx) {
    const unsigned G = gridDim.x * gridDim.y * gridDim.z;
    unsigned sum, cnt, mine, sp = 0u;
    for (;;) {
        sum = 0u; cnt = 0u; mine = 0u;
#pragma unroll
        for (unsigned j = 0; j < 16; ++j) { const unsigned c = xb_ld(&bar[XB_XCNT(j)]); sum += c; cnt += (c > 0u) ? 1u : 0u; mine = (j == x) ? c : mine; }
        if (sum == G) break;
        __builtin_amdgcn_s_sleep(1);
        if ((++sp & 255u) == 0u) { if (xb_ld(&bar[XB_TMO])) break; if (sp > XB_SPIN_CAP) { atomicAdd(&bar[XB_TMO], 1u); break; } }
    }
    nloc = mine > 0u ? mine : 1u; nx = cnt > 0u ? cnt : 1u;
}

template <bool LIGHT = false> __device__ __forceinline__ void xcd_barrier(const XcdBarrier& b) {
    asm volatile("s_waitcnt vmcnt(0)" ::: "memory");
    __syncthreads();
    if (threadIdx.x == 0) {
        unsigned* bar = b.bar;
        __builtin_amdgcn_s_waitcnt(0);
        unsigned nloc = b.st[0], nx = b.st[1];
        if (nloc == 0u) { xcd_barrier_complete(bar, b.x, nloc, nx); b.st[0] = nloc; b.st[1] = nx; }
        const unsigned old = xb_add(&bar[XB_XSUB(b.x)], 1u);
        const unsigned gen = old / nloc;
        if (old + 1u == (gen + 1u) * nloc) {
            if constexpr (!LIGHT) __builtin_amdgcn_fence(__ATOMIC_RELEASE, "agent");
            asm volatile("s_waitcnt vmcnt(0)" ::: "memory");
            const unsigned og = xb_add(&bar[XB_TOP], 1u);
            const unsigned tg = og / nx;
            if (og + 1u == (tg + 1u) * nx) xb_add(&bar[XB_TOPGEN], 1u);
            else XB_SPIN(xb_ld(&bar[XB_TOPGEN]) == tg, bar);
            if constexpr (!LIGHT) __builtin_amdgcn_fence(__ATOMIC_ACQUIRE, "agent");
            xb_add(&bar[XB_XGEN(b.x)], 1u);
            asm volatile("s_waitcnt vmcnt(0)" ::: "memory");
        } else {
            XB_SPIN(xb_ld(&bar[XB_XGEN(b.x)]) == gen, bar);
            if constexpr (!LIGHT) __builtin_amdgcn_fence(__ATOMIC_ACQUIRE, "agent");
            asm volatile("s_waitcnt vmcnt(0)" ::: "memory");
        }
    }
    __syncthreads();
}
using pg8::Unit;
template <bool Q> struct EpiInProjT {
    static constexpr bool PERM = true, AFTER_DRAIN = false, I8 = Q;
    typedef typename pg8::AccSel<Q>::T acc_t;
    bf16* P; bf16* G; bf16* GR; const float* LB; const float* SA; const float* SB;
    __device__ __forceinline__ void cvt8(const acc_t& v0, const acc_t& v1, const Unit& u, int row, int ct, float (&a)[8]) const {
        if constexpr (Q) { const float s = SA[row]; const f32x4 b0 = *(const f32x4*)(SB + u.pn * 256 + ct), b1 = *(const f32x4*)(SB + u.pn * 256 + ct + 4);
            a[0] = (float)v0[0] * (s * b0.x); a[1] = (float)v0[1] * (s * b0.y); a[2] = (float)v0[2] * (s * b0.z); a[3] = (float)v0[3] * (s * b0.w); a[4] = (float)v1[0] * (s * b1.x); a[5] = (float)v1[1] * (s * b1.y); a[6] = (float)v1[2] * (s * b1.z); a[7] = (float)v1[3] * (s * b1.w); }
        else { a[0] = v0[0]; a[1] = v0[1]; a[2] = v0[2]; a[3] = v0[3]; a[4] = v1[0]; a[5] = v1[1]; a[6] = v1[2]; a[7] = v1[3]; } }
    __device__ __forceinline__ void operator()(const acc_t (&acc)[2][2][4][2], const Unit& u, int wr, int wc, int fr, int fq) const {
        const int pn = u.pn;
        const int row0 = u.pm * 256 + wr * 64 + fr, cin = wc * 32 + 8 * fq;
        if (pn == 16) {
            if (wc == 0) {
#pragma unroll
                for (int ai = 0; ai < 2; ++ai)
#pragma unroll
                    for (int m = 0; m < 4; ++m) { float a[8]; cvt8(acc[ai][0][m][0], acc[ai][0][m][1], u, row0 + ai * 128 + m * 16, 8 * fq, a); v4u w; w.x = pk2(a[0], a[1]); w.y = pk2(a[2], a[3]); w.z = pk2(a[4], a[5]); w.w = pk2(a[6], a[7]);
                        *(v4u*)(GR + (size_t)(row0 + ai * 128 + m * 16) * 32 + 8 * fq) = w; }
            }
            return;
        }
        if (pn == 4 || pn == 5 || pn >= 14) {
            const int dcol = (pn >= 14) ? 512 + 256 * (pn - 14) : 256 * (pn - 4);
#pragma unroll
            for (int ai = 0; ai < 2; ++ai)
#pragma unroll
                for (int m = 0; m < 4; ++m)
#pragma unroll
                    for (int bj = 0; bj < 2; ++bj) { float a[8]; cvt8(acc[ai][bj][m][0], acc[ai][bj][m][1], u, row0 + ai * 128 + m * 16, bj * 128 + cin, a);
                        v4u w; w.x = pk2(a[0], a[1]); w.y = pk2(a[2], a[3]); w.z = pk2(a[4], a[5]); w.w = pk2(a[6], a[7]);
                        *(v4u*)(G + (size_t)(row0 + ai * 128 + m * 16) * 1024 + dcol + bj * 128 + cin) = w; }
            return;
        }
        const bool gla = pn <= 3; const int blk = gla ? PBLK_G : PBLK_H;
        int mode = 1, hdv[2], tof[2], tof2 = 0; const float* lbp = LB;
#pragma unroll
        for (int bj = 0; bj < 2; ++bj) { const int c = bj * 128 + cin;
            if (pn == 0) { mode = 0; hdv[bj] = c >> 6; tof[bj] = (c & 63); }
            else if (pn == 1) { hdv[bj] = c >> 6; tof[bj] = 64 + (c & 63); }
            else if (pn <= 3) { hdv[bj] = 2 * (pn - 2) + bj; tof[bj] = 128 + cin; }
            else if (pn <= 7) { mode = 2; hdv[bj] = 2 * (pn - 6) + bj; tof[bj] = 384 + cin; }
            else if (pn <= 9) { mode = 3; hdv[bj] = 2 * (pn - 8) + bj; tof[bj] = 512 + cin; tof2 = 128; lbp = LB + 256 * (pn - 8); }
            else if (pn <= 11) { mode = 3; hdv[bj] = 2 * (pn - 10) + bj; tof[bj] = cin; tof2 = 128; lbp = LB + 512 + 256 * (pn - 10); }
            else { hdv[bj] = 2 * (pn - 12) + bj; tof[bj] = 256 + cin; } }
        bf16* Pp = P + (gla ? 0 : PH_OFF);
        float lb[2][8];
        if (mode == 3) {
#pragma unroll
            for (int bj = 0; bj < 2; ++bj)
#pragma unroll
                for (int j = 0; j < 8; ++j) lb[bj][j] = lbp[bj * 128 + cin + j];
        }
#pragma unroll
        for (int ai = 0; ai < 2; ++ai)
#pragma unroll
            for (int m = 0; m < 4; ++m) {
                const int row = row0 + ai * 128 + m * 16; int b, pos;
                if (row < ML) { b = row >> 11; const int t = row & (SEQ - 1); pos = CTXL + (gla ? t : ((t & 63) * 32 + (t >> 6))); } else { b = (row - ML) >> 8; pos = (row - ML) & (CTXL - 1); }
#pragma unroll
                for (int bj = 0; bj < 2; ++bj) {
                    bf16* dp = Pp + ((size_t)(b * 4 + hdv[bj]) * NPOS + pos) * blk + tof[bj];
                    float a[8]; cvt8(acc[ai][bj][m][0], acc[ai][bj][m][1], u, row, bj * 128 + cin, a);
                    if (mode == 3) {
#pragma unroll
                        for (int j = 0; j < 8; ++j) { const float e = __expf(-fabsf(a[j])), r = __builtin_amdgcn_rcpf(1.f + e), sn = a[j] >= 0.f ? e * r : r;
                            a[j] = (1.f - lb[bj][j]) * sn; } }
                    else if (mode == 0) {
#pragma unroll
                        for (int j = 0; j < 8; ++j) a[j] *= 0.125f; }
                    else if (mode == 2) {
#pragma unroll
                        for (int j = 0; j < 8; ++j) a[j] = silu_f(a[j]); }
                    v4u w; w.x = pk2(a[0], a[1]); w.y = pk2(a[2], a[3]); w.z = pk2(a[4], a[5]); w.w = pk2(a[6], a[7]);
                    *(v4u*)dp = w;
                }
            }
    }
};
template <bool Q> struct EpiResidT {
    static constexpr bool PERM = false, AFTER_DRAIN = false, I8 = Q;
    typedef typename pg8::AccSel<Q>::T acc_t;
    const float* base_lat; const float* base_ctx; float* out_lat; float* out_ctx; const float* gate_lat; const float* gate_ctx; const float* SA; const float* SB;
    __device__ __forceinline__ void operator()(const acc_t (&acc)[2][2][4][2], const Unit& u, int wr, int wc, int fr, int fq) const {
        const int prow = u.pm * 256; const float* base; float* out; const float* gate; int r0;
        if (prow < ML) { base = base_lat; out = out_lat; gate = gate_lat + (prow >> 11) * 6144; r0 = prow; }
        else { base = base_ctx; out = out_ctx; gate = gate_ctx; r0 = prow - ML; }
        const int row0 = r0 + wr * 64 + fr, col0 = u.pn * 256 + wc * 32 + 4 * fq;
        pg8::f32x4 gv[2][2];
#pragma unroll
        for (int bj = 0; bj < 2; ++bj)
#pragma unroll
            for (int n = 0; n < 2; ++n) { gv[bj][n] = *(const pg8::f32x4*)(gate + col0 + bj * 128 + n * 16); if constexpr (Q) gv[bj][n] = gv[bj][n] * *(const pg8::f32x4*)(SB + col0 + bj * 128 + n * 16); }
#pragma unroll
        for (int ai = 0; ai < 2; ++ai) {
            pg8::f32x4 bs[4][2][2];
#pragma unroll
            for (int m = 0; m < 4; ++m) { const size_t off = (size_t)(row0 + ai * 128 + m * 16) * D + col0;
#pragma unroll
                for (int bj = 0; bj < 2; ++bj)
#pragma unroll
                    for (int n = 0; n < 2; ++n) bs[m][bj][n] = *(const pg8::f32x4*)(base + off + bj * 128 + n * 16); }
#pragma unroll
            for (int m = 0; m < 4; ++m) { const size_t off = (size_t)(row0 + ai * 128 + m * 16) * D + col0;
#pragma unroll
                for (int bj = 0; bj < 2; ++bj)
#pragma unroll
                    for (int n = 0; n < 2; ++n) { pg8::f32x4 av; if constexpr (Q) { const float s = SA[u.pm * 256 + wr * 64 + fr + ai * 128 + m * 16]; av = (pg8::f32x4){(float)acc[ai][bj][m][n][0] * s, (float)acc[ai][bj][m][n][1] * s, (float)acc[ai][bj][m][n][2] * s, (float)acc[ai][bj][m][n][3] * s}; } else av = acc[ai][bj][m][n];
                        *(pg8::f32x4*)(out + off + bj * 128 + n * 16) = bs[m][bj][n] + gv[bj][n] * av; } }
            asm volatile("" ::: "memory"); }
    }
};
template <bool F32IN> struct EpiResidB {
    static constexpr bool PERM = true, AFTER_DRAIN = false, I8 = false;
    const void* in_lat; const void* in_ctx; bf16* out_lat; bf16* out_ctx; const float* gate_lat; const float* gate_ctx;
    __device__ __forceinline__ void operator()(const pg8::f32x4 (&acc)[2][2][4][2], const Unit& u, int wr, int wc, int fr, int fq) const {
        const int prow = u.pm * 256; const unsigned char* base; bf16* out; const float* gate; int r0;
        if (prow < ML) { base = (const unsigned char*)in_lat; out = out_lat; gate = gate_lat + (prow >> 11) * 6144; r0 = prow; }
        else { base = (const unsigned char*)in_ctx; out = out_ctx; gate = gate_ctx; r0 = prow - ML; }
        const int row0 = r0 + wr * 64 + fr, col0 = u.pn * 256 + wc * 32 + 8 * fq;
        pg8::f32x4 gv[2][2];
#pragma unroll
        for (int bj = 0; bj < 2; ++bj)
#pragma unroll
            for (int n = 0; n < 2; ++n) gv[bj][n] = *(const pg8::f32x4*)(gate + col0 + bj * 128 + n * 4);
        if constexpr (F32IN) {
#pragma unroll
            for (int ai = 0; ai < 2; ++ai) {
                pg8::f32x4 bs[4][2][2];
#pragma unroll
                for (int m = 0; m < 4; ++m) { const size_t off = (size_t)(row0 + ai * 128 + m * 16) * D + col0;
#pragma unroll
                    for (int bj = 0; bj < 2; ++bj)
#pragma unroll
                        for (int n = 0; n < 2; ++n) bs[m][bj][n] = *(const pg8::f32x4*)((const float*)base + off + bj * 128 + n * 4); }
#pragma unroll
                for (int m = 0; m < 4; ++m) { const size_t off = (size_t)(row0 + ai * 128 + m * 16) * D + col0;
#pragma unroll
                    for (int bj = 0; bj < 2; ++bj) { const pg8::f32x4 v0 = bs[m][bj][0] + gv[bj][0] * acc[ai][bj][m][0], v1 = bs[m][bj][1] + gv[bj][1] * acc[ai][bj][m][1];
                        v4u w; w.x = pk2(v0[0], v0[1]); w.y = pk2(v0[2], v0[3]); w.z = pk2(v1[0], v1[1]); w.w = pk2(v1[2], v1[3]);
                        *(v4u*)(out + off + bj * 128) = w; } }
                asm volatile("" ::: "memory"); }
        } else {
#pragma unroll
            for (int ai = 0; ai < 2; ++ai) {
                v4u bs[4][2];
#pragma unroll
                for (int m = 0; m < 4; ++m) { const size_t off = (size_t)(row0 + ai * 128 + m * 16) * D + col0;
#pragma unroll
                    for (int bj = 0; bj < 2; ++bj) bs[m][bj] = *(const v4u*)((const bf16*)base + off + bj * 128); }
#pragma unroll
                for (int m = 0; m < 4; ++m) { const size_t off = (size_t)(row0 + ai * 128 + m * 16) * D + col0;
#pragma unroll
                    for (int bj = 0; bj < 2; ++bj) { const v4u b = bs[m][bj]; const pg8::f32x4 a0 = acc[ai][bj][m][0], a1 = acc[ai][bj][m][1], g0 = gv[bj][0], g1 = gv[bj][1];
                        v4u w; w.x = pk2(bflo(b.x) + g0[0] * a0[0], bfhi(b.x) + g0[1] * a0[1]); w.y = pk2(bflo(b.y) + g0[2] * a0[2], bfhi(b.y) + g0[3] * a0[3]);
                        w.z = pk2(bflo(b.z) + g1[0] * a1[0], bfhi(b.z) + g1[1] * a1[1]); w.w = pk2(bflo(b.w) + g1[2] * a1[2], bfhi(b.w) + g1[3] * a1[3]);
                        *(v4u*)(out + off + bj * 128) = w; } }
                asm volatile("" ::: "memory"); }
        }
    }
};
typedef EpiInProjT<false> EpiInProj; typedef EpiResidT<false> EpiResid;
struct EpiSwiGLU {
    static constexpr bool PERM = true, AFTER_DRAIN = false, I8 = false;
    bf16* ACT; int ldc, tiles, pm_off;
    __device__ __forceinline__ void operator()(const pg8::f32x4 (&acc)[2][2][4][2], const Unit& u, int wr, int wc, int fr, int fq) const {
        const int row0 = (u.pm - pm_off) * 256 + wr * 64 + fr, col0 = (u.pn % tiles) * 128 + wc * 32 + 8 * fq;
#pragma unroll
        for (int ai = 0; ai < 2; ++ai)
#pragma unroll
            for (int m = 0; m < 4; ++m) {
                const pg8::f32x4 g0 = acc[ai][0][m][0], g1 = acc[ai][0][m][1], u0 = acc[ai][1][m][0], u1 = acc[ai][1][m][1];
                float o[8];
#pragma unroll
                for (int j = 0; j < 4; ++j) { o[j] = silu_f(g0[j]) * u0[j]; o[4 + j] = silu_f(g1[j]) * u1[j]; }
                v4u w; w.x = pk2(o[0], o[1]); w.y = pk2(o[2], o[3]); w.z = pk2(o[4], o[5]); w.w = pk2(o[6], o[7]);
                *(v4u*)(ACT + (size_t)(row0 + ai * 128 + m * 16) * ldc + col0) = w;
            }
    }
};
struct EpiSwiGLUQ {
    static constexpr bool PERM = true, AFTER_DRAIN = false, I8 = true;
    bf16* ACT; int ldc, tiles, pm_off; const float* SA; const float* SB;
    __device__ __forceinline__ void operator()(const pg8::i32x4 (&acc)[2][2][4][2], const Unit& u, int wr, int wc, int fr, int fq) const {
        const int arow0 = u.pm * 256 + wr * 64 + fr, row0 = (u.pm - pm_off) * 256 + wr * 64 + fr, cin = wc * 32 + 8 * fq, col0 = (u.pn % tiles) * 128 + cin;
        float sg[8], su[8];
        { const f32x4 a0 = *(const f32x4*)(SB + (size_t)u.pn * 256 + cin), a1 = *(const f32x4*)(SB + (size_t)u.pn * 256 + cin + 4), b0 = *(const f32x4*)(SB + (size_t)u.pn * 256 + 128 + cin), b1 = *(const f32x4*)(SB + (size_t)u.pn * 256 + 128 + cin + 4);
          sg[0] = a0.x; sg[1] = a0.y; sg[2] = a0.z; sg[3] = a0.w; sg[4] = a1.x; sg[5] = a1.y; sg[6] = a1.z; sg[7] = a1.w; su[0] = b0.x; su[1] = b0.y; su[2] = b0.z; su[3] = b0.w; su[4] = b1.x; su[5] = b1.y; su[6] = b1.z; su[7] = b1.w; }
        float sa[2][4];
#pragma unroll
        for (int ai = 0; ai < 2; ++ai)
#pragma unroll
            for (int m = 0; m < 4; ++m) sa[ai][m] = SA[arow0 + ai * 128 + m * 16];
#pragma unroll
        for (int ai = 0; ai < 2; ++ai)
#pragma unroll
            for (int m = 0; m < 4; ++m) {
                const pg8::i32x4 g0 = acc[ai][0][m][0], g1 = acc[ai][0][m][1], u0 = acc[ai][1][m][0], u1 = acc[ai][1][m][1]; const float s = sa[ai][m];
                float o[8];
#pragma unroll
                for (int j = 0; j < 4; ++j) { o[j] = silu_f((float)g0[j] * (s * sg[j])) * ((float)u0[j] * (s * su[j])); o[4 + j] = silu_f((float)g1[j] * (s * sg[4 + j])) * ((float)u1[j] * (s * su[4 + j])); }
                v4u w; w.x = pk2(o[0], o[1]); w.y = pk2(o[2], o[3]); w.z = pk2(o[4], o[5]); w.w = pk2(o[6], o[7]);
                *(v4u*)(ACT + (size_t)(row0 + ai * 128 + m * 16) * ldc + col0) = w;
            }
    }
};
struct EpiMoeOut {
    static constexpr bool PERM = true, AFTER_DRAIN = false, I8 = false;
    bf16* Y; const float* GW; int pm_off;
    __device__ __forceinline__ void operator()(const pg8::f32x4 (&acc)[2][2][4][2], const Unit& u, int wr, int wc, int fr, int fq) const {
        const int row0 = (u.pm + pm_off) * 256 + wr * 64 + fr, col0 = (u.pn & 3) * 256 + wc * 32 + 8 * fq;
        float gwv[2][4];
#pragma unroll
        for (int ai = 0; ai < 2; ++ai)
#pragma unroll
            for (int m = 0; m < 4; ++m) gwv[ai][m] = GW[row0 + ai * 128 + m * 16];
#pragma unroll
        for (int ai = 0; ai < 2; ++ai)
#pragma unroll
            for (int m = 0; m < 4; ++m) { const int row = row0 + ai * 128 + m * 16; const float gw = gwv[ai][m];
#pragma unroll
                for (int bj = 0; bj < 2; ++bj) { const pg8::f32x4 v0 = acc[ai][bj][m][0] * gw, v1 = acc[ai][bj][m][1] * gw;
                    v4u w; w.x = pk2(v0[0], v0[1]); w.y = pk2(v0[2], v0[3]); w.z = pk2(v1[0], v1[1]); w.w = pk2(v1[2], v1[3]);
                    *(v4u*)(Y + (size_t)row * D + col0 + bj * 128) = w; } }
    }
};
struct MoeOrder {
    int nM, nN, nwg, G, c, pan0, a_local, nb, keep; int pb[8];
    __device__ __forceinline__ void init(int nM_, int nN_, int G_, int c_, int pan0_, int a_local_) { nM = nM_; nN = nN_; nwg = nM * nN; G = G_; c = c_; pan0 = pan0_; a_local = a_local_; nb = 0; keep = 4; }
    __device__ __forceinline__ bool next(int i, Unit& u) const {
        long L = (long)i * G + c;
        if (nb > 0) { const int rounds = (nwg + G - 1) / G;
            if (c < nb) { if (i >= keep) return false; }
            else if (i >= rounds) { const int e = c - nb + (i - rounds) * (G - nb); if (e >= (rounds - keep) * nb) return false; L = (long)(keep + e / nb) * G + (e % nb); } }
        if (L >= nwg) return false;
        int wgid = (int)L; { const int q = nwg / 8, r = nwg % 8, xcd = wgid % 8, off = wgid / 8; wgid = (xcd < r ? xcd * (q + 1) : r * (q + 1) + (xcd - r) * q) + off; }
        const int nig = 8 * nN, gid = wgid / nig, fm = gid * 8, gsz = (nM - fm) < 8 ? (nM - fm) : 8;
        const int pml = fm + ((wgid % nig) % gsz), pnl = (wgid % nig) / gsz, gp = pan0 + pml;
        int e = 0;
#pragma unroll
        for (int j = 1; j < 8; ++j) e += (gp >= pb[j]) ? 1 : 0;
        u.pm = a_local ? pml : gp; u.pn = e * nN + pnl; return true;
    }
    __device__ __forceinline__ void a_ready(const Unit&) const {}
    __device__ __forceinline__ void done(const Unit&) const {}
};


#if defined(PROBE_EXTRA)
        struct EpiNull { static constexpr bool PERM = true, AFTER_DRAIN = false, I8 = false; float* sink;
            __device__ __forceinline__ void operator()(const pg8::f32x4 (&acc)[2][2][4][2], const Unit& u, int wr, int wc, int fr, int fq) const { float s = 0.f;
#pragma unroll
                for (int a = 0; a < 2; ++a)
#pragma unroll
                    for (int b = 0; b < 2; ++b)
#pragma unroll
                        for (int mm = 0; mm < 4; ++mm)
#pragma unroll
                            for (int n = 0; n < 2; ++n) s += acc[a][b][mm][n][0] + acc[a][b][mm][n][1] + acc[a][b][mm][n][2] + acc[a][b][mm][n][3];
                if (s == 123456.789f) sink[threadIdx.x] = s; } };
        struct SameOrder : pg8::StaticOrder { int same; __device__ __forceinline__ bool next(int i, Unit& u) const { const bool r = pg8::StaticOrder::next(i, u); if (same) { u.pm = 0; u.pn = 0; } return r; } };

#endif
struct Args { const float* in[23]; float* out; unsigned char* ws; int ph_lo, ph_hi; };
typedef const __attribute__((address_space(4))) Args* KA;
__device__ __forceinline__ KA kargs() { KA p = (KA)__builtin_amdgcn_kernarg_segment_ptr(); asm volatile("" : "+s"(p)); return p; }
enum { I_X = 0, I_C, I_CTX, I_CCTX, I_WMOD, I_BMOD, I_N1G, I_N2G, I_WIN, I_GW2, I_GB, I_GLAG, I_HGG, I_HLB, I_WOUT, I_F1, I_F3, I_F2, I_ROUTER, I_M1, I_M3, I_M2, I_FNG };

__device__ __forceinline__ void tr_block(const float* W, int ldw, int col0, int k0, bf16* WT, int K, int drow0, LAS float* scr, int lane) {
    f32x4 v[8]; const int lr = lane >> 3, lc = 4 * (lane & 7);
#pragma unroll
    for (int i = 0; i < 8; ++i) v[i] = *(const f32x4*)(W + (size_t)(k0 + 8 * i + lr) * ldw + col0 + lc);
#pragma unroll
    for (int i = 0; i < 8; ++i) { LAS float* s = scr + (8 * i + lr) * 33 + lc; s[0] = v[i].x; s[1] = v[i].y; s[2] = v[i].z; s[3] = v[i].w; }
    LDS_WAIT(); asm volatile("" ::: "memory");
    const int c = lane & 7;
#pragma unroll
    for (int j = 0; j < 4; ++j) { const int n = (lane >> 3) + 8 * j; const LAS float* s = scr + (8 * c) * 33 + n;
        v4u o; o.x = pk2(s[0 * 33], s[1 * 33]); o.y = pk2(s[2 * 33], s[3 * 33]); o.z = pk2(s[4 * 33], s[5 * 33]); o.w = pk2(s[6 * 33], s[7 * 33]);
        *(v4u*)(WT + (size_t)(drow0 + n) * K + k0 + 8 * c) = o; }
    LDS_WAIT(); asm volatile("" ::: "memory");
}

__device__ __forceinline__ void tr_block_q(const float* W, int ldw, int col0, int k0, signed char* WQ, int K, int drow0, const float* sc, LAS float* scr, int lane) {
    f32x4 v[8]; const int lr = lane >> 3, lc = 4 * (lane & 7);
#pragma unroll
    for (int i = 0; i < 8; ++i) v[i] = *(const f32x4*)(W + (size_t)(k0 + 8 * i + lr) * ldw + col0 + lc);
#pragma unroll
    for (int i = 0; i < 8; ++i) { LAS float* s = scr + (8 * i + lr) * 33 + lc; s[0] = v[i].x; s[1] = v[i].y; s[2] = v[i].z; s[3] = v[i].w; }
    LDS_WAIT(); asm volatile("" ::: "memory");
    const int c = lane & 7;
#pragma unroll
    for (int j = 0; j < 4; ++j) { const int n = (lane >> 3) + 8 * j; const LAS float* s = scr + (8 * c) * 33 + n; const float inv = __builtin_amdgcn_rcpf(sc[drow0 + n]);
        int q[8];
#pragma unroll
        for (int e = 0; e < 8; ++e) { const float t = fminf(fmaxf(__builtin_rintf(s[e * 33] * inv), -127.f), 127.f); q[e] = (int)t & 255; }
        v2u o; o.x = (unsigned)q[0] | ((unsigned)q[1] << 8) | ((unsigned)q[2] << 16) | ((unsigned)q[3] << 24); o.y = (unsigned)q[4] | ((unsigned)q[5] << 8) | ((unsigned)q[6] << 16) | ((unsigned)q[7] << 24);
        *(v2u*)(WQ + (size_t)(drow0 + n) * K + k0 + 8 * c) = o; }
    LDS_WAIT(); asm volatile("" ::: "memory");
}

__device__ __forceinline__ void colmax_rows_item(KA a, int it, int tid) {
    const int e = it >> 5, which = (it >> 4) & 1, rb = it & 15;
    const float* W = (which ? a->in[I_M3] : a->in[I_M1]) + (size_t)e * 1024 * DEXP + (size_t)(64 * rb) * DEXP + tid;
    float mx[7];
#pragma unroll
    for (int j = 0; j < 7; ++j) mx[j] = 0.f;
    for (int r = 0; r < 64; r += 4) { float w[4][7];
#pragma unroll
        for (int i = 0; i < 4; ++i)
#pragma unroll
            for (int j = 0; j < 7; ++j) w[i][j] = W[(size_t)(r + i) * DEXP + 512 * j];
#pragma unroll
        for (int i = 0; i < 4; ++i)
#pragma unroll
            for (int j = 0; j < 7; ++j) mx[j] = fmaxf(mx[j], fabsf(w[i][j])); }
    unsigned* cm = (unsigned*)(a->ws + WS_CTL) + CW_CM + (e * 2 + which) * DEXP + tid;
#pragma unroll
    for (int j = 0; j < 7; ++j) atomicMax(cm + 512 * j, __builtin_bit_cast(unsigned, mx[j]));
}
__device__ __forceinline__ void colscale_item(KA a, int it, LAS unsigned char* lds, int tid, int lane, int wave) {
    LAS float* red = (LAS float*)lds;
    const int e = it / 112, r = it % 112, which = r / 56, g = r % 56;
    const float* W = (which ? a->in[I_M3] : a->in[I_M1]) + (size_t)e * 1024 * DEXP + 64 * g + lane;
    float mx = 0.f;
    for (int k0 = wave * 128; k0 < wave * 128 + 128; k0 += 32) { float w[32];
#pragma unroll
        for (int i = 0; i < 32; ++i) w[i] = W[(size_t)(k0 + i) * DEXP];
#pragma unroll
        for (int i = 0; i < 32; ++i) mx = fmaxf(mx, fabsf(w[i])); }
    red[wave * 64 + lane] = mx;
    __syncthreads();
    if (tid < 64) { float m = red[tid];
#pragma unroll
        for (int w = 1; w < 8; ++w) m = fmaxf(m, red[w * 64 + tid]);
        ((float*)(a->ws + WS_SB13))[(size_t)e * 7168 + 256 * (g >> 1) + 128 * which + 64 * (g & 1) + tid] = fmaxf(m, 1e-30f) * (1.f / 127.f); }
    __syncthreads();
}

__device__ __forceinline__ void colscale32(const float* W, int ldw, int K, int col0, float* dst, LAS unsigned char* lds, int tid, int lane, int wave) {
    LAS float* red = (LAS float*)lds; const int c = lane & 31, rh = lane >> 5; const float* p = W + (size_t)(wave * (K / 8) + rh) * ldw + col0 + c;
    float mx = 0.f;
    for (int k0 = 0; k0 < K / 16; k0 += 32) { float w[32];
#pragma unroll
        for (int i = 0; i < 32; ++i) w[i] = p[(size_t)(2 * (k0 + i)) * ldw];
#pragma unroll
        for (int i = 0; i < 32; ++i) mx = fmaxf(mx, fabsf(w[i])); }
    red[(wave * 2 + rh) * 32 + c] = mx;
    __syncthreads();
    if (tid < 32) { float m = red[tid];
#pragma unroll
        for (int w = 1; w < 16; ++w) m = fmaxf(m, red[w * 32 + tid]);
        dst[tid] = fmaxf(m, 1e-30f) * (1.f / 127.f); }
    __syncthreads();
}
constexpr int NS_WIN = 2 * 129, NS_F13 = 2 * 88, NS_WOUT = 2 * 32, NS_MAIN = NS_WIN + NS_F13;
__device__ __forceinline__ void colscale_item_main(KA a, int it, LAS unsigned char* lds, int tid, int lane, int wave) {
    unsigned char* ws = a->ws;
    if (it < NS_WIN) { const int l = it / 129, nb = it % 129; if (nb == 48) return; const int drow = nb < 48 ? 32 * nb : 32 * (nb - 1);
        colscale32(a->in[I_WIN] + (size_t)l * 1024 * INW, INW, 1024, 32 * nb, (float*)(ws + WS_SBIN) + l * 4096 + drow, lds, tid, lane, wave); return; }
    it -= NS_WIN;
    if (it < NS_F13) { const int which = it / 88, c = 32 * (it % 88); colscale32(which ? a->in[I_F3] : a->in[I_F1], DFF, 1024, c, (float*)(ws + WS_SBF) + 256 * (c >> 7) + 128 * which + (c & 127), lds, tid, lane, wave); return; }
    it -= NS_F13;
    { const int l = it / 32, nb = it % 32; colscale32(a->in[I_WOUT] + (size_t)l * 1024 * 1024, 1024, 1024, 32 * nb, (float*)(ws + WS_SBO) + l * 1024 + 32 * nb, lds, tid, lane, wave); }
}
constexpr int NQ_WIN = 2 * 16 * 129, NQ_F13 = 16 * 176, NQ_WOUT = 2 * 16 * 32, NQ_MAIN = NQ_WIN + NQ_F13;
__device__ __forceinline__ void conv_item_q(KA a, int it, LAS float* scr, int lane) {
    unsigned char* ws = a->ws;
    if (it < NQ_WIN) { const int l = it / 2064, r = it % 2064, kb = r / 129, nb = r % 129; if (nb == 48) return; const int drow = nb < 48 ? 32 * nb : 32 * (nb - 1);
        tr_block_q(a->in[I_WIN] + (size_t)l * 1024 * INW, INW, 32 * nb, 64 * kb, (signed char*)(ws + WS_WINQ) + (size_t)l * 4096 * 1024, 1024, drow, (const float*)(ws + WS_SBIN) + l * 4096, scr, lane); return; }
    it -= NQ_WIN;
    if (it < NQ_F13) { const int kb = it / 176, db = it % 176, drow = 32 * db, pn = drow >> 8, half = (drow >> 7) & 1, off = drow & 127;
        tr_block_q(half ? a->in[I_F3] : a->in[I_F1], DFF, 128 * pn + off, 64 * kb, (signed char*)(ws + WS_F13), 1024, drow, (const float*)(ws + WS_SBF), scr, lane); return; }
    it -= NQ_F13;
    { const int l = it / 512, r = it % 512, kb = r / 32, nb = r % 32;
      tr_block_q(a->in[I_WOUT] + (size_t)l * 1024 * 1024, 1024, 32 * nb, 64 * kb, (signed char*)(ws + WS_WOUT) + (size_t)l * 1024 * 1024, 1024, 32 * nb, (const float*)(ws + WS_SBO) + l * 1024, scr, lane); }
}
__device__ __forceinline__ void quant_row(const f32x4 (&y)[4], unsigned* qrow, float* srow, int lane) {
    float am = 0.f;
#pragma unroll
    for (int j = 0; j < 4; ++j) am = fmaxf(fmaxf(am, fmaxf(fabsf(y[j].x), fabsf(y[j].y))), fmaxf(fabsf(y[j].z), fabsf(y[j].w)));
#pragma unroll
    for (int o = 1; o < 64; o <<= 1) am = fmaxf(am, __shfl_xor(am, o));
    am = fmaxf(am, 1e-30f); const float inv = 127.f / am;
#pragma unroll
    for (int j = 0; j < 4; ++j) { const int q0 = (int)__builtin_rintf(y[j].x * inv), q1 = (int)__builtin_rintf(y[j].y * inv), q2 = (int)__builtin_rintf(y[j].z * inv), q3 = (int)__builtin_rintf(y[j].w * inv);
        qrow[lane + 64 * j] = (unsigned)(q0 & 255) | ((unsigned)(q1 & 255) << 8) | ((unsigned)(q2 & 255) << 16) | ((unsigned)(q3 & 255) << 24); }
    if (lane == 0) *srow = am * (1.f / 127.f);
}
constexpr int NI_F2 = 44 * 32, NI_MAIN = 32 + 2 * 512 + NI_F2;
constexpr int NI_M13E = 16 * 224, NI_M2E = 56 * 32, NI_M13 = 8 * NI_M13E, NI_MOE = NI_M13 + 8 * NI_M2E;
__device__ __forceinline__ void conv_item_main(KA a, int it, LAS float* scr, int lane) {
    unsigned char* ws = a->ws;
    if (it < 32) { const int l = it / 16, kb = it % 16; tr_block(a->in[I_WIN] + (size_t)l * 1024 * INW, INW, 1536, 64 * kb, (bf16*)(ws + WS_WIN) + (size_t)l * 32 * 1024, 1024, 0, scr, lane); return; }
    it -= 32;
    if (it < 2 * 512) { const int l = it / 512, r = it % 512, kb = r / 32, nb = r % 32; tr_block(a->in[I_WOUT] + (size_t)l * 1024 * 1024, 1024, 32 * nb, 64 * kb, (bf16*)(ws + WS_WOUT) + (size_t)l * 1024 * 1024, 1024, 32 * nb, scr, lane); return; }
    it -= 2 * 512;
    { const int kb = it / 32, nb = it % 32; tr_block(a->in[I_F2], 1024, 32 * nb, 64 * kb, (bf16*)(ws + WS_F2), DFF, 32 * nb, scr, lane); }
}
__device__ __forceinline__ void conv_item_moe(KA a, int it, LAS float* scr, int lane) {
    unsigned char* ws = a->ws;
    if (it < NI_M13) { const int e = it / NI_M13E, r = it % NI_M13E, kb = r / 224, db = r % 224, drow = 32 * db, pn = drow >> 8, half = (drow >> 7) & 1, off = drow & 127;
        tr_block_q((half ? a->in[I_M3] : a->in[I_M1]) + (size_t)e * 1024 * DEXP, DEXP, 128 * pn + off, 64 * kb, (signed char*)a->out + DO_M13Q + (size_t)e * 7168 * 1024, 1024, drow, (const float*)(ws + WS_SB13) + (size_t)e * 7168, scr, lane); return; }
    it -= NI_M13;
    { const int e = it / NI_M2E, r = it % NI_M2E, kb = r / 32, nb = r % 32;
      tr_block(a->in[I_M2] + (size_t)e * DEXP * 1024, 1024, 32 * nb, 64 * kb, (bf16*)((unsigned char*)a->out + DO_M2) + (size_t)e * 1024 * DEXP, DEXP, 32 * nb, scr, lane); }
}
__device__ __forceinline__ void mod_item(KA a, int it, LAS unsigned char* lds, int tid, int lane, int wave) {
    LAS float* sc = (LAS float*)lds; LAS float* red = (LAS float*)(lds + 69632);
    const int l = it / 96, n0 = 64 * (it % 96);
    for (int idx = tid; idx < 17 * 1024; idx += NTHR) { const int r = idx >> 10, k = idx & 1023; const float v = r < 16 ? a->in[I_C][r * 1024 + k] : a->in[I_CCTX][k]; sc[k * 17 + r] = silu_f(v); }
    __syncthreads();
    float acc[17];
#pragma unroll
    for (int r = 0; r < 17; ++r) acc[r] = 0.f;
    const float* wm = a->in[I_WMOD] + (size_t)l * 1024 * 6144 + n0 + lane;
    for (int k0 = wave * 128; k0 < wave * 128 + 128; k0 += 32) { float w[32];
#pragma unroll
        for (int i = 0; i < 32; ++i) w[i] = wm[(size_t)(k0 + i) * 6144];
#pragma unroll
        for (int i = 0; i < 32; ++i)
#pragma unroll
            for (int r = 0; r < 17; ++r) acc[r] += sc[(k0 + i) * 17 + r] * w[i]; }
#pragma unroll
    for (int r = 0; r < 17; ++r) red[(wave * 17 + r) * 64 + lane] = acc[r];
    __syncthreads();
    float* mods = (float*)(a->ws + WS_MODS);
    for (int idx = tid; idx < 17 * 64; idx += NTHR) { const int r = idx >> 6, ln = idx & 63; float s = a->in[I_BMOD][l * 6144 + n0 + ln];
#pragma unroll
        for (int w = 0; w < 8; ++w) s += red[(w * 17 + r) * 64 + ln];
        if (r < 16) mods[MO_LAT + (l * 16 + r) * 6144 + n0 + ln] = s; else mods[MO_CTX + l * 6144 + n0 + ln] = s; }
    __syncthreads();
}
__device__ __forceinline__ void ada_norm_row(const float* xrow, bf16* orow, const float* g, const float* shift, const float* scale, int lane, f32x4 (&y)[4]) {
    const f32x4* xr = (const f32x4*)xrow + lane; float s = 0.f;
#pragma unroll
    for (int j = 0; j < 4; ++j) { y[j] = xr[64 * j]; s += (y[j].x * y[j].x + y[j].y * y[j].y) + (y[j].z * y[j].z + y[j].w * y[j].w); }
    const float rstd = rsqrtf(wave_sum(s) * (1.f / D) + EPS);
    v2u* o8 = (v2u*)orow + lane;
#pragma unroll
    for (int j = 0; j < 4; ++j) { const f32x4 gv = ((const f32x4*)g)[lane + 64 * j], sh = ((const f32x4*)shift)[lane + 64 * j], sc = ((const f32x4*)scale)[lane + 64 * j];
        y[j] = y[j] * rstd * gv * (sc + 1.f) + sh; v2u w; w.x = pk2(y[j].x, y[j].y); w.y = pk2(y[j].z, y[j].w); o8[64 * j] = w; }
}
__device__ __forceinline__ int scan_row(int grp, int b, int dir, int step) {
    if (step < CTXL) { const int t = dir ? (CTXL - 1 - step) : step; return ML + b * CTXL + t; }
    int lp = step - CTXL; if (dir) lp = SEQ - 1 - lp;
    const int t = grp ? ((lp & 31) * 64 + (lp >> 5)) : lp;
    return b * SEQ + t;
}
template <int DK> __device__ __forceinline__ void scan_simple(LAS unsigned char* lds, const bf16* P, const bf16* GR, const float* w2, const float* gb, bf16* OUT, int grp, int b, int hd, int dir, int tid) {
    LAS float* qs = (LAS float*)lds; LAS float* ks = qs + 32 * 128; LAS float* fs = ks + 32 * 128; LAS float* vs = fs + 32 * 128; LAS float* red = vs + 32 * 128;
    const int j = tid & 127, cg = tid >> 7; constexpr int CPT = DK / 4;
    float st[CPT];
#pragma unroll
    for (int i = 0; i < CPT; ++i) st[i] = 0.f;
    for (int blk = 0; blk < (CTXL + SEQ) / 32; ++blk) {
        for (int idx = tid; idx < 32 * DK; idx += NTHR) { const int t = idx / DK, c = idx % DK, row = scan_row(grp, b, dir, blk * 32 + t); const bf16* pr = P + (size_t)row * PW; float q, k, lf;
            if (DK == 64) { q = bf2f(pr[hd * 64 + c]); k = bf2f(pr[256 + hd * 64 + c]); float lg = gb[hd * 64 + c]; const bf16* gr = GR + (size_t)row * 32 + dir * 16;
#pragma unroll
                for (int r = 0; r < 16; ++r) lg += bf2f(gr[r]) * w2[r * 256 + hd * 64 + c];
                lf = logsig_f(lg) * (1.f / 16.f); }
            else { q = bf2f(pr[1024 + hd * 128 + c]); k = bf2f(pr[(dir ? 2560 : 1536) + hd * 128 + c]); lf = bf2f(pr[(dir ? 3072 : 2048) + hd * 128 + c]); }
            qs[t * 128 + c] = q; ks[t * 128 + c] = k; fs[t * 128 + c] = __expf(lf); }
        for (int idx = tid; idx < 32 * 128; idx += NTHR) { const int t = idx >> 7, jj = idx & 127, row = scan_row(grp, b, dir, blk * 32 + t); vs[idx] = bf2f(P[(size_t)row * PW + (DK == 64 ? 512 : 3584) + hd * 128 + jj]); }
        __syncthreads();
        for (int t = 0; t < 32; ++t) { const float vv = vs[t * 128 + j]; float acc = 0.f;
#pragma unroll
            for (int i = 0; i < CPT; ++i) { const int c = cg * CPT + i; st[i] = st[i] * fs[t * 128 + c] + ks[t * 128 + c] * vv; acc += st[i] * qs[t * 128 + c]; }
            red[(t * 4 + cg) * 128 + j] = acc; }
        __syncthreads();
        for (int idx = tid; idx < 4096; idx += NTHR) { const int t = idx >> 7, jj = idx & 127, row = scan_row(grp, b, dir, blk * 32 + t);
            const float o = (red[(t * 4 + 0) * 128 + jj] + red[(t * 4 + 1) * 128 + jj]) + (red[(t * 4 + 2) * 128 + jj] + red[(t * 4 + 3) * 128 + jj]);
            OUT[(size_t)row * D + grp * 512 + hd * 128 + jj] = (bf16)f2bf(o); }
        __syncthreads();
    }
}
__device__ __forceinline__ void mix_row(const bf16* of, const bf16* ob, const bf16* gate, const float* gla_g, const float* hg_g, bf16* out, int lane) {
    const v4u* pf = (const v4u*)of + 2 * lane; const v4u* pb = (const v4u*)ob + 2 * lane; const v4u* pg = (const v4u*)gate + 2 * lane;
    const v4u f0 = pf[0], f1 = pf[1], b0 = pb[0], b1 = pb[1], g0 = pg[0], g1 = pg[1];
    const unsigned fw[8] = {f0.x, f0.y, f0.z, f0.w, f1.x, f1.y, f1.z, f1.w}, bw[8] = {b0.x, b0.y, b0.z, b0.w, b1.x, b1.y, b1.z, b1.w}, gw[8] = {g0.x, g0.y, g0.z, g0.w, g1.x, g1.y, g1.z, g1.w};
    float o[16]; float ss = 0.f;
#pragma unroll
    for (int i = 0; i < 8; ++i) { o[2 * i] = bflo(fw[i]) + bflo(bw[i]); o[2 * i + 1] = bfhi(fw[i]) + bfhi(bw[i]); ss += o[2 * i] * o[2 * i] + o[2 * i + 1] * o[2 * i + 1]; }
    ss += __shfl_xor(ss, 1); ss += __shfl_xor(ss, 2); ss += __shfl_xor(ss, 4);
    const float rstd = rsqrtf(ss * (1.f / 128.f) + EPS);
    const float* ng = ((lane >> 5) ? hg_g : gla_g) + (lane & 7) * 16;
    unsigned w[8];
#pragma unroll
    for (int i = 0; i < 8; ++i) { const float a = o[2 * i] * rstd * ng[2 * i] * silu_f(bflo(gw[i])), c = o[2 * i + 1] * rstd * ng[2 * i + 1] * silu_f(bfhi(gw[i])); w[i] = pk2(a, c); }
    v4u* po = (v4u*)out + 2 * lane; po[0] = (v4u){w[0], w[1], w[2], w[3]}; po[1] = (v4u){w[4], w[5], w[6], w[7]};
}

__device__ __forceinline__ void xload(const float* xrow, int lane, f32x4 (&y)[4]) {
    const f32x4* xr = (const f32x4*)xrow + lane;
#pragma unroll
    for (int j = 0; j < 4; ++j) y[j] = xr[64 * j];
}
__device__ __forceinline__ void xloadb(const bf16* xrow, int lane, v2u (&r)[4]) {
    const v2u* xr = (const v2u*)xrow + lane;
#pragma unroll
    for (int j = 0; j < 4; ++j) r[j] = xr[64 * j];
}
__device__ __forceinline__ void xcvt(const v2u (&r)[4], f32x4 (&y)[4]) {
#pragma unroll
    for (int j = 0; j < 4; ++j) y[j] = (f32x4){bflo(r[j].x), bfhi(r[j].x), bflo(r[j].y), bfhi(r[j].y)};
}
__device__ __forceinline__ void norm_finish(bf16* orow, const float* g, const float* shift, const float* scale, int lane, f32x4 (&y)[4]) {
    float s = 0.f;
#pragma unroll
    for (int j = 0; j < 4; ++j) s += (y[j].x * y[j].x + y[j].y * y[j].y) + (y[j].z * y[j].z + y[j].w * y[j].w);
    const float rstd = rsqrtf(wave_sum(s) * (1.f / D) + EPS);
    v2u* o8 = (v2u*)orow + lane;
#pragma unroll
    for (int j = 0; j < 4; ++j) { const f32x4 gv = ((const f32x4*)g)[lane + 64 * j], sh = ((const f32x4*)shift)[lane + 64 * j], sc = ((const f32x4*)scale)[lane + 64 * j];
        y[j] = y[j] * rstd * gv * (sc + 1.f) + sh; v2u w; w.x = pk2(y[j].x, y[j].y); w.y = pk2(y[j].z, y[j].w); o8[64 * j] = w; }
}
__device__ __forceinline__ void norm_finish_q(unsigned* qrow, float* srow, const float* g, const float* shift, const float* scale, int lane, f32x4 (&y)[4]) {
    float s = 0.f;
#pragma unroll
    for (int j = 0; j < 4; ++j) s += (y[j].x * y[j].x + y[j].y * y[j].y) + (y[j].z * y[j].z + y[j].w * y[j].w);
    const float rstd = rsqrtf(wave_sum(s) * (1.f / D) + EPS);
#pragma unroll
    for (int j = 0; j < 4; ++j) { const f32x4 gv = ((const f32x4*)g)[lane + 64 * j], sh = ((const f32x4*)shift)[lane + 64 * j], sc = ((const f32x4*)scale)[lane + 64 * j]; y[j] = y[j] * rstd * gv * (sc + 1.f) + sh; }
    quant_row(y, qrow, srow, lane);
}
struct MixIn { v4u f0, f1, b0, b1, g0, g1; };
__device__ __forceinline__ void mix_load(const bf16* of, const bf16* ob, const bf16* gate, int lane, MixIn& r) {
    const v4u* pf = (const v4u*)of + 2 * lane; const v4u* pb = (const v4u*)ob + 2 * lane; const v4u* pg = (const v4u*)gate + 2 * lane;
    r.f0 = pf[0]; r.f1 = pf[1]; r.b0 = pb[0]; r.b1 = pb[1]; r.g0 = pg[0]; r.g1 = pg[1];
}
__device__ __forceinline__ void mix_finish(const MixIn& r, const float* gla_g, const float* hg_g, signed char* out, float* srow, int lane) {
    const unsigned fw[8] = {r.f0.x, r.f0.y, r.f0.z, r.f0.w, r.f1.x, r.f1.y, r.f1.z, r.f1.w}, bw[8] = {r.b0.x, r.b0.y, r.b0.z, r.b0.w, r.b1.x, r.b1.y, r.b1.z, r.b1.w}, gw[8] = {r.g0.x, r.g0.y, r.g0.z, r.g0.w, r.g1.x, r.g1.y, r.g1.z, r.g1.w};
    float o[16]; float ss = 0.f;
#pragma unroll
    for (int i = 0; i < 8; ++i) { o[2 * i] = bflo(fw[i]) + bflo(bw[i]); o[2 * i + 1] = bfhi(fw[i]) + bfhi(bw[i]); ss += o[2 * i] * o[2 * i] + o[2 * i + 1] * o[2 * i + 1]; }
    ss += __shfl_xor(ss, 1); ss += __shfl_xor(ss, 2); ss += __shfl_xor(ss, 4);
    const float rstd = rsqrtf(ss * (1.f / 128.f) + EPS);
    const float* ng = ((lane >> 5) ? hg_g : gla_g) + (lane & 7) * 16;
    float mv[16]; float am = 0.f;
#pragma unroll
    for (int i = 0; i < 8; ++i) { mv[2 * i] = o[2 * i] * rstd * ng[2 * i] * silu_f(bflo(gw[i])); mv[2 * i + 1] = o[2 * i + 1] * rstd * ng[2 * i + 1] * silu_f(bfhi(gw[i])); am = fmaxf(am, fmaxf(fabsf(mv[2 * i]), fabsf(mv[2 * i + 1]))); }
#pragma unroll
    for (int of = 1; of < 64; of <<= 1) am = fmaxf(am, __shfl_xor(am, of));
    am = fmaxf(am, 1e-30f); const float inv = 127.f / am; unsigned w[4];
#pragma unroll
    for (int i = 0; i < 4; ++i) { const int q0 = (int)__builtin_rintf(mv[4 * i] * inv), q1 = (int)__builtin_rintf(mv[4 * i + 1] * inv), q2 = (int)__builtin_rintf(mv[4 * i + 2] * inv), q3 = (int)__builtin_rintf(mv[4 * i + 3] * inv);
        w[i] = (unsigned)(q0 & 255) | ((unsigned)(q1 & 255) << 8) | ((unsigned)(q2 & 255) << 16) | ((unsigned)(q3 & 255) << 24); }
    ((v4u*)out)[lane] = (v4u){w[0], w[1], w[2], w[3]};
    if (lane == 0) *srow = am * (1.f / 127.f);
}
__device__ __forceinline__ void mix_finish_bf(const MixIn& r, const float* gla_g, const float* hg_g, bf16* out, int lane) {
    const unsigned fw[8] = {r.f0.x, r.f0.y, r.f0.z, r.f0.w, r.f1.x, r.f1.y, r.f1.z, r.f1.w}, bw[8] = {r.b0.x, r.b0.y, r.b0.z, r.b0.w, r.b1.x, r.b1.y, r.b1.z, r.b1.w}, gw[8] = {r.g0.x, r.g0.y, r.g0.z, r.g0.w, r.g1.x, r.g1.y, r.g1.z, r.g1.w};
    float o[16]; float ss = 0.f;
#pragma unroll
    for (int i = 0; i < 8; ++i) { o[2 * i] = bflo(fw[i]) + bflo(bw[i]); o[2 * i + 1] = bfhi(fw[i]) + bfhi(bw[i]); ss += o[2 * i] * o[2 * i] + o[2 * i + 1] * o[2 * i + 1]; }
    ss += __shfl_xor(ss, 1); ss += __shfl_xor(ss, 2); ss += __shfl_xor(ss, 4);
    const float rstd = rsqrtf(ss * (1.f / 128.f) + EPS);
    const float* ng = ((lane >> 5) ? hg_g : gla_g) + (lane & 7) * 16;
    unsigned w[8];
#pragma unroll
    for (int i = 0; i < 8; ++i) { const float a = o[2 * i] * rstd * ng[2 * i] * silu_f(bflo(gw[i])), c = o[2 * i + 1] * rstd * ng[2 * i + 1] * silu_f(bfhi(gw[i])); w[i] = pk2(a, c); }
    v4u* po = (v4u*)out + 2 * lane; po[0] = (v4u){w[0], w[1], w[2], w[3]}; po[1] = (v4u){w[4], w[5], w[6], w[7]};
}
template <bool ATOMIC> __device__ __forceinline__ void moe_tab(KA a, LAS unsigned char* lds, int tid, int wg) {
    LAS int* tab = (LAS int*)(lds + TAB_OFF);
    if (tid < 32) tab[tid] = 0;
    __syncthreads();
    if (tid < 256) { int c[8];
        if constexpr (ATOMIC) {
#pragma unroll
            for (int e = 0; e < 8; ++e) c[e] = __hip_atomic_load((int*)(a->ws + WS_ROUTE + RT_CNT) + 8 * tid + e, __ATOMIC_RELAXED, __HIP_MEMORY_SCOPE_AGENT); }
        else { const v4i* cp = (const v4i*)(a->ws + WS_ROUTE + RT_CNT) + 2 * tid; const v4i c0 = cp[0], c1 = cp[1]; c[0] = c0.x; c[1] = c0.y; c[2] = c0.z; c[3] = c0.w; c[4] = c1.x; c[5] = c1.y; c[6] = c1.z; c[7] = c1.w; }
#pragma unroll
        for (int e = 0; e < 8; ++e) { __hip_atomic_fetch_add(&tab[e], c[e], __ATOMIC_RELAXED, __HIP_MEMORY_SCOPE_WORKGROUP); if (tid < wg) __hip_atomic_fetch_add(&tab[8 + e], c[e], __ATOMIC_RELAXED, __HIP_MEMORY_SCOPE_WORKGROUP); } }
    __syncthreads();
    if (tid == 0) { int pb = 0; for (int e = 0; e < 8; ++e) { tab[16 + e] = pb; pb += (tab[e] + 255) >> 8; } tab[24] = pb; }
    __syncthreads();
}


#ifndef STAG_TICKS
#define STAG_TICKS 400
#endif
#ifndef STAG_NCLS
#define STAG_NCLS 8
#endif
__device__ __forceinline__ void stagger_start(int vc) {
    const int cls = (vc >> 3) % STAG_NCLS;
    if (cls) { const unsigned long long t0 = __builtin_amdgcn_s_memrealtime(), w = (unsigned long long)cls * STAG_TICKS; while (__builtin_amdgcn_s_memrealtime() - t0 < w) __builtin_amdgcn_s_sleep(4); }
}
typedef short bf16x8 __attribute__((ext_vector_type(8)));
typedef float f32x16 __attribute__((ext_vector_type(16)));
#define MFMA32(a, b, c) __builtin_amdgcn_mfma_f32_32x32x16_bf16((a), (b), (c), 0, 0, 0)
#define SCHED_FENCE() __builtin_amdgcn_sched_barrier(0)
__device__ __forceinline__ int perm16(int c) { return (c & ~12) | ((c & 4) << 1) | ((c & 8) >> 1); }
template <int DK> __device__ __forceinline__ int rm_swz(int t) { return (DK == 128) ? (t & 15) : ((t >> 1) & 7); }
template <int DK> __device__ __forceinline__ int rm_addr(int t, int pos) { return t * (2 * DK) + ((((pos >> 3) ^ rm_swz<DK>(t))) << 4) + ((pos & 7) << 1); }
__device__ __forceinline__ int ti_addr(int row, int tok) { return row * 64 + ((((tok >> 3) ^ ((row >> 2) & 3))) << 4) + ((tok & 7) << 1); }
constexpr int SC_IMG = 25600, SC_QI = 0, SC_KDT = 8192, SC_VT = 16384, SC_DV = 24576;
constexpr int SC_QK = 3 * SC_IMG, SC_QKSET = 16384, SC_S = SC_QK + 2 * SC_QKSET;
static_assert(SC_S + 4096 <= RING_BYTES, "scan LDS map");
constexpr int NCHUNK = (CTXL + SEQ) / 32;
constexpr float LOG2E = 1.4426950408889634f;
__device__ __forceinline__ void chunk_rows(int grp, int b, int dir, int ch, int& rbase, int& rstep) {
    if (ch < CTXL / 32) { rbase = ML + b * CTXL + (dir ? CTXL - 1 - ch * 32 : ch * 32); rstep = dir ? -1 : 1; }
    else { const int cc = ch - CTXL / 32;
        if (grp) { rbase = b * SEQ + (dir ? 31 * 64 + 63 - cc : cc); rstep = dir ? -64 : 64; }
        else { rbase = b * SEQ + (dir ? SEQ - 1 - cc * 32 : cc * 32); rstep = dir ? -1 : 1; } }
}
template <int V> struct IC { static constexpr int value = V; };
template <int DK, int DIRT> __device__ __forceinline__ void scan_mfma(LAS unsigned char* lds, const bf16* P, const bf16* GR, const float* w2, const float* gb, bf16* OUT, int grp, int b, int hd, int tid) {
    constexpr int dir = DIRT;
    const int lane = tid & 63, wave = __builtin_amdgcn_readfirstlane(tid >> 6);
    constexpr int NCP = DK / 8, NTG = 64 / NCP, TPL = 32 / NTG, NT = DK / 32, NKS = DK / 16, RP = 2 * DK;
    constexpr int BLK = (DK == 64) ? PBLK_G : PBLK_H;
    const int qcol = (DK == 64) ? 0 : 384, kcol = (DK == 64) ? 64 : (dir ? 0 : 512), lcol = dir ? 128 : 640, vcol = (DK == 64) ? 128 : 256;
    const char* Pblk = (const char*)(P + ((DK == 64) ? 0 : PH_OFF) + (size_t)(b * 4 + hd) * NPOS * BLK);
    const int ocol = grp * 512 + hd * 128;
    if (wave < 4) {
        const int sw = wave;
        f32x16 ST[NT];
#pragma unroll
        for (int T = 0; T < NT; ++T)
#pragma unroll
            for (int r = 0; r < 16; ++r) ST[T][r] = 0.f;
        for (int it = -2; it < NCHUNK; ++it) {
            if (it >= 0) {
                int i31 = lane & 31, h = lane >> 5; asm volatile("" : "+v"(i31), "+v"(h));
                const LAS unsigned char* img = lds + (it % 3) * SC_IMG; const LAS unsigned char* simg = lds + SC_S + (it & 1) * 2048;
                const int aq0 = i31 * RP + ((h ^ rm_swz<DK>(i31)) << 4);
                const int x2 = (i31 >> 2) & 3, at0 = i31 * 64 + ((h ^ x2) << 4);
                const int vrow = 32 * sw * 64;
                bf16x8 bq[NKS], va[2], sb[2], kd[NT][2]; f32x4 d4[NT][4];
#pragma unroll
                for (int ks = 0; ks < NKS; ++ks) bq[ks] = *(const LAS bf16x8*)(img + SC_QI + (aq0 ^ (ks << 5)));
#pragma unroll
                for (int s = 0; s < 2; ++s) { va[s] = *(const LAS bf16x8*)(img + SC_VT + vrow + (at0 ^ (s << 5))); sb[s] = *(const LAS bf16x8*)(simg + (at0 ^ (s << 5))); }
#pragma unroll
                for (int T = 0; T < 2; ++T) {
#pragma unroll
                    for (int g = 0; g < 4; ++g) d4[T][g] = *(const LAS f32x4*)(img + SC_DV + 16 * h + 128 * T + 32 * g);
#pragma unroll
                    for (int s = 0; s < 2; ++s) kd[T][s] = *(const LAS bf16x8*)(img + SC_KDT + 2048 * T + (at0 ^ (s << 5))); }
                SCHED_FENCE();
                f32x16 oacc;
#pragma unroll
                for (int r = 0; r < 16; ++r) oacc[r] = 0.f;
#pragma unroll
                for (int T = 0; T < NT; ++T)
#pragma unroll
                    for (int s = 0; s < 2; ++s) {
                        v4u p; p.x = cvtpk(ST[T][8 * s], ST[T][8 * s + 1]); p.y = cvtpk(ST[T][8 * s + 2], ST[T][8 * s + 3]); p.z = cvtpk(ST[T][8 * s + 4], ST[T][8 * s + 5]); p.w = cvtpk(ST[T][8 * s + 6], ST[T][8 * s + 7]);
                        oacc = MFMA32(__builtin_bit_cast(bf16x8, p), bq[2 * T + s], oacc); }
#pragma unroll
                for (int s = 0; s < 2; ++s) oacc = MFMA32(va[s], sb[s], oacc);
                SCHED_FENCE();
                if constexpr (NT == 4) {
#pragma unroll
                    for (int T = 2; T < 4; ++T) {
#pragma unroll
                        for (int g = 0; g < 4; ++g) d4[T][g] = *(const LAS f32x4*)(img + SC_DV + 16 * h + 128 * T + 32 * g);
#pragma unroll
                        for (int s = 0; s < 2; ++s) kd[T][s] = *(const LAS bf16x8*)(img + SC_KDT + 2048 * T + (at0 ^ (s << 5))); }
                }
#pragma unroll
                for (int T = 0; T < 2; ++T) {
#pragma unroll
                    for (int g = 0; g < 4; ++g) { ST[T][4 * g] *= d4[T][g].x; ST[T][4 * g + 1] *= d4[T][g].y; ST[T][4 * g + 2] *= d4[T][g].z; ST[T][4 * g + 3] *= d4[T][g].w; }
#pragma unroll
                    for (int s = 0; s < 2; ++s) ST[T] = MFMA32(kd[T][s], va[s], ST[T]); }
                SCHED_FENCE();
                { int rbase, rstep; chunk_rows(grp, b, dir, it, rbase, rstep); const int row = rbase + i31 * rstep; bf16* op = OUT + (size_t)row * D + ocol + 32 * sw + 4 * h;
#pragma unroll
                  for (int g = 0; g < 4; ++g) { v2u w; w.x = cvtpk(oacc[4 * g], oacc[4 * g + 1]); w.y = cvtpk(oacc[4 * g + 2], oacc[4 * g + 3]); *(v2u*)(op + 8 * g) = w; } }
                if constexpr (NT == 4) {
#pragma unroll
                    for (int T = 2; T < 4; ++T) {
#pragma unroll
                        for (int g = 0; g < 4; ++g) { ST[T][4 * g] *= d4[T][g].x; ST[T][4 * g + 1] *= d4[T][g].y; ST[T][4 * g + 2] *= d4[T][g].z; ST[T][4 * g + 3] *= d4[T][g].w; }
#pragma unroll
                        for (int s = 0; s < 2; ++s) ST[T] = MFMA32(kd[T][s], va[s], ST[T]); }
                }
            }
            asm volatile("s_waitcnt lgkmcnt(0)" ::: "memory"); __builtin_amdgcn_s_barrier(); asm volatile("" ::: "memory");
        }
    } else {
        const int pw = wave - 4;
        const int tg = lane / NCP, cp = lane % NCP, c0 = (DK / 4) * pw + 2 * cp, t0 = tg * TPL;
        const int pos0 = (c0 & ~15) | perm16(c0 & 15);
        const int tgv = lane >> 4, cpv = lane & 15, d0 = 32 * pw + 2 * cpv, tv0 = 8 * tgv;
        float w2r[2][16]; float gb0 = 0.f, gb1 = 0.f;
        if (DK == 64) {
#pragma unroll
            for (int r = 0; r < 16; ++r) { w2r[0][r] = w2[r * 256 + hd * 64 + c0]; w2r[1][r] = w2[r * 256 + hd * 64 + c0 + 1]; }
            gb0 = gb[hd * 64 + c0]; gb1 = gb[hd * 64 + c0 + 1];
        }
        constexpr int AHEAD = (DK == 128) ? 2 : 1;
        unsigned rq[AHEAD][TPL], rk[AHEAD][TPL], rl[AHEAD][TPL], rv[AHEAD][8]; v4u rg[AHEAD][TPL][2];
        auto load_chunk = [&](auto setc, int ch) { constexpr int SI = decltype(setc)::value;
            const int pb = dir ? ((ch < CTXL / 32) ? CTXL - 1 - 32 * ch : CTXL + SEQ - 1 - 32 * (ch - CTXL / 32)) : 32 * ch, ps = dir ? -1 : 1;
            const int stp = ps * BLK * 2;
            int o1 = ((pb + t0 * ps) * BLK + c0) * 2, o2 = ((pb + tv0 * ps) * BLK + vcol + d0) * 2;
            if constexpr (DK == 128) {
                const int oq = o1 + 2 * qcol, ok = o1 + 2 * kcol;
                static_assert(BLK * 2 * 2 <= 4095, "immediate offsets");
#define SC_LD(dst, off, IMM) asm volatile("global_load_dword %0, %1, %2 offset:" #IMM : "=v"(dst) : "v"(off), "s"(Pblk) : "memory")
#define SC_LD3(arr, base, j) do { if constexpr (DIRT != 0) { const int b_ = (base) + (7 - 3 * (j)) * stp; SC_LD(arr[SI][7 - 3 * (j)], b_, 0); SC_LD(arr[SI][6 - 3 * (j)], b_, 1536); if (5 - 3 * (j) >= 0) SC_LD(arr[SI][(5 - 3 * (j)) & 7], b_, 3072); } \
        else { const int b_ = (base) + (3 * (j)) * stp; SC_LD(arr[SI][3 * (j)], b_, 0); SC_LD(arr[SI][3 * (j) + 1], b_, 1536); if (3 * (j) + 2 < 8) SC_LD(arr[SI][(3 * (j) + 2) & 7], b_, 3072); } } while (0)
#pragma unroll
                for (int j = 0; j < 3; ++j) { SC_LD3(rq, oq, j); SC_LD3(rk, ok, j); SC_LD3(rv, o2, j); }
#undef SC_LD3
#undef SC_LD
                return;
            }
#pragma unroll
            for (int t = 0; t < TPL; ++t) {
                rq[SI][t] = *(const unsigned*)(Pblk + o1 + 2 * qcol); rk[SI][t] = *(const unsigned*)(Pblk + o1 + 2 * kcol);
                o1 += stp; }
            if (DK == 64) { int rbase, rstep; chunk_rows(grp, b, dir, ch, rbase, rstep); int o3 = ((rbase + t0 * rstep) * 32 + dir * 16) * 2; const int st3 = rstep * 64;
#pragma unroll
                for (int t = 0; t < TPL; ++t) { const v4u* gp = (const v4u*)((const char*)GR + o3); rg[SI][t][0] = gp[0]; rg[SI][t][1] = gp[1]; o3 += st3; } }
#pragma unroll
            for (int t = 0; t < 8; ++t) { rv[SI][t] = *(const unsigned*)(Pblk + o2); o2 += stp; }
        };
        load_chunk(IC<0>{}, 0); if constexpr (AHEAD == 2) load_chunk(IC<1>{}, 1);
        if (pw == 3) { const int iz = lane & 15, cz = 2 + ((lane >> 4) & 1), bz = lane >> 5;
            *(LAS v4u*)(lds + SC_S + bz * 2048 + iz * 64 + ((cz ^ ((iz >> 2) & 3)) << 4)) = (v4u){0u, 0u, 0u, 0u}; }
        auto prep_step = [&](auto setc, int it) { constexpr int SI = decltype(setc)::value;
            const int cw = it + 2;
            int rm0 = t0 * RP + ((((pos0 >> 3) ^ rm_swz<DK>(t0))) << 4) + ((pos0 & 7) << 1), ti0 = ti_addr(c0, t0), ti1 = ti_addr(c0 + 1, t0), tv_0 = ti_addr(d0, tv0), tv_1 = ti_addr(d0 + 1, tv0), dvo = c0 * 4;
            if (cw < NCHUNK) {
                if constexpr (DK == 128) {
#define SC_W16(arr) "+v"(arr[SI][0]), "+v"(arr[SI][1]), "+v"(arr[SI][2]), "+v"(arr[SI][3]), "+v"(arr[SI][4]), "+v"(arr[SI][5]), "+v"(arr[SI][6]), "+v"(arr[SI][7])
                    if (cw + 1 < NCHUNK) asm volatile("s_waitcnt vmcnt(24)" ::: "memory"); else asm volatile("s_waitcnt vmcnt(0)" ::: "memory");
                    SCHED_FENCE();
                    asm volatile("" : SC_W16(rq), SC_W16(rk));
                    asm volatile("" : SC_W16(rv));
#undef SC_W16
                    SCHED_FENCE();
                }
                LAS unsigned char* img = lds + (cw % 3) * SC_IMG;
                static_assert(SC_IMG % 256 == 0 && SC_QI % 256 == 0 && SC_QK % 256 == 0 && SC_QKSET % 256 == 0, "image bases");
                const int R0q = rm0 + (cw % 3) * SC_IMG + SC_QI, R0k = rm0 + SC_QK + (cw & 1) * SC_QKSET;
                float c0v[TPL], c1v[TPL], off0, off1, cL0, cL1;
                if constexpr (DK == 64) {
                    float a0 = 0.f, a1 = 0.f;
#pragma unroll
                    for (int t = 0; t < TPL; ++t) { float g0 = gb0, g1 = gb1; const unsigned gw[8] = {rg[SI][t][0].x, rg[SI][t][0].y, rg[SI][t][0].z, rg[SI][t][0].w, rg[SI][t][1].x, rg[SI][t][1].y, rg[SI][t][1].z, rg[SI][t][1].w};
#pragma unroll
                        for (int r = 0; r < 8; ++r) { const float e0 = bflo(gw[r]), e1 = bfhi(gw[r]); g0 += e0 * w2r[0][2 * r] + e1 * w2r[0][2 * r + 1]; g1 += e0 * w2r[1][2 * r] + e1 * w2r[1][2 * r + 1]; }
                        const float l0 = (fminf(g0, 0.f) * LOG2E - __builtin_amdgcn_logf(1.f + __builtin_amdgcn_exp2f(-fabsf(g0) * LOG2E))) * (1.f / 16.f);
                        const float l1 = (fminf(g1, 0.f) * LOG2E - __builtin_amdgcn_logf(1.f + __builtin_amdgcn_exp2f(-fabsf(g1) * LOG2E))) * (1.f / 16.f);
                        a0 += l0; a1 += l1; c0v[t] = a0; c1v[t] = a1; }
                    float s0 = c0v[TPL - 1], s1 = c1v[TPL - 1];
#pragma unroll
                    for (int d = NCP; d < 64; d <<= 1) { const float u0 = __shfl_up(s0, d), u1 = __shfl_up(s1, d); if (lane >= d) { s0 += u0; s1 += u1; } }
                    const float bl0 = __shfl(s0, (NTG - 1) * NCP + cp), bl1 = __shfl(s1, (NTG - 1) * NCP + cp);
                    off0 = s0 - c0v[TPL - 1]; off1 = s1 - c1v[TPL - 1];
                    cL0 = __builtin_amdgcn_exp2f(bl0); cL1 = __builtin_amdgcn_exp2f(bl1);
                } else {
                    float a0 = 1.f, a1 = 1.f;
#pragma unroll
                    for (int t = 0; t < TPL; ++t) { a0 *= 1.f - bflo(rk[SI][t]); a1 *= 1.f - bfhi(rk[SI][t]); c0v[t] = a0; c1v[t] = a1; }
                    float s0 = a0, s1 = a1;
#pragma unroll
                    for (int d = NCP; d < 64; d <<= 1) { const float u0 = __shfl_up(s0, d), u1 = __shfl_up(s1, d); if (lane >= d) { s0 *= u0; s1 *= u1; } }
                    cL0 = __shfl(s0, (NTG - 1) * NCP + cp); cL1 = __shfl(s1, (NTG - 1) * NCP + cp);
                    const float p0 = __shfl_up(s0, NCP), p1 = __shfl_up(s1, NCP);
                    off0 = lane >= NCP ? p0 : 1.f; off1 = lane >= NCP ? p1 : 1.f;
                }
                unsigned kdp0[TPL / 2], kdp1[TPL / 2]; float kdprev0 = 0.f, kdprev1 = 0.f;
#pragma unroll
                for (int t = 0; t < TPL; ++t) {
                    float E0, E1, Rc0, Rc1;
                    if constexpr (DK == 64) { const float e0 = fmaxf(off0 + c0v[t], -100.f), e1 = fmaxf(off1 + c1v[t], -100.f);
                        E0 = __builtin_amdgcn_exp2f(e0); E1 = __builtin_amdgcn_exp2f(e1); Rc0 = __builtin_amdgcn_exp2f(-e0); Rc1 = __builtin_amdgcn_exp2f(-e1); }
                    else { E0 = fmaxf(off0 * c0v[t], 0x1p-100f); E1 = fmaxf(off1 * c1v[t], 0x1p-100f); Rc0 = __builtin_amdgcn_rcpf(E0); Rc1 = __builtin_amdgcn_rcpf(E1); }
                    const float ks0 = bflo(rk[SI][t]) * Rc0, ks1 = bfhi(rk[SI][t]) * Rc1;
                    const int xr = ((DK == 128) ? t : (t >> 1)) << 4;
                    *(LAS unsigned*)(lds + (R0q ^ xr) + t * RP) = cvtpk(bflo(rq[SI][t]) * E0, bfhi(rq[SI][t]) * E1);
                    *(LAS unsigned*)(lds + (R0k ^ xr) + t * RP) = cvtpk(ks0, ks1);
                    const float kd0 = ks0 * cL0, kd1 = ks1 * cL1;
                    if (t & 1) { kdp0[t >> 1] = cvtpk(kdprev0, kd0); kdp1[t >> 1] = cvtpk(kdprev1, kd1); } else { kdprev0 = kd0; kdprev1 = kd1; }
                }
                if constexpr (TPL == 8) { *(LAS v4u*)(img + SC_KDT + ti0) = (v4u){kdp0[0], kdp0[1], kdp0[TPL / 2 - 2], kdp0[TPL / 2 - 1]}; *(LAS v4u*)(img + SC_KDT + ti1) = (v4u){kdp1[0], kdp1[1], kdp1[TPL / 2 - 2], kdp1[TPL / 2 - 1]}; }
                else { *(LAS v2u*)(img + SC_KDT + ti0) = (v2u){kdp0[0], kdp0[1]}; *(LAS v2u*)(img + SC_KDT + ti1) = (v2u){kdp1[0], kdp1[1]}; }
                if (tg == 0) *(LAS f32x2v*)(img + SC_DV + dvo) = (f32x2v){cL0, cL1};
                { v4u lo, hi;
                  lo.x = __builtin_amdgcn_perm(rv[SI][1], rv[SI][0], 0x05040100u); lo.y = __builtin_amdgcn_perm(rv[SI][3], rv[SI][2], 0x05040100u); lo.z = __builtin_amdgcn_perm(rv[SI][5], rv[SI][4], 0x05040100u); lo.w = __builtin_amdgcn_perm(rv[SI][7], rv[SI][6], 0x05040100u);
                  hi.x = __builtin_amdgcn_perm(rv[SI][1], rv[SI][0], 0x07060302u); hi.y = __builtin_amdgcn_perm(rv[SI][3], rv[SI][2], 0x07060302u); hi.z = __builtin_amdgcn_perm(rv[SI][5], rv[SI][4], 0x07060302u); hi.w = __builtin_amdgcn_perm(rv[SI][7], rv[SI][6], 0x07060302u);
                  *(LAS v4u*)(img + SC_VT + tv_0) = lo; *(LAS v4u*)(img + SC_VT + tv_1) = hi; }
                if (cw + AHEAD < NCHUNK) load_chunk(setc, cw + AHEAD);
            }
            const int cs = it + 1;
            if (cs >= 0 && cs < NCHUNK && pw < 3) {
                int l15 = lane & 15, kq = lane >> 4; asm volatile("" : "+v"(l15), "+v"(kq));
                const int ib = (pw + 1) >> 1, jb = pw >> 1;
                const int iq = 16 * ib + l15, jk = 16 * jb + l15;
                const int aqb = iq * RP + (cs % 3) * SC_IMG + SC_QI, akb = jk * RP + SC_QK + (cs & 1) * SC_QKSET, swi = rm_swz<DK>(iq), swj = rm_swz<DK>(jk);
                f32x4 sc4 = {0.f, 0.f, 0.f, 0.f};
#pragma unroll
                for (int ks = 0; ks < DK / 32; ++ks) { const int ch = 4 * ks + kq;
                    const bf16x8 ka = *(const LAS bf16x8*)(lds + akb + ((ch ^ swj) << 4)), qb = *(const LAS bf16x8*)(lds + aqb + ((ch ^ swi) << 4));
                    sc4 = __builtin_amdgcn_mfma_f32_16x16x32_bf16(ka, qb, sc4, 0, 0, 0); }
                const int j0 = 16 * jb + 4 * kq; float m[4];
#pragma unroll
                for (int e = 0; e < 4; ++e) m[e] = (j0 + e <= iq) ? sc4[e] : 0.f;
                *(LAS v2u*)(lds + SC_S + (cs & 1) * 2048 + iq * 64 + ((((j0 >> 3) ^ ((iq >> 2) & 3))) << 4) + 8 * (kq & 1)) = (v2u){cvtpk(m[0], m[1]), cvtpk(m[2], m[3])};
            }
            asm volatile("s_waitcnt lgkmcnt(0)" ::: "memory"); __builtin_amdgcn_s_barrier(); asm volatile("" ::: "memory");
        };
        static_assert((NCHUNK & 1) == 0, "interval loop is unrolled by two");
        for (int it = -2; it < NCHUNK; it += 2) { prep_step(IC<0>{}, it); if constexpr (AHEAD == 2) prep_step(IC<1>{}, it + 1); else prep_step(IC<0>{}, it + 1); }
    }
}

__global__ void __launch_bounds__(NTHR, 2) fwd_kernel(Args args) {
    extern __shared__ __attribute__((aligned(16))) unsigned char lds_raw[];
    LAS unsigned char* lds = (LAS unsigned char*)lds_raw;
    {   const int t0 = threadIdx.x;
        for (int u = t0; u < (LDS_BYTES - LDSCTL_OFF) / 4; u += NTHR) ((LAS unsigned*)(lds + LDSCTL_OFF))[u] = 0u;
        __syncthreads();
        if (t0 == 0) { volatile LAS unsigned* M = (volatile LAS unsigned*)(lds + MISC_OFF); unsigned* barw = (unsigned*)(kargs()->ws + WS_CTL) + CW_BAR; const unsigned x = xb_xcc_id();
            const unsigned rk = xb_add(&barw[XB_XCNT(x)], 1u); M[12] = x; M[13] = rk; M[14] = blockIdx.x; }
        __syncthreads(); }
#define IN(k) (kargs()->ph_lo <= (k) && (k) < kargs()->ph_hi)
#define BARL() do { XcdBarrier bar_; bar_.bar = (unsigned*)(kargs()->ws + WS_CTL) + CW_BAR; bar_.x = xb_xcc_id(); bar_.st = (volatile LAS unsigned*)(lds + MISC_OFF) + 8; xcd_barrier<true>(bar_); } while (0)
#define BAR(k) do { if (IN(k) && IN((k) + 1)) { XcdBarrier bar_; bar_.bar = (unsigned*)(kargs()->ws + WS_CTL) + CW_BAR; bar_.x = xb_xcc_id(); bar_.st = (volatile LAS unsigned*)(lds + MISC_OFF) + 8; xcd_barrier(bar_); } } while (0)
#define PH_VIEW() KA A = kargs(); unsigned char* ws = A->ws; float* mods = (float*)(ws + WS_MODS); bf16* Hb = (bf16*)(ws + WS_H); bf16* OBb = (bf16*)(ws + WS_OB); bf16* Gb = (bf16*)(ws + WS_G); bf16* Pb = (bf16*)(ws + WS_P); \
    bf16* GRb = (bf16*)(ws + WS_GR); bf16* MIXb = (bf16*)(ws + WS_MIX); bf16* XBC = (bf16*)(ws + WS_XC); bf16* XBL = (bf16*)A->out; (void)mods; (void)Hb; (void)OBb; (void)Gb; (void)Pb; (void)GRb; (void)MIXb; (void)XBC; (void)XBL; \
    int tid = threadIdx.x; asm volatile("" : "+v"(tid)); const int lane = tid & 63, wave = __builtin_amdgcn_readfirstlane(tid >> 6), wg = blockIdx.x, G = gridDim.x, gw = wg * NWAVES + wave, NGW = G * NWAVES; \
    (void)lane; (void)wave; (void)wg; (void)G; (void)gw; (void)NGW
#define LAYER_VIEW() const float* xlat = A->in[I_X]; const float* xctx = A->in[I_CTX]; \
    const float* mlat = mods + MO_LAT + l * 16 * 6144; const float* mctx = mods + MO_CTX + l * 6144; (void)xlat; (void)xctx; (void)mlat; (void)mctx
    LAS int* tab = (LAS int*)(lds + TAB_OFF);
#define VCU() ((int)__builtin_amdgcn_readfirstlane(((volatile LAS unsigned*)(lds + MISC_OFF))[14]))

    if (IN(0)) { PH_VIEW();
        LAS float* scr = (LAS float*)(lds + wave * 16384);
        for (int it = gw; it < NI_MAIN; it += NGW) conv_item_main(A, it, scr, lane);
        __syncthreads();
        for (int it = wg; it < 192; it += G) mod_item(A, it, lds, tid, lane, wave);
        for (int it = wg; it < 256; it += G) colmax_rows_item(A, it, tid);
        for (int it = wg; it < NS_MAIN; it += G) colscale_item_main(A, it, lds, tid, lane, wave);
        if (wg == G - 1) for (int i = tid; i < 1024; i += NTHR) { const int d = i >> 9, ch = i & 511; const float a0 = A->in[I_HLB][d * 512 + ch], a1 = A->in[I_HLB][(2 + d) * 512 + ch];
            mods[MO_LB + d * 512 + ch] = 0.f; mods[MO_LB + 1024 + d * 512 + ch] = 1.f / (1.f + __expf(a0 - a1)); }
    }
    BAR(0);
#if !MK_MULTI
    if (threadIdx.x == 0 && IN(0) && IN(1)) { volatile LAS unsigned* M = (volatile LAS unsigned*)(lds + MISC_OFF); unsigned* barw = (unsigned*)(kargs()->ws + WS_CTL) + CW_BAR; const unsigned per = gridDim.x / 8; bool ok = (gridDim.x % 8) == 0;
        for (unsigned j = 0; j < 16; ++j) { const unsigned cnt = xb_ld(&barw[XB_XCNT(j)]); ok = ok && (j < 8 ? cnt == per : cnt == 0u); }
        if (ok) M[14] = M[13] * 8u + M[12]; }
    __syncthreads();
#endif
#pragma nounroll
    for (int l = 0; l < 2; ++l) {
        const int pb = l ? 10 : 1;
        if (IN(pb)) { PH_VIEW(); LAYER_VIEW();
            typedef float f32x4m __attribute__((ext_vector_type(4)));
            const bf16* W32 = (const bf16*)(ws + WS_WIN) + (size_t)l * 32 * 1024;
            const int fm = lane & 15, kq = lane >> 4;
            bf16x8 wb[2][4];
#pragma unroll
            for (int nt = 0; nt < 2; ++nt)
#pragma unroll
                for (int s = 0; s < 4; ++s) wb[nt][s] = *(const bf16x8*)(W32 + (size_t)(nt * 16 + fm) * 1024 + 128 * wave + 32 * s + 8 * kq);
            LAS unsigned char* tile = lds; LAS float* red = (LAS float*)(lds + 32768);
            v4u yb[2][4];
#define N1LOAD(rr_, m_) do { const int mm_ = (m_); if (l) { const v2u* xr_ = (const v2u*)(mm_ < ML ? XBL + (size_t)mm_ * D : XBC + (size_t)(mm_ - ML) * D) + lane; \
        _Pragma("unroll") for (int j = 0; j < 4; ++j) { const v2u w_ = xr_[64 * j]; yb[rr_][j] = (v4u){w_.x, w_.y, 0u, 0u}; } } \
    else { const float* xr_ = mm_ < ML ? xlat + (size_t)mm_ * D : xctx + (size_t)(mm_ - ML) * D; _Pragma("unroll") for (int j = 0; j < 4; ++j) yb[rr_][j] = ((const v4u*)xr_)[lane + 64 * j]; } } while (0)
#pragma unroll
            for (int rr = 0; rr < 2; ++rr) N1LOAD(rr, wg * 144 + 2 * wave + rr);
            for (int blk = 0; blk < 9; ++blk) {
                const int r0 = wg * 144 + blk * 16;
#pragma unroll
                for (int rr = 0; rr < 2; ++rr) { const int lr = 2 * wave + rr, m = r0 + lr; const bool lat = m < ML; const float* md = lat ? mlat + (m >> 11) * 6144 : mctx;
                    f32x4 y[4]; float ss = 0.f;
#pragma unroll
                    for (int j = 0; j < 4; ++j) { const v4u w_ = yb[rr][j]; if (l) y[j] = (f32x4){bflo(w_.x), bfhi(w_.x), bflo(w_.y), bfhi(w_.y)}; else y[j] = __builtin_bit_cast(f32x4, w_);
                        ss += (y[j].x * y[j].x + y[j].y * y[j].y) + (y[j].z * y[j].z + y[j].w * y[j].w); }
                    if (blk + 1 < 9) N1LOAD(rr, m + 16);
                    const float rstd = rsqrtf(wave_sum(ss) * (1.f / D) + EPS);
                    const float* g1 = A->in[I_N1G] + l * D;
#pragma unroll
                    for (int j = 0; j < 4; ++j) { const f32x4 gv = ((const f32x4*)g1)[lane + 64 * j], sh = ((const f32x4*)md)[lane + 64 * j], sc = ((const f32x4*)(md + 1024))[lane + 64 * j];
                        y[j] = y[j] * rstd * gv * (sc + 1.f) + sh; const v2u w = (v2u){pk2(y[j].x, y[j].y), pk2(y[j].z, y[j].w)};
                        const int ch = (lane + 64 * j) >> 1; *(LAS v2u*)(tile + lr * 2048 + ((ch ^ lr) << 4) + (lane & 1) * 8) = w; }
                    quant_row(y, (unsigned*)(ws + WS_HQ) + (size_t)m * 256, (float*)(ws + WS_SAR) + m, lane); }
                __syncthreads();
                f32x4m c0 = {0.f, 0.f, 0.f, 0.f}, c1 = {0.f, 0.f, 0.f, 0.f};
#pragma unroll
                for (int s = 0; s < 4; ++s) { const bf16x8 af = *(const LAS bf16x8*)(tile + fm * 2048 + (((16 * wave + 4 * s + kq) ^ fm) << 4));
                    c0 = __builtin_amdgcn_mfma_f32_16x16x32_bf16(af, wb[0][s], c0, 0, 0, 0); c1 = __builtin_amdgcn_mfma_f32_16x16x32_bf16(af, wb[1][s], c1, 0, 0, 0); }
#pragma unroll
                for (int e = 0; e < 4; ++e) { red[(wave * 16 + 4 * kq + e) * 32 + fm] = c0[e]; red[(wave * 16 + 4 * kq + e) * 32 + 16 + fm] = c1[e]; }
                __syncthreads();
                { float s = 0.f;
#pragma unroll
                  for (int w = 0; w < 8; ++w) s += red[w * 512 + tid];
                  GRb[(size_t)(r0 + (tid >> 5)) * 32 + (tid & 31)] = (bf16)f2bf(s); }
            }
#undef N1LOAD
            if (l == 0) { __syncthreads(); LAS float* scr = (LAS float*)(lds + wave * 16384); for (int it = gw; it < NQ_MAIN; it += NGW) conv_item_q(A, it, scr, lane);
                for (int idx = wg * NTHR + tid; idx < 8 * 7168; idx += G * NTHR) { const int e = idx / 7168, row = idx % 7168, which = (row >> 7) & 1, col = 128 * (row >> 8) + (row & 127);
                    ((float*)(ws + WS_SB13))[idx] = fmaxf(__builtin_bit_cast(float, ((const unsigned*)(ws + WS_CTL))[CW_CM + (e * 2 + which) * DEXP + col]), 1e-30f) * (1.f / 127.f); } }
        }
        BAR(pb);
        if (IN(pb + 1)) { PH_VIEW(); LAYER_VIEW();
            pg8::Gemm g{(const bf16*)(ws + WS_HQ), (const bf16*)(ws + WS_WINQ + (size_t)l * 4096 * 1024), MT, PW, D / 2}; pg8::StaticOrder S; S.init(MT, PW, G, VCU());
            EpiInProjT<true> E{Pb, Gb, GRb, mods + MO_LB + l * 1024, (const float*)(ws + WS_SAR), (const float*)(ws + WS_SBIN) + l * 4096};
            pg8::gemm_phase<EpiInProjT<true>, pg8::StaticOrder, true, true>(lds, g, S, E);
        }
        BAR(pb + 1);
        if (IN(pb + 2)) { PH_VIEW(); LAYER_VIEW();
            for (int s = wg; s < 256; s += G) { const int grp = s >> 7, r = s & 127, b = r >> 3, hd = (r >> 1) & 3, dir = r & 1;
                bf16* OUT = dir ? OBb : Hb;
                const float* w2 = A->in[I_GW2] + (size_t)(l * 2 + dir) * 16 * 256; const float* gb = A->in[I_GB] + (l * 2 + dir) * 256;
                if (grp == 0) { if (dir) scan_mfma<64, 1>(lds, Pb, GRb, w2, gb, OUT, grp, b, hd, tid); else scan_mfma<64, 0>(lds, Pb, GRb, w2, gb, OUT, grp, b, hd, tid); }
                else { if (dir) scan_mfma<128, 1>(lds, Pb, GRb, w2, gb, OUT, grp, b, hd, tid); else scan_mfma<128, 0>(lds, Pb, GRb, w2, gb, OUT, grp, b, hd, tid); } }
        }
        BAR(pb + 2);
        if (IN(pb + 3)) { PH_VIEW(); LAYER_VIEW();
            const int nrow = l ? ML : MT;
            for (int m = gw; m < nrow; m += 2 * NGW) { const int m2 = m + NGW; MixIn ra, rb;
                mix_load(Hb + (size_t)m * D, OBb + (size_t)m * D, Gb + (size_t)m * D, lane, ra);
                { const int mc = m2 < nrow ? m2 : m; mix_load(Hb + (size_t)mc * D, OBb + (size_t)mc * D, Gb + (size_t)mc * D, lane, rb); }
                mix_finish_bf(ra, A->in[I_GLAG] + l * 128, A->in[I_HGG] + l * 128, MIXb + (size_t)m * D, lane);
                if (m2 < nrow) mix_finish_bf(rb, A->in[I_GLAG] + l * 128, A->in[I_HGG] + l * 128, MIXb + (size_t)m2 * D, lane); }
            if (l == 1) { LAS float* scr = (LAS float*)(lds + wave * 16384); for (int it = gw; it < NI_M13; it += NGW) conv_item_moe(A, it, scr, lane); }
        }
        BAR(pb + 3);
        if (IN(pb + 4)) { PH_VIEW(); LAYER_VIEW();
            const int Mw = l ? ML : MT;
            pg8::Gemm g{MIXb, (const bf16*)(ws + WS_WOUT) + (size_t)l * 1024 * 1024, Mw, D, D}; pg8::StaticOrder S; S.init(Mw, D, G, VCU());
            if (l == 0) { EpiResidB<true> E{xlat, xctx, XBL, XBC, mlat + 2048, mctx + 2048}; pg8::gemm_phase<EpiResidB<true>, pg8::StaticOrder, true, true>(lds, g, S, E); }
            else { EpiResidB<false> E{XBL, XBC, (bf16*)(ws + WS_X3), XBC, mlat + 2048, mctx + 2048}; pg8::gemm_phase<EpiResidB<false>, pg8::StaticOrder, true, true>(lds, g, S, E); }
        }
        BAR(pb + 4);
        if (l == 0) {
            if (IN(6)) { PH_VIEW(); LAYER_VIEW();
                for (int m = gw; m < MT; m += 2 * NGW) { const int m2 = m + NGW; f32x4 ya[4], yb[4]; v2u ra[4], rb[4];
                    xloadb(m < ML ? XBL + (size_t)m * D : XBC + (size_t)(m - ML) * D, lane, ra);
                    { const int mc = m2 < MT ? m2 : m; xloadb(mc < ML ? XBL + (size_t)mc * D : XBC + (size_t)(mc - ML) * D, lane, rb); }
                    xcvt(ra, ya); xcvt(rb, yb);
                    { const float* md = m < ML ? mlat + (m >> 11) * 6144 : mctx; norm_finish_q((unsigned*)(ws + WS_HQ) + (size_t)m * 256, (float*)(ws + WS_SAR) + m, A->in[I_N2G], md + 3072, md + 4096, lane, ya); }
                    if (m2 < MT) { const float* md = m2 < ML ? mlat + (m2 >> 11) * 6144 : mctx; norm_finish_q((unsigned*)(ws + WS_HQ) + (size_t)m2 * 256, (float*)(ws + WS_SAR) + m2, A->in[I_N2G], md + 3072, md + 4096, lane, yb); } }
            }
            BAR(6);
            if (IN(7)) { PH_VIEW(); LAYER_VIEW();
                pg8::Gemm g{(const bf16*)(ws + WS_HQ), (const bf16*)(ws + WS_F13), MT, 2 * DFF, D / 2}; MoeOrder S; S.init(MC / 256, 22, G, VCU(), ML / 256, 0);
#pragma unroll
                for (int e = 0; e < 8; ++e) S.pb[e] = 1 << 30;
                EpiSwiGLUQ E{(bf16*)(ws + WS_ACT0), DFF, 22, 0, (const float*)(ws + WS_SAR), (const float*)(ws + WS_SBF)};
                pg8::gemm_phase<EpiSwiGLUQ, MoeOrder, true, true>(lds, g, S, E);
            }
            BAR(7);
            if (IN(8)) { PH_VIEW(); LAYER_VIEW();
                { pg8::Gemm g{(const bf16*)(ws + WS_ACT0), (const bf16*)(ws + WS_F2), MT, D, DFF}; MoeOrder S; S.init(MC / 256, 4, G, VCU(), ML / 256, 0);
#pragma unroll
                  for (int e = 0; e < 8; ++e) S.pb[e] = 1 << 30;
                  EpiResidB<false> E{XBL, XBC, XBL, XBC, mlat + 5120, mctx + 5120};
                  pg8::gemm_phase<EpiResidB<false>, MoeOrder, true, true>(lds, g, S, E); }
                { pg8::Gemm g{(const bf16*)(ws + WS_HQ), (const bf16*)(ws + WS_F13), MT, 2 * DFF, D / 2}; MoeOrder S; S.init(ML / 256, 22, G, VCU(), 0, 0); S.nb = (MC / 256) * 4; S.keep = 7;
#pragma unroll
                  for (int e = 0; e < 8; ++e) S.pb[e] = 1 << 30;
                  EpiSwiGLUQ E{(bf16*)(ws + WS_ACT0), DFF, 22, 0, (const float*)(ws + WS_SAR), (const float*)(ws + WS_SBF)};
                  pg8::gemm_phase<EpiSwiGLUQ, MoeOrder, true, true>(lds, g, S, E); }
            }
            BAR(8);
            if (IN(9)) { PH_VIEW(); LAYER_VIEW();
                pg8::Gemm g{(const bf16*)(ws + WS_ACT0), (const bf16*)(ws + WS_F2), MT, D, DFF}; MoeOrder S; S.init(ML / 256, 4, G, VCU(), 0, 0);
#pragma unroll
                for (int e = 0; e < 8; ++e) S.pb[e] = 1 << 30;
                EpiResidB<false> E{XBL, XBC, XBL, XBC, mlat + 5120, mctx + 5120};
                pg8::gemm_phase<EpiResidB<false>, MoeOrder, true, true>(lds, g, S, E);
            }
            BAR(9);
        }
    }
    if (IN(15)) { PH_VIEW(); const float* mlat1 = mods + MO_LAT + 16 * 6144;
        LAS int* sE = (LAS int*)(lds + LDSCTL_OFF + 4096); LAS float* sW = (LAS float*)(lds + LDSCTL_OFF + 5120); LAS int* sL = (LAS int*)(lds + LDSCTL_OFF + 6144); LAS float* sS = (LAS float*)(lds + LDSCTL_OFF + 7168);
        f32x4 ga[4], sh4[4], rw[8][4];
        { const float* md0 = mlat1 + ((wg * 128) >> 11) * 6144;
#pragma unroll
          for (int j = 0; j < 4; ++j) { const f32x4 gv = ((const f32x4*)(A->in[I_N2G] + D))[lane + 64 * j], sc = ((const f32x4*)(md0 + 4096))[lane + 64 * j]; sh4[j] = ((const f32x4*)(md0 + 3072))[lane + 64 * j]; ga[j] = gv * (sc + 1.f);
              const f32x4* rp = (const f32x4*)(A->in[I_ROUTER] + (size_t)(4 * (lane + 64 * j)) * 8); f32x4 v[8];
#pragma unroll
              for (int q = 0; q < 8; ++q) v[q] = rp[q];
#pragma unroll
              for (int e = 0; e < 8; ++e) rw[e][j] = (f32x4){v[(e >> 2)][e & 3], v[2 + (e >> 2)][e & 3], v[4 + (e >> 2)][e & 3], v[6 + (e >> 2)][e & 3]}; } }
        const bf16* X3 = (const bf16*)(ws + WS_X3);
        f32x4 y[4]; v2u yr[4], yn[4]; xloadb(X3 + (size_t)(wg * 128 + wave * 16) * D, lane, yr);
        for (int rr = 0; rr < 16; ++rr) { const int tl = wave * 16 + rr, row = wg * 128 + tl;
            { const int rn = rr + 1 < 16 ? row + 1 : row; xloadb(X3 + (size_t)rn * D, lane, yn); }
            xcvt(yr, y);
            { float s = 0.f;
#pragma unroll
              for (int j = 0; j < 4; ++j) s += (y[j].x * y[j].x + y[j].y * y[j].y) + (y[j].z * y[j].z + y[j].w * y[j].w);
              const float rstd = rsqrtf(wave_sum(s) * (1.f / D) + EPS); float am = 0.f;
#pragma unroll
              for (int j = 0; j < 4; ++j) {
                  y[j] = y[j] * rstd * ga[j] + sh4[j]; am = fmaxf(fmaxf(am, fmaxf(fabsf(y[j].x), fabsf(y[j].y))), fmaxf(fabsf(y[j].z), fabsf(y[j].w))); }
#pragma unroll
              for (int o = 1; o < 64; o <<= 1) am = fmaxf(am, __shfl_xor(am, o));
              am = fmaxf(am, 1e-30f); const float inv = 127.f / am; LAS unsigned* hq = (LAS unsigned*)(lds + tl * 1024) + lane;
#pragma unroll
              for (int j = 0; j < 4; ++j) { const int q0 = (int)__builtin_rintf(y[j].x * inv), q1 = (int)__builtin_rintf(y[j].y * inv), q2 = (int)__builtin_rintf(y[j].z * inv), q3 = (int)__builtin_rintf(y[j].w * inv);
                  hq[64 * j] = (unsigned)(q0 & 255) | ((unsigned)(q1 & 255) << 8) | ((unsigned)(q2 & 255) << 16) | ((unsigned)(q3 & 255) << 24); }
              if (lane == 0) sS[tl] = am * (1.f / 127.f); }
            float lg[8];
            { float p[8];
#pragma unroll
              for (int e = 0; e < 8; ++e) { float a = 0.f;
#pragma unroll
                  for (int j = 0; j < 4; ++j) { const f32x4 r4 = rw[e][j]; a += (y[j].x * r4.x + y[j].y * r4.y) + (y[j].z * r4.z + y[j].w * r4.w); }
                  p[e] = a; }
              const bool h5 = (lane & 32) != 0, h4 = (lane & 16) != 0, h3 = (lane & 8) != 0; float p4[4], p2[2], p1;
#pragma unroll
              for (int i = 0; i < 4; ++i) { const float snd = h5 ? p[i] : p[i + 4], kp = h5 ? p[i + 4] : p[i]; p4[i] = kp + __shfl_xor(snd, 32); }
#pragma unroll
              for (int i = 0; i < 2; ++i) { const float snd = h4 ? p4[i] : p4[i + 2], kp = h4 ? p4[i + 2] : p4[i]; p2[i] = kp + __shfl_xor(snd, 16); }
              { const float snd = h3 ? p2[0] : p2[1], kp = h3 ? p2[1] : p2[0]; p1 = kp + __shfl_xor(snd, 8); }
              p1 += __shfl_xor(p1, 4); p1 += __shfl_xor(p1, 2); p1 += __shfl_xor(p1, 1);
#pragma unroll
              for (int e = 0; e < 8; ++e) lg[e] = __builtin_bit_cast(float, __builtin_amdgcn_readlane(__builtin_bit_cast(int, p1), e * 8)); }
            int i0 = 0; float v0 = lg[0];
#pragma unroll
            for (int e = 1; e < 8; ++e) if (lg[e] > v0) { v0 = lg[e]; i0 = e; }
            int i1 = -1; float v1 = -3.0e38f;
#pragma unroll
            for (int e = 0; e < 8; ++e) if (e != i0 && lg[e] > v1) { v1 = lg[e]; i1 = e; }
            const float w0 = 1.f / (1.f + __expf(v1 - v0));
            if (lane == 0) { sE[2 * tl] = i0; sE[2 * tl + 1] = i1; sW[2 * tl] = w0; sW[2 * tl + 1] = 1.f - w0; }
#pragma unroll
            for (int j = 0; j < 4; ++j) yr[j] = yn[j]; }
        __syncthreads();
        { int run = 0;
#pragma unroll
          for (int j = 0; j < 4; ++j) { const bool mt = sE[64 * j + lane] == wave; const unsigned long long mk = __ballot(mt);
              if (mt) sL[64 * j + lane] = run + __popcll(mk & ((1ull << lane) - 1ull)); run += __popcll(mk); }
          if (lane == 0) __hip_atomic_store((int*)(ws + WS_ROUTE + RT_CNT) + wg * 8 + wave, run, __ATOMIC_RELAXED, __HIP_MEMORY_SCOPE_AGENT); }
        BARL();
        moe_tab<true>(kargs(), lds, tid, wg);
        for (int t = wave; t < 128; t += NWAVES) { const int row = wg * 128 + t; const int e0 = sE[2 * t], e1 = sE[2 * t + 1];
            const int s0 = tab[16 + e0] * 256 + tab[8 + e0] + sL[2 * t], s1 = tab[16 + e1] * 256 + tab[8 + e1] + sL[2 * t + 1];
            const v4u a0 = *(const LAS v4u*)(lds + t * 1024 + lane * 16);
            ((v4u*)((signed char*)(ws + WS_HSQ) + (size_t)s0 * D))[lane] = a0; ((v4u*)((signed char*)(ws + WS_HSQ) + (size_t)s1 * D))[lane] = a0;
            if (lane == 0) { float* gwp = (float*)(ws + WS_ROUTE + RT_GW); gwp[s0] = sW[2 * t]; gwp[s1] = sW[2 * t + 1]; float* sap = (float*)(ws + WS_ROUTE + RT_SA); const float san = sS[t]; sap[s0] = san; sap[s1] = san;
                ((v4i*)(ws + WS_ROUTE + RT_SEL))[row] = (v4i){e0, e1, s0, s1}; } }
        __syncthreads();
        { LAS float* scr = (LAS float*)(lds + wave * 16384); for (int it = NI_M13 + gw; it < NI_MOE; it += NGW) conv_item_moe(A, it, scr, lane); }
    }
    BAR(15);
    if (kargs()->ph_lo >= PH_M0 && kargs()->ph_lo <= NPHASE - 1) moe_tab<false>(kargs(), lds, threadIdx.x, blockIdx.x);
    if (IN(PH_M0)) {
        { PH_VIEW(); pg8::Gemm g{(const bf16*)(ws + WS_HSQ), (const bf16*)((const unsigned char*)A->out + DO_M13Q), 0, 0, D / 2}; MoeOrder S; S.init(CHUNK_PAN, 28, G, VCU(), 0, 0);
#pragma unroll
          for (int e = 0; e < 8; ++e) S.pb[e] = __builtin_amdgcn_readfirstlane(tab[16 + e]);
          EpiSwiGLUQ E{(bf16*)(ws + WS_ACT), DEXP, 28, 0, (const float*)(ws + WS_ROUTE + RT_SA), (const float*)(ws + WS_SB13)};
          pg8::gemm_phase<EpiSwiGLUQ, MoeOrder, true, true>(lds, g, S, E); }
        const int R0 = tab[24] - NCHK * CHUNK_PAN;
        if (R0 > 0) { PH_VIEW(); pg8::Gemm g{(const bf16*)(ws + WS_HSQ), (const bf16*)((const unsigned char*)A->out + DO_M13Q), 0, 0, D / 2}; MoeOrder S; S.init(R0, 28, G, VCU(), NCHK * CHUNK_PAN, 0);
#pragma unroll
          for (int e = 0; e < 8; ++e) S.pb[e] = __builtin_amdgcn_readfirstlane(tab[16 + e]);
          EpiSwiGLUQ E{(bf16*)(ws + WS_ACT), DEXP, 28, (NCHK - 1) * CHUNK_PAN, (const float*)(ws + WS_ROUTE + RT_SA), (const float*)(ws + WS_SB13)};
          pg8::gemm_phase<EpiSwiGLUQ, MoeOrder, true, true>(lds, g, S, E); }
    }
    BAR(PH_M0);
#pragma nounroll
    for (int it = 1; it <= NCHK; ++it) {
        const int TP = tab[24], R = TP - NCHK * CHUNK_PAN, pa = PH_M0 - 1 + 2 * it, pbb = PH_M0 + 2 * it;
        if (IN(pa)) { PH_VIEW();
            pg8::Gemm g{(const bf16*)(ws + WS_ACT), (const bf16*)((const unsigned char*)A->out + DO_M2), 0, 0, DEXP}; MoeOrder S; S.init(CHUNK_PAN, 4, G, VCU(), CHUNK_PAN * (it - 1), 1); S.nb = 0;
#pragma unroll
            for (int e = 0; e < 8; ++e) S.pb[e] = __builtin_amdgcn_readfirstlane(tab[16 + e]);
            EpiMoeOut E{(bf16*)(ws + WS_HS), (const float*)(ws + WS_ROUTE + RT_GW), CHUNK_PAN * (it - 1)};
            pg8::gemm_phase<EpiMoeOut, MoeOrder, true, true>(lds, g, S, E);
        }
        BAR(pa);
        if (it < NCHK) {
            if (IN(pbb) && it == 1 && R > 0) { PH_VIEW();
                pg8::Gemm g{(const bf16*)(ws + WS_ACT) + (size_t)CHUNK_PAN * 256 * DEXP, (const bf16*)((const unsigned char*)A->out + DO_M2), 0, 0, DEXP}; MoeOrder S; S.init(R, 4, G, VCU(), NCHK * CHUNK_PAN, 1); S.nb = 0;
#pragma unroll
                for (int e = 0; e < 8; ++e) S.pb[e] = __builtin_amdgcn_readfirstlane(tab[16 + e]);
                EpiMoeOut E{(bf16*)(ws + WS_HS), (const float*)(ws + WS_ROUTE + RT_GW), NCHK * CHUNK_PAN};
                pg8::gemm_phase<EpiMoeOut, MoeOrder, true, true>(lds, g, S, E);
            }
            if (IN(pbb)) { PH_VIEW();
                pg8::Gemm g{(const bf16*)(ws + WS_HSQ), (const bf16*)((const unsigned char*)A->out + DO_M13Q), 0, 0, D / 2}; MoeOrder S; S.init(CHUNK_PAN, 28, G, VCU(), CHUNK_PAN * it, 0); S.nb = (it == 1) ? 4 * R : 0;
#pragma unroll
                for (int e = 0; e < 8; ++e) S.pb[e] = __builtin_amdgcn_readfirstlane(tab[16 + e]);
                EpiSwiGLUQ E{(bf16*)(ws + WS_ACT), DEXP, 28, CHUNK_PAN * it, (const float*)(ws + WS_ROUTE + RT_SA), (const float*)(ws + WS_SB13)};
                pg8::gemm_phase<EpiSwiGLUQ, MoeOrder, true, true>(lds, g, S, E);
            }
            BAR(pbb);
        }
    }
    if (IN(NPHASE - 1)) { PH_VIEW(); const float* mlat1 = mods + MO_LAT + 16 * 6144;
        unsigned bad = __hip_atomic_load((unsigned*)(ws + WS_CTL) + CW_BAR + XB_TMO, __ATOMIC_RELAXED, __HIP_MEMORY_SCOPE_AGENT);
        const bf16* Y = (const bf16*)(ws + WS_HS);
        const v4i* selt = (const v4i*)(ws + WS_ROUTE + RT_SEL);
        const bf16* X3 = (const bf16*)(ws + WS_X3);
#define FIN_LOAD(mm, sel_, X_, A_, B_) do { const v2u* xr_ = (const v2u*)(X3 + (size_t)(mm) * D) + lane; const v2u* y0_ = (const v2u*)(Y + (size_t)(sel_).z * D) + lane; const v2u* y1_ = (const v2u*)(Y + (size_t)(sel_).w * D) + lane; \
            _Pragma("unroll") for (int j = 0; j < 4; ++j) { X_[j] = xr_[64 * j]; A_[j] = y0_[64 * j]; B_[j] = y1_[64 * j]; } } while (0)
        v2u xa[4], xn[4]; v2u aa[4], ab[4], na[4], nb[4]; v4i seln = (v4i){0, 0, 0, 0};
        if (gw < ML) { const v4i s0 = selt[gw]; FIN_LOAD(gw, s0, xa, aa, ab); if (gw + NGW < ML) seln = selt[gw + NGW]; }
        for (int m = gw; m < ML; m += NGW) { const int mn = m + NGW; const float* md = mlat1 + (m >> 11) * 6144 + 5120;
            if (mn < ML) { FIN_LOAD(mn, seln, xn, na, nb); if (mn + NGW < ML) seln = selt[mn + NGW]; }
            f32x4* xr = (f32x4*)(A->out + (size_t)m * D) + lane;
            f32x4 v[4]; float s = 0.f;
#pragma unroll
            for (int j = 0; j < 4; ++j) { const f32x4 gt = ((const f32x4*)md)[lane + 64 * j]; const v2u a = aa[j], b = ab[j];
                const f32x4 yy = {bflo(a.x) + bflo(b.x), bfhi(a.x) + bfhi(b.x), bflo(a.y) + bflo(b.y), bfhi(a.y) + bfhi(b.y)};
                v[j] = (f32x4){bflo(xa[j].x), bfhi(xa[j].x), bflo(xa[j].y), bfhi(xa[j].y)} + gt * yy; s += (v[j].x * v[j].x + v[j].y * v[j].y) + (v[j].z * v[j].z + v[j].w * v[j].w); }
            const float rstd = rsqrtf(wave_sum(s) * (1.f / D) + EPS);
#pragma unroll
            for (int j = 0; j < 4; ++j) { f32x4 o = v[j] * rstd * ((const f32x4*)A->in[I_FNG])[lane + 64 * j]; if (bad) o = (f32x4){__builtin_nanf(""), __builtin_nanf(""), __builtin_nanf(""), __builtin_nanf("")}; xr[64 * j] = o; }
#pragma unroll
            for (int j = 0; j < 4; ++j) { xa[j] = xn[j]; aa[j] = na[j]; ab[j] = nb[j]; } }
#undef FIN_LOAD
    }
#undef IN
#undef BAR
}

extern "C" void kernel_launch(void* const* d_in, const int* in_sizes, int n_in, void* d_out, int out_size, void* d_ws, size_t ws_size, hipStream_t stream) {
    static int grid = 0;
    if (grid == 0) {
        if (n_in != 23 || in_sizes[0] != ML * D || out_size != ML * D || ws_size < WS_END2) { fprintf(stderr, "kernel_launch: unexpected shapes (n_in %d, in0 %d, out %d, ws %zu, need %zu); nothing launched\n", n_in, n_in > 0 ? in_sizes[0] : -1, out_size, ws_size, (size_t)WS_END2); grid = -1; return; }
        int dev = 0, cus = 0, per_cu = 0;
        if (hipGetDevice(&dev) != hipSuccess || hipDeviceGetAttribute(&cus, hipDeviceAttributeMultiprocessorCount, dev) != hipSuccess) { grid = -1; return; }
        if (hipFuncSetAttribute((const void*)fwd_kernel, hipFuncAttributeMaxDynamicSharedMemorySize, LDS_BYTES) != hipSuccess) { fprintf(stderr, "kernel_launch: hipFuncSetAttribute failed\n"); grid = -1; return; }
        if (hipOccupancyMaxActiveBlocksPerMultiprocessor(&per_cu, (const void*)fwd_kernel, NTHR, LDS_BYTES) != hipSuccess || per_cu < 1) fprintf(stderr, "kernel_launch: occupancy query reports %d\n", per_cu);
        (void)hipGetLastError();
        if (cus < 256) { fprintf(stderr, "kernel_launch: needs 256 CUs, device has %d\n", cus); grid = -1; return; }
        grid = 256;
    }
    if (grid < 0) return;
    if (hipMemsetAsync((char*)d_ws + WS_CTL, 0, CTL_ZERO_BYTES, stream) != hipSuccess) return;
    Args a{};
    for (int i = 0; i < 23; ++i) a.in[i] = (const float*)d_in[i];
    a.out = (float*)d_out; a.ws = (unsigned char*)d_ws;
#if MK_MULTI
#if defined(PROBE_EXTRA)
    { a.ph_lo = PROBE_EXTRA; a.ph_hi = PROBE_EXTRA + 1; }
#define PROBE_LAUNCH() do { Args b = a; b.ph_lo = PROBE_EXTRA; b.ph_hi = PROBE_EXTRA + 1; hipLaunchKernelGGL(fwd_kernel, dim3(grid), dim3(NTHR), LDS_BYTES, stream, b); } while (0)
#else
#define PROBE_LAUNCH() do { } while (0)
#endif
    for (int k = 0; k < NPHASE; ++k) { if (k == PROBE_AT) PROBE_LAUNCH(); a.ph_lo = k; a.ph_hi = k + 1; const int nrep = ((PROBE_REP >> k) & 1ull) ? 2 : 1; for (int r = 0; r < nrep; ++r) hipLaunchKernelGGL(fwd_kernel, dim3(grid), dim3(NTHR), LDS_BYTES, stream, a); }
#else
    a.ph_lo = 0; a.ph_hi = NPHASE; hipLaunchKernelGGL(fwd_kernel, dim3(grid), dim3(NTHR), LDS_BYTES, stream, a);
#endif
}
```
